# Optimizing an MI355X kernel written in HIP

```python
import math
import jax, jax.numpy as jnp
from jax import lax
import numpy as np

D_MODEL = 1024
BATCH = 8
SEQ = 4096
DEPTH = 1

N_HEADS_A = 8
HEAD_DIM_A = 64
N_IDX_HEADS = 16
IDX_DIM = 64
TOPK_MAX = 256
N_HEADS_B = 8
QK_NOPE_DIM = 64
QK_ROPE_DIM = 32
V_DIM_B = 64
Q_LORA = 384
KV_LORA = 256
D_MIX = N_HEADS_A * HEAD_DIM_A + N_HEADS_B * V_DIM_B
D_FF = 2816
ROPE_THETA = 10000.0
EPS = 1e-6
Q_BLOCK = 128

PROJ_SIZES = (
    N_HEADS_A * HEAD_DIM_A,
    HEAD_DIM_A,
    HEAD_DIM_A,
    N_IDX_HEADS * IDX_DIM,
    IDX_DIM,
    N_IDX_HEADS,
    Q_LORA,
    KV_LORA,
    QK_ROPE_DIM,
)
D_PROJ = sum(PROJ_SIZES)

kernel_name = "hybrid_dsa_mla_macaron"


def rmsnorm(x, g):
    xf = x.astype(jnp.float32)
    y = xf * lax.rsqrt(jnp.mean(xf * xf, axis=-1, keepdims=True) + EPS)
    return (y * g.astype(jnp.float32)).astype(x.dtype)


def swiglu(x, w_gate, w_up, w_down):
    return (jax.nn.silu(x @ w_gate) * (x @ w_up)) @ w_down


def rope_tables(seq_len, dim):
    pos = jnp.arange(seq_len, dtype=jnp.float32)
    inv_freq = ROPE_THETA ** (-jnp.arange(0, dim, 2, dtype=jnp.float32) / dim)
    ang = pos[:, None] * inv_freq[None, :]
    return jnp.cos(ang), jnp.sin(ang)


def apply_rope(x, cos, sin):
    shape = (cos.shape[0],) + (1,) * (x.ndim - 3) + (cos.shape[1],)
    c = cos.reshape(shape)
    s = sin.reshape(shape)
    xf = x.astype(jnp.float32)
    x1, x2 = jnp.split(xf, 2, axis=-1)
    return jnp.concatenate([x1 * c - x2 * s, x1 * s + x2 * c], axis=-1).astype(x.dtype)


def block_slice(a, start):
    return lax.dynamic_slice_in_dim(a, start, Q_BLOCK, axis=1)


def dsa_sparse_attention(q, k, v, q_idx, k_idx, w_idx):
    B, T = q.shape[0], q.shape[1]
    top_k = min(TOPK_MAX, T // 4)
    n_blocks = T // Q_BLOCK
    key_pos = jnp.arange(T)
    scale = HEAD_DIM_A ** -0.5
    idx_scale = (N_IDX_HEADS * IDX_DIM) ** -0.5

    def one_block(i):
        s0 = i * Q_BLOCK
        qb = block_slice(q, s0)
        qib = block_slice(q_idx, s0)
        wb = block_slice(w_idx, s0).astype(jnp.float32) * idx_scale
        qpos = s0 + jnp.arange(Q_BLOCK)
        causal = key_pos[None, :] <= qpos[:, None]
        idx_logits = jnp.einsum('bqhd,bsd->bqhs', qib, k_idx).astype(jnp.float32)
        score = jnp.einsum('bqh,bqhs->bqs', wb, jax.nn.relu(idx_logits))
        score = jnp.where(causal[None], score, -jnp.inf)
        _, sel = lax.top_k(score, top_k)
        valid = sel <= qpos[None, :, None]
        kg = jax.vmap(lambda kb, ib: kb[ib])(k, sel)
        vg = jax.vmap(lambda vb, ib: vb[ib])(v, sel)
        att = jnp.einsum('bqhd,bqkd->bqhk', qb, kg).astype(jnp.float32) * scale
        att = jnp.where(valid[:, :, None, :], att, -jnp.inf)
        p = jax.nn.softmax(att, axis=-1)
        return jnp.einsum('bqhk,bqkd->bqhd', p.astype(vg.dtype), vg)

    out = lax.map(one_block, jnp.arange(n_blocks))
    return jnp.moveaxis(out, 0, 1).reshape(B, T, N_HEADS_A * HEAD_DIM_A)


def mla_attention(c_q, c_kv, k_rope, g_q_lat, g_kv_lat, w_uq, w_ukv, cos_b, sin_b):
    B, T = c_q.shape[0], c_q.shape[1]
    n_blocks = T // Q_BLOCK
    key_pos = jnp.arange(T)
    scale = (QK_NOPE_DIM + QK_ROPE_DIM) ** -0.5
    q = (rmsnorm(c_q, g_q_lat) @ w_uq).reshape(B, T, N_HEADS_B, QK_NOPE_DIM + QK_ROPE_DIM)
    q_nope, q_pe = q[..., :QK_NOPE_DIM], q[..., QK_NOPE_DIM:]
    q_pe = apply_rope(q_pe, cos_b, sin_b)
    kv = (rmsnorm(c_kv, g_kv_lat) @ w_ukv).reshape(B, T, N_HEADS_B, QK_NOPE_DIM + V_DIM_B)
    k_nope, v = kv[..., :QK_NOPE_DIM], kv[..., QK_NOPE_DIM:]
    k_pe = apply_rope(k_rope, cos_b, sin_b)

    def one_block(i):
        s0 = i * Q_BLOCK
        qn = block_slice(q_nope, s0)
        qp = block_slice(q_pe, s0)
        qpos = s0 + jnp.arange(Q_BLOCK)
        causal = key_pos[None, :] <= qpos[:, None]
        s = (jnp.einsum('bqhd,bshd->bhqs', qn, k_nope)
             + jnp.einsum('bqhr,bsr->bhqs', qp, k_pe)).astype(jnp.float32) * scale
        s = jnp.where(causal[None, None], s, -jnp.inf)
        p = jax.nn.softmax(s, axis=-1)
        return jnp.einsum('bhqs,bshd->bqhd', p.astype(v.dtype), v)

    out = lax.map(one_block, jnp.arange(n_blocks))
    return jnp.moveaxis(out, 0, 1).reshape(B, T, N_HEADS_B * V_DIM_B)


def setup_inputs(seed: int = 0) -> dict:
    key = jax.random.key(seed)
    ks = jax.random.split(key, 20)

    def w(k, shape, fan_in):
        return jax.random.normal(k, shape, jnp.float32) * (fan_in ** -0.5)

    def gain(k, shape):
        return 1.0 + 0.1 * jax.random.normal(k, shape, jnp.float32)

    L = DEPTH
    return {
        "x": jax.random.normal(ks[0], (BATCH, SEQ, D_MODEL), jnp.float32),
        "g_ffn1": gain(ks[1], (L, D_MODEL)),
        "w1_gate": w(ks[2], (L, D_MODEL, D_FF), D_MODEL),
        "w1_up": w(ks[3], (L, D_MODEL, D_FF), D_MODEL),
        "w1_down": w(ks[4], (L, D_FF, D_MODEL), D_FF),
        "g_mix": gain(ks[5], (L, D_MODEL)),
        "w_in": w(ks[6], (L, D_MODEL, D_PROJ), D_MODEL),
        "g_q_lat": gain(ks[7], (L, Q_LORA)),
        "g_kv_lat": gain(ks[8], (L, KV_LORA)),
        "w_uq": w(ks[9], (L, Q_LORA, N_HEADS_B * (QK_NOPE_DIM + QK_ROPE_DIM)), Q_LORA),
        "w_ukv": w(ks[10], (L, KV_LORA, N_HEADS_B * (QK_NOPE_DIM + V_DIM_B)), KV_LORA),
        "w_out": w(ks[11], (L, D_MIX, D_MODEL), D_MIX),
        "g_ffn2": gain(ks[12], (L, D_MODEL)),
        "w2_gate": w(ks[13], (L, D_MODEL, D_FF), D_MODEL),
        "w2_up": w(ks[14], (L, D_MODEL, D_FF), D_MODEL),
        "w2_down": w(ks[15], (L, D_FF, D_MODEL), D_FF),
        "g_final": gain(ks[16], (D_MODEL,)),
    }


def reference(x, g_ffn1, w1_gate, w1_up, w1_down, g_mix, w_in, g_q_lat, g_kv_lat,
              w_uq, w_ukv, w_out, g_ffn2, w2_gate, w2_up, w2_down, g_final):
    B, T, _ = x.shape
    cos_a, sin_a = rope_tables(T, HEAD_DIM_A)
    cos_i, sin_i = rope_tables(T, IDX_DIM)
    cos_b, sin_b = rope_tables(T, QK_ROPE_DIM)
    split_points = [int(v) for v in np.cumsum(PROJ_SIZES)[:-1]]
    for l in range(DEPTH):
        x = x + 0.5 * swiglu(rmsnorm(x, g_ffn1[l]), w1_gate[l], w1_up[l], w1_down[l])
        h = rmsnorm(x, g_mix[l])
        p = h @ w_in[l]
        qa, ka, va, qi, ki, wi, cq, ckv, kr = jnp.split(p, split_points, axis=-1)
        qa = apply_rope(qa.reshape(B, T, N_HEADS_A, HEAD_DIM_A), cos_a, sin_a)
        ka = apply_rope(ka, cos_a, sin_a)
        qi = apply_rope(qi.reshape(B, T, N_IDX_HEADS, IDX_DIM), cos_i, sin_i)
        ki = apply_rope(ki, cos_i, sin_i)
        out_a = dsa_sparse_attention(qa, ka, va, qi, ki, wi)
        out_b = mla_attention(cq, ckv, kr, g_q_lat[l], g_kv_lat[l], w_uq[l], w_ukv[l], cos_b, sin_b)
        x = x + jnp.concatenate([out_a, out_b], axis=-1) @ w_out[l]
        x = x + 0.5 * swiglu(rmsnorm(x, g_ffn2[l]), w2_gate[l], w2_up[l], w2_down[l])
    return rmsnorm(x, g_final)
```

```cpp
#include <hip/hip_runtime.h>
#include <cstdio>
#include <cstdint>
#include <cmath>

#ifndef MK_DEBUG
#define MK_DEBUG 0
#endif
#define LAS __attribute__((address_space(3)))
#define GAS __attribute__((address_space(1)))
typedef _Float16 f16;
typedef _Float16 h8 __attribute__((ext_vector_type(8)));
typedef _Float16 h4 __attribute__((ext_vector_type(4)));
typedef _Float16 h2 __attribute__((ext_vector_type(2)));
typedef float f32x2 __attribute__((ext_vector_type(2)));
typedef float f32x4 __attribute__((ext_vector_type(4)));
typedef float f32x16 __attribute__((ext_vector_type(16)));
typedef unsigned u32x2 __attribute__((ext_vector_type(2)));
typedef unsigned u32x4 __attribute__((ext_vector_type(4)));
typedef unsigned short u16;

constexpr int BATCH = 8, SEQ = 4096, DM = 1024, M = BATCH * SEQ;
constexpr int DFF = 2816, NFF = 2 * DFF;
constexpr int DPROJ = 2416, NP = 2560;
constexpr int QLORA = 384, KVLORA = 256;
constexpr int NQB = 768, NKV = 1024;
constexpr float EPS = 1e-6f;
constexpr float LOG2E = 1.4426950408889634f;
constexpr int PC_QA = 0, PC_QI = 512, PC_KA = 1536, PC_KI = 1600, PC_KR = 1664, PC_VA = 1696, PC_WI = 1760, PC_CQ = 1792, PC_CKV = 2304;
constexpr int WC_QA = 0, WC_KA = 512, WC_VA = 576, WC_QI = 640, WC_KI = 1664, WC_WI = 1728, WC_CQ = 1744, WC_CKV = 2128, WC_KR = 2384;

constexpr size_t MiB = 1u << 20;
constexpr size_t WS_CTL = 0, CTL_ZERO_BYTES = 1 * MiB;
constexpr size_t WS_BT1 = 1 * MiB;
constexpr size_t WS_BTD1 = 12 * MiB;
constexpr size_t WS_BT2 = 18 * MiB;
constexpr size_t WS_BTD2 = 29 * MiB;
constexpr size_t WS_BTIN = 35 * MiB;
constexpr size_t WS_BTQ = 40 * MiB;
constexpr size_t WS_BTKV = 41 * MiB;
constexpr size_t WS_BTOUT = 42 * MiB;
constexpr size_t WS_ROPE = 44 * MiB;
constexpr size_t WS_SS0 = 46 * MiB;
constexpr size_t WS_SS16 = 47 * MiB;
constexpr size_t WS_SSQ = 49 * MiB;
constexpr size_t WS_SSKV = 50 * MiB;
constexpr size_t WS_WI = 51 * MiB;
constexpr size_t WS_XH = 54 * MiB;
constexpr size_t WS_H = 118 * MiB;
constexpr size_t WS_P = WS_H;
constexpr size_t WS_QB = 294 * MiB;
constexpr size_t WS_KV = 342 * MiB;
constexpr size_t WS_MIX = 406 * MiB;
constexpr size_t WS_MASK = 470 * MiB;
constexpr size_t WS_END = 486 * MiB;

constexpr int RING_BYTES = 131072;
constexpr int LDSCTL_OFF = RING_BYTES, MISC_OFF = LDSCTL_OFF + 320;
constexpr int LDS_BYTES = 147456;
constexpr int NWAVES = 8;

#define RLX_AGENT __ATOMIC_RELAXED, __HIP_MEMORY_SCOPE_AGENT
#define LDS_WAIT() asm volatile("s_waitcnt lgkmcnt(0)" ::: "memory")
#define VM_WAIT() asm volatile("s_waitcnt vmcnt(0)" ::: "memory")

__device__ __forceinline__ unsigned pkh(float a, float b) { h2 v; v.x = (f16)a; v.y = (f16)b; return __builtin_bit_cast(unsigned, v); }
__device__ __forceinline__ int opaque_tid() { int t = threadIdx.x; asm volatile("" : "+v"(t)); return t; }
__device__ __forceinline__ float frsq(float x) { return __builtin_amdgcn_rsqf(x); }
__device__ __forceinline__ float sq4(const f32x4 v) { return (v.x * v.x + v.y * v.y) + (v.z * v.z + v.w * v.w); }
__device__ __forceinline__ float wave_sum(float v) {
#pragma unroll
    for (int o = 1; o < 64; o <<= 1) v += __shfl_xor(v, o);
    return v;
}

#define XB_TMO      128
#define XB_XCNT(j)  (256  + 64 * (j))
#define XB_XSUB(j)  (1280 + 64 * (j))
#define XB_XGEN(j)  (2304 + 64 * (j))
#define XB_TOP      3328
#define XB_TOPGEN   3392
#define XCD_BAR_WORDS 3456
#define XB_SPIN_CAP (1u << 18)
constexpr int CW_BAR = 4096;

__device__ __forceinline__ unsigned xb_ld(unsigned* p)              { return __hip_atomic_load(p, __ATOMIC_RELAXED, __HIP_MEMORY_SCOPE_AGENT); }
__device__ __forceinline__ unsigned xb_add(unsigned* p, unsigned v) { return __hip_atomic_fetch_add(p, v, __ATOMIC_RELAXED, __HIP_MEMORY_SCOPE_AGENT); }
__device__ __forceinline__ unsigned xb_xcc_id() { return (unsigned)__builtin_amdgcn_s_getreg((3 << 11) | 20) & 0xFu; }
#define XB_SPIN(cond, bar) do { unsigned _sp = 0; while (cond) { __builtin_amdgcn_s_sleep(1); \
    if ((++_sp & 255u) == 0u) { if (xb_ld(&(bar)[XB_TMO])) break; if (_sp > XB_SPIN_CAP) { atomicAdd(&(bar)[XB_TMO], 1u); break; } } } } while (0)

struct XcdBarrier { unsigned* bar; unsigned x; volatile LAS unsigned* st; };

__device__ __forceinline__ XcdBarrier xcd_barrier_post(unsigned* bar, volatile LAS unsigned* st) {
    XcdBarrier b; b.bar = bar; b.x = xb_xcc_id(); b.st = st;
    if (threadIdx.x == 0) (void)xb_add(&bar[XB_XCNT(b.x)], 1u);
    return b;
}
__device__ __forceinline__ void xcd_barrier_complete(unsigned* bar, unsigned x, unsigned& nloc, unsigned& nx) {
    const unsigned G = gridDim.x * gridDim.y * gridDim.z;
    unsigned sum, cnt, mine, sp = 0u;
    for (;;) {
        sum = 0u; cnt = 0u; mine = 0u;
#pragma unroll
        for (unsigned j = 0; j < 16; ++j) { const unsigned c = xb_ld(&bar[XB_XCNT(j)]); sum += c; cnt += (c > 0u) ? 1u : 0u; mine = (j == x) ? c : mine; }
        if (sum == G) break;
        __builtin_amdgcn_s_sleep(1);
        if ((++sp & 255u) == 0u) { if (xb_ld(&bar[XB_TMO])) break; if (sp > XB_SPIN_CAP) { atomicAdd(&bar[XB_TMO], 1u); break; } }
    }
    nloc = mine > 0u ? mine : 1u; nx = cnt > 0u ? cnt : 1u;
}
__device__ __forceinline__ void xcd_barrier(const XcdBarrier& b) {
    asm volatile("s_waitcnt vmcnt(0)" ::: "memory");
    __syncthreads();
    if (threadIdx.x == 0) {
        unsigned* bar = b.bar; unsigned bx_ = b.x;
        asm volatile("" : "+s"(bar), "+s"(bx_));
        __builtin_amdgcn_s_waitcnt(0);
        unsigned nloc = b.st[0], nx = b.st[1];
        if (nloc == 0u) { xcd_barrier_complete(bar, bx_, nloc, nx); b.st[0] = nloc; b.st[1] = nx; }
        const unsigned old = xb_add(&bar[XB_XSUB(bx_)], 1u);
        const unsigned gen = old / nloc;
        if (old + 1u == (gen + 1u) * nloc) {
            __builtin_amdgcn_fence(__ATOMIC_RELEASE, "agent");
            asm volatile("s_waitcnt vmcnt(0)" ::: "memory");
            const unsigned og = xb_add(&bar[XB_TOP], 1u);
            const unsigned tg = og / nx;
            if (og + 1u == (tg + 1u) * nx) xb_add(&bar[XB_TOPGEN], 1u);
            else XB_SPIN(xb_ld(&bar[XB_TOPGEN]) == tg, bar);
            __builtin_amdgcn_fence(__ATOMIC_ACQUIRE, "agent");
            xb_add(&bar[XB_XGEN(bx_)], 1u);
            asm volatile("s_waitcnt vmcnt(0)" ::: "memory");
        } else {
            XB_SPIN(xb_ld(&bar[XB_XGEN(bx_)]) == gen, bar);
            __builtin_amdgcn_fence(__ATOMIC_ACQUIRE, "agent");
            asm volatile("s_waitcnt vmcnt(0)" ::: "memory");
        }
    }
    __syncthreads();
}

struct Args {
    const float* x; const float* g_ffn1; const float* w1_gate; const float* w1_up; const float* w1_down;
    const float* g_mix; const float* w_in; const float* g_q_lat; const float* g_kv_lat; const float* w_uq; const float* w_ukv;
    const float* w_out; const float* g_ffn2; const float* w2_gate; const float* w2_up; const float* w2_down; const float* g_final;
    float* out; unsigned char* ws;
};

constexpr int G_FFN1A = 0, G_FFN1B = 1, G_WIN = 2, G_QUP = 3, G_KVUP = 4, G_WOUT = 5, G_FFN2A = 6, G_FFN2B = 7;
namespace pg8 {
constexpr int BM = 256, BK = 64, HALF = 128, HTB = HALF * BK * 2, STAGE_BYTES = 8 * HTB, NXCD = 8, WGM = 8;
__host__ __device__ __forceinline__ int lds_byte(int r, int c) { const int st = (r >> 4) * 2 + (c >> 5), rr = r & 15, cc = c & 31, ob = rr * 64 + cc * 2; return st * 1024 + (ob ^ (((ob >> 9) & 1) << 5)); }
__host__ __device__ __forceinline__ void stage_rc(int b, int& R, int& C) { const int st = b / 1024, sb = b % 1024, swz = sb ^ (((sb >> 9) & 1) << 5); R = (st >> 1) * 16 + swz / 64; C = (st & 1) * 32 + (swz % 64) / 2; }
__host__ __device__ __forceinline__ int perm32(int rho) { const int n = rho >> 4, i = rho & 15; return 8 * (i >> 2) + 4 * n + (i & 3); }

struct Unit { int pm, pn; };
struct StaticOrder {
    int nM, nN, nwg, G, c;
    __device__ void init(int M_, int N_, int G_, int c_) { nM = M_ / BM; nN = N_ / BM; nwg = nM * nN; G = G_; c = c_; }
    __device__ bool next(int i, Unit& u) const {
        const long L = (long)i * G + c; if (L >= nwg) return false;
        int wgid = (int)L; { const int q = nwg / NXCD, r = nwg % NXCD, xcd = wgid % NXCD, off = wgid / NXCD; wgid = (xcd < r ? xcd * (q + 1) : r * (q + 1) + (xcd - r) * q) + off; }
        const int nig = WGM * nN, gid = wgid / nig, fm = gid * WGM, gsz = (nM - fm) < WGM ? (nM - fm) : WGM;
        u.pm = fm + ((wgid % nig) % gsz); u.pn = (wgid % nig) / gsz; return true;
    }
};

enum { EPI_SWIGLU = 0, EPI_RESID = 1, EPI_WIN = 2, EPI_QUP = 3, EPI_KVUP = 4 };
struct GemmDesc {
    const f16* A; const f16* Bt; int M, N, K, lda;
    int epi;
    const float* ss; int nss;
    float invn;
    f16* oh; int ldo;
    const float* xin; float* xout; f16* xh; float* ssout; float rscale;
    const float* cos64; const float* sin64; const float* cos32; const float* sin32;
    float* wi; float* ssq; float* sskv;
};

template <int NSS> __device__ __forceinline__ float row_rstd(const float* ss, int row, float invn) {
    float s;
    if (NSS == 1) s = ss[row];
    else { s = 0.f;
#pragma unroll
        for (int j = 0; j < NSS / 4; ++j) { const f32x4 v = *(const f32x4*)(ss + (size_t)row * NSS + 4 * j); s += (v.x + v.y) + (v.z + v.w); } }
    return frsq(s * invn + EPS);
}
__device__ __forceinline__ float row_rstd_rt(const float* ss, int nss, int row, float invn) {
    if (nss == 1) return row_rstd<1>(ss, row, invn);
    if (nss == 4) return row_rstd<4>(ss, row, invn);
    if (nss == 8) return row_rstd<8>(ss, row, invn);
    return row_rstd<16>(ss, row, invn);
}

__device__ __forceinline__ void make_gemm(const Args& a, int gi, GemmDesc& g);
__device__ __forceinline__ void epilogue(const Args& a, int gi, const f32x4 (&acc)[2][2][4][2], const Unit& u, int wr, int wc, int fr, int fq) {
    asm volatile("" : "+s"(gi), "+s"(wr), "+s"(wc), "+v"(fr), "+v"(fq));
    GemmDesc g; make_gemm(a, gi, g);
    const int row0 = u.pm * BM + wr * 64 + fr;
    if (g.epi == EPI_SWIGLU) {
        const int hc0 = 128 * u.pn + 16 * wc + 4 * fq;
#pragma unroll
        for (int ai = 0; ai < 2; ++ai)
#pragma unroll
            for (int m = 0; m < 4; ++m) {
                const int row = row0 + ai * HALF + m * 16;
                const float rs = row_rstd_rt(g.ss, g.nss, row, g.invn);
                f16* op = g.oh + (size_t)row * DFF + hc0;
#pragma unroll
                for (int bj = 0; bj < 2; ++bj) {
                    const f32x4 ga = acc[ai][bj][m][0] * rs, ua = acc[ai][bj][m][1] * rs;
                    float hv[4];
#pragma unroll
                    for (int i = 0; i < 4; ++i) { const float sg = __builtin_amdgcn_rcpf(1.f + __builtin_amdgcn_exp2f(-ga[i] * LOG2E)); hv[i] = ga[i] * sg * ua[i]; }
                    u32x2 w; w.x = pkh(hv[0], hv[1]); w.y = pkh(hv[2], hv[3]);
                    *(u32x2*)(op + 64 * bj) = w;
                }
            }
    } else if (g.epi == EPI_RESID) {
        const int col0 = u.pn * BM + wc * 32 + 4 * fq;
#pragma unroll
        for (int ai = 0; ai < 2; ++ai)
#pragma unroll
            for (int m = 0; m < 4; ++m) {
                const int row = row0 + ai * HALF + m * 16;
                const size_t off = (size_t)row * DM + col0;
                float q = 0.f;
#pragma unroll
                for (int bj = 0; bj < 2; ++bj)
#pragma unroll
                    for (int n = 0; n < 2; ++n) {
                        const f32x4 xi = *(const f32x4*)(g.xin + off + bj * HALF + n * 16);
                        const f32x4 xo = xi + acc[ai][bj][m][n] * g.rscale;
                        *(f32x4*)(g.xout + off + bj * HALF + n * 16) = xo;
                        u32x2 w; w.x = pkh(xo[0], xo[1]); w.y = pkh(xo[2], xo[3]);
                        *(u32x2*)(g.xh + off + bj * HALF + n * 16) = w;
                        q += sq4(xo);
                    }
                q += __shfl_xor(q, 16); q += __shfl_xor(q, 32);
                if (fq == 0) g.ssout[(size_t)row * 16 + u.pn * 4 + wc] = q;
                if (m & 1) asm volatile("" ::: "memory");
            }
    } else if (g.epi == EPI_WIN) {
        const int pn = u.pn;
#pragma unroll
        for (int ai = 0; ai < 2; ++ai)
#pragma unroll
            for (int m = 0; m < 4; ++m) {
                const int row = row0 + ai * HALF + m * 16;
                const int t = row & (SEQ - 1);
                const float rs = row_rstd_rt(g.ss, g.nss, row, g.invn);
                f16* prow = g.oh + (size_t)row * NP;
                float ssacc = 0.f;
#pragma unroll
                for (int bj = 0; bj < 2; ++bj) {
                    const f32x4 v0 = acc[ai][bj][m][0] * rs, v1 = acc[ai][bj][m][1] * rs;
                    int type, pcol;
                    float sc = 1.f;
                    if (pn < 6) { type = 0; pcol = 256 * pn + 128 * bj + 64 * (wc >> 1); if (pn < 2) sc = 0.125f * LOG2E; }
                    else if (pn == 6) {
                        if (bj == 0) { type = 0; pcol = PC_KA + 64 * (wc >> 1); }
                        else if (wc == 0) { type = 1; pcol = PC_KR; }
                        else if (wc < 3) { type = 2; pcol = PC_VA + 32 * (wc - 1); }
                        else { type = 3; pcol = 0; }
                    } else if (pn == 7) { type = 2; pcol = PC_CQ + 128 * bj + 32 * wc; }
                    else if (pn == 8) { if (bj == 0) { type = 2; pcol = PC_CQ + 256 + 32 * wc; } else { type = 4; pcol = 0; } }
                    else { type = 2; pcol = PC_CKV + 128 * bj + 32 * wc; }
                    if (type == 0) {
                        const int g2 = wc & 1;
                        const f32x4 c4 = *(const f32x4*)(g.cos64 + t * 32 + 16 * g2 + 4 * fq), s4 = *(const f32x4*)(g.sin64 + t * 32 + 16 * g2 + 4 * fq);
                        const f32x4 o1 = (v0 * c4 - v1 * s4) * sc, o2 = (v0 * s4 + v1 * c4) * sc;
                        u32x2 w1; w1.x = pkh(o1[0], o1[1]); w1.y = pkh(o1[2], o1[3]);
                        u32x2 w2; w2.x = pkh(o2[0], o2[1]); w2.y = pkh(o2[2], o2[3]);
                        *(u32x2*)(prow + pcol + 16 * g2 + 4 * fq) = w1;
                        *(u32x2*)(prow + pcol + 32 + 16 * g2 + 4 * fq) = w2;
                    } else if (type == 1) {
                        const f32x4 c4 = *(const f32x4*)(g.cos32 + t * 16 + 4 * fq), s4 = *(const f32x4*)(g.sin32 + t * 16 + 4 * fq);
                        const f32x4 o1 = v0 * c4 - v1 * s4, o2 = v0 * s4 + v1 * c4;
                        u32x2 w1; w1.x = pkh(o1[0], o1[1]); w1.y = pkh(o1[2], o1[3]);
                        u32x2 w2; w2.x = pkh(o2[0], o2[1]); w2.y = pkh(o2[2], o2[3]);
                        *(u32x2*)(prow + pcol + 4 * fq) = w1;
                        *(u32x2*)(prow + pcol + 16 + 4 * fq) = w2;
                    } else if (type == 2) {
                        u32x4 w; w.x = pkh(v0[0], v0[1]); w.y = pkh(v0[2], v0[3]); w.z = pkh(v1[0], v1[1]); w.w = pkh(v1[2], v1[3]);
                        *(u32x4*)(prow + pcol + 8 * fq) = w;
                        ssacc += sq4(v0) + sq4(v1);
                    } else if (type == 3) {
                        *(f32x4*)(g.wi + (size_t)row * 16 + 4 * fq) = v0;
                    }
                }
                if (pn >= 7) {
                    ssacc += __shfl_xor(ssacc, 16); ssacc += __shfl_xor(ssacc, 32);
                    if (fq == 0) {
                        if (pn == 7) g.ssq[(size_t)row * 8 + wc] = ssacc;
                        else if (pn == 8) g.ssq[(size_t)row * 8 + 4 + wc] = ssacc;
                        else g.sskv[(size_t)row * 4 + wc] = ssacc;
                    }
                }
            }
    } else if (g.epi == EPI_QUP) {
        const float c2b = 0.10206207261596577f * LOG2E;
#pragma unroll
        for (int ai = 0; ai < 2; ++ai)
#pragma unroll
            for (int m = 0; m < 4; ++m) {
                const int row = row0 + ai * HALF + m * 16;
                const int t = row & (SEQ - 1);
                const float rs = row_rstd<8>(g.ss, row, g.invn) * c2b;
                f16* prow = g.oh + (size_t)row * NQB;
#pragma unroll
                for (int bj = 0; bj < 2; ++bj) {
                    const f32x4 v0 = acc[ai][bj][m][0] * rs, v1 = acc[ai][bj][m][1] * rs;
                    if (u.pn < 2) {
                        u32x4 w; w.x = pkh(v0[0], v0[1]); w.y = pkh(v0[2], v0[3]); w.z = pkh(v1[0], v1[1]); w.w = pkh(v1[2], v1[3]);
                        *(u32x4*)(prow + 256 * u.pn + 128 * bj + 32 * wc + 8 * fq) = w;
                    } else {
                        const int head = 4 * bj + wc;
                        const f32x4 c4 = *(const f32x4*)(g.cos32 + t * 16 + 4 * fq), s4 = *(const f32x4*)(g.sin32 + t * 16 + 4 * fq);
                        const f32x4 o1 = v0 * c4 - v1 * s4, o2 = v0 * s4 + v1 * c4;
                        u32x2 w1; w1.x = pkh(o1[0], o1[1]); w1.y = pkh(o1[2], o1[3]);
                        u32x2 w2; w2.x = pkh(o2[0], o2[1]); w2.y = pkh(o2[2], o2[3]);
                        *(u32x2*)(prow + 512 + 32 * head + 4 * fq) = w1;
                        *(u32x2*)(prow + 512 + 32 * head + 16 + 4 * fq) = w2;
                    }
                }
            }
    } else {
#pragma unroll
        for (int ai = 0; ai < 2; ++ai)
#pragma unroll
            for (int m = 0; m < 4; ++m) {
                const int row = row0 + ai * HALF + m * 16;
                const float rs = row_rstd<4>(g.ss, row, g.invn);
                f16* prow = g.oh + (size_t)row * NKV;
#pragma unroll
                for (int bj = 0; bj < 2; ++bj) {
                    const f32x4 v0 = acc[ai][bj][m][0] * rs, v1 = acc[ai][bj][m][1] * rs;
                    u32x4 w; w.x = pkh(v0[0], v0[1]); w.y = pkh(v0[2], v0[3]); w.z = pkh(v1[0], v1[1]); w.w = pkh(v1[2], v1[3]);
                    *(u32x4*)(prow + 256 * u.pn + 128 * bj + 32 * wc + 8 * fq) = w;
                }
            }
    }
}

__device__ __forceinline__ void gemm_phase(LAS unsigned char* lds, const Args& args, const int gi, const GemmDesc& g, const StaticOrder& S) {
    const int tid = opaque_tid(), wid = __builtin_amdgcn_readfirstlane(tid >> 6), lane = tid & 63, wr = wid >> 2, wc = wid & 3, fr = lane & 15, fq = lane >> 4;
    const int K = g.K, nt = K / BK, lda = g.lda;
    unsigned voffA[2], voffB[2];
#pragma unroll
    for (int i = 0; i < 2; ++i) { int R, C; stage_rc(tid * 16 + i * 8192, R, C);
        voffA[i] = (unsigned)(R * lda + C) * 2u; voffB[i] = (unsigned)(R * K + C) * 2u; }
    const size_t kstep = (size_t)(BK * 2);
    const size_t hstepA = (size_t)HALF * lda * 2, hstepB = (size_t)HALF * K * 2;
    const size_t tstepA = 2 * hstepA, tstepB = 2 * hstepB;
    const unsigned ldsw = (unsigned)wid * 1024u;
    const int aoff = lds_byte(wr * 64 + fr, fq * 8), boff = lds_byte(wc * 32 + fr, fq * 8);
#define PG8_SA(b, h) (((b) * 2 + (h)) * HTB)
#define PG8_SB(b, h) ((4 + (b) * 2 + (h)) * HTB)
#define PG8_STAGE(bufoff, gbase, voff) do { _Pragma("unroll") for (int _i = 0; _i < 2; ++_i) \
        __builtin_amdgcn_global_load_lds((const unsigned*)((const char*)(gbase) + (voff)[_i]), (LAS unsigned*)(lds + (bufoff) + ldsw + _i * 8192), 16, 0, 0); } while (0)
#define PG8_LDA(dst, b, h) do { _Pragma("unroll") for (int m = 0; m < 4; ++m) _Pragma("unroll") for (int k = 0; k < 2; ++k) dst[m][k] = *(const LAS h8*)(lds + PG8_SA(b, h) + aoff + m * 2048 + k * 1024); } while (0)
#define PG8_LDB(dst, b, h) do { _Pragma("unroll") for (int n = 0; n < 2; ++n) _Pragma("unroll") for (int k = 0; k < 2; ++k) dst[n][k] = *(const LAS h8*)(lds + PG8_SB(b, h) + boff + n * 2048 + k * 1024); } while (0)
#define PG8_MMA(ai, bj, At, Bt) do { __builtin_amdgcn_s_setprio(1); _Pragma("unroll") for (int m = 0; m < 4; ++m) _Pragma("unroll") for (int n = 0; n < 2; ++n) _Pragma("unroll") for (int k = 0; k < 2; ++k) \
        acc[ai][bj][m][n] = __builtin_amdgcn_mfma_f32_16x16x32_f16(Bt[n][k], At[m][k], acc[ai][bj][m][n], 0, 0, 0); __builtin_amdgcn_s_setprio(0); } while (0)
#define PG8_WAIT_V(n) asm volatile("s_waitcnt vmcnt(" #n ")" ::: "memory")
#define PG8_WAIT_L(n) asm volatile("s_waitcnt lgkmcnt(" #n ")" ::: "memory")
#define PG8_BAR __builtin_amdgcn_s_barrier()
#define PG8_SCHED __builtin_amdgcn_sched_barrier(0)
    Unit cur, nxt; int ui = 0;
    if (!S.next(0, cur)) return;
    f32x4 acc[2][2][4][2];
#pragma unroll
    for (int a = 0; a < 2; ++a)
#pragma unroll
        for (int b = 0; b < 2; ++b)
#pragma unroll
            for (int m = 0; m < 4; ++m)
#pragma unroll
                for (int n = 0; n < 2; ++n) acc[a][b][m][n] = (f32x4){0.f, 0.f, 0.f, 0.f};
    h8 At[4][2], B0[2][2], B1[2][2];
    const char* cA = (const char*)g.A + (size_t)cur.pm * tstepA; const char* cB = (const char*)g.Bt + (size_t)cur.pn * tstepB;
    PG8_STAGE(PG8_SB(0, 0), cB, voffB); PG8_STAGE(PG8_SB(0, 1), cB + hstepB, voffB); PG8_STAGE(PG8_SA(0, 0), cA, voffA); PG8_STAGE(PG8_SA(0, 1), cA + hstepA, voffA);
    if (wr == 1) PG8_BAR;
    PG8_WAIT_V(2); PG8_BAR;
    PG8_STAGE(PG8_SB(1, 0), cB + kstep, voffB); PG8_STAGE(PG8_SA(1, 0), cA + kstep, voffA); PG8_STAGE(PG8_SB(1, 1), cB + hstepB + kstep, voffB);
    PG8_WAIT_V(6); PG8_BAR;
    for (;;) {
        const bool has_next = S.next(ui + 1, nxt);
        const char* nA = has_next ? (const char*)g.A + (size_t)nxt.pm * tstepA : cA; const char* nB = has_next ? (const char*)g.Bt + (size_t)nxt.pn * tstepB : cB;
        for (int t = 0; t < nt; t += 2) {
            const bool last = (t == nt - 2);
            const char* a1 = cA + (size_t)(t + 1) * kstep;
            const char* a2 = last ? nA : cA + (size_t)(t + 2) * kstep; const char* b2 = last ? nB : cB + (size_t)(t + 2) * kstep;
            const char* a3 = a2 + kstep; const char* b3 = b2 + kstep;
            PG8_LDB(B0, 0, 0); PG8_LDB(B1, 0, 1); PG8_SCHED; PG8_LDA(At, 0, 0); PG8_STAGE(PG8_SA(1, 1), a1 + hstepA, voffA);
            PG8_WAIT_V(8); PG8_WAIT_L(0); PG8_BAR; PG8_MMA(0, 0, At, B0); PG8_MMA(0, 1, At, B1); PG8_BAR; PG8_SCHED;
            PG8_LDA(At, 0, 1); PG8_STAGE(PG8_SB(0, 0), b2, voffB); PG8_STAGE(PG8_SB(0, 1), b2 + hstepB, voffB); PG8_STAGE(PG8_SA(0, 0), a2, voffA);
            PG8_WAIT_V(8); PG8_WAIT_L(0); PG8_BAR; PG8_MMA(1, 0, At, B0); PG8_MMA(1, 1, At, B1); PG8_BAR; PG8_SCHED;
            PG8_LDB(B0, 1, 0); PG8_LDB(B1, 1, 1); PG8_SCHED; PG8_LDA(At, 1, 0); PG8_STAGE(PG8_SA(0, 1), a2 + hstepA, voffA);
            PG8_WAIT_V(8); PG8_WAIT_L(0); PG8_BAR; PG8_MMA(0, 0, At, B0); PG8_MMA(0, 1, At, B1); PG8_BAR; PG8_SCHED;
            PG8_LDA(At, 1, 1); PG8_STAGE(PG8_SB(1, 0), b3, voffB); PG8_STAGE(PG8_SB(1, 1), b3 + hstepB, voffB); PG8_STAGE(PG8_SA(1, 0), a3, voffA);
            PG8_WAIT_V(8); PG8_WAIT_L(0); PG8_BAR; PG8_MMA(1, 0, At, B0); PG8_MMA(1, 1, At, B1); PG8_BAR; PG8_SCHED;
        }
        if (wr == 0) PG8_BAR;
        epilogue(args, gi, acc, cur, wr, wc, fr, fq);
        if (!has_next) break;
#pragma unroll
        for (int a = 0; a < 2; ++a)
#pragma unroll
            for (int b = 0; b < 2; ++b)
#pragma unroll
                for (int m = 0; m < 4; ++m)
#pragma unroll
                    for (int n = 0; n < 2; ++n) acc[a][b][m][n] = (f32x4){0.f, 0.f, 0.f, 0.f};
        cur = nxt; cA = nA; cB = nB; ++ui;
        if (wr == 1) PG8_BAR;
    }
    PG8_WAIT_V(0);
    PG8_BAR;
#undef PG8_SA
#undef PG8_SB
#undef PG8_STAGE
#undef PG8_LDA
#undef PG8_LDB
#undef PG8_MMA
#undef PG8_WAIT_V
#undef PG8_WAIT_L
#undef PG8_BAR
#undef PG8_SCHED
}
__device__ __forceinline__ void make_gemm(const Args& a, int gi, GemmDesc& g) {
    unsigned char* ws = a.ws; const float* ax = a.x; float* aout = a.out;
    asm volatile("" : "+s"(ws), "+s"(ax), "+s"(aout));
    float* rope = (float*)(ws + WS_ROPE);
    g.M = M; g.ss = nullptr; g.nss = 1; g.invn = 1.f / DM; g.oh = nullptr; g.ldo = 0; g.xin = nullptr; g.xout = nullptr; g.xh = nullptr; g.ssout = nullptr; g.rscale = 1.f;
    g.cos64 = rope; g.sin64 = rope + SEQ * 32; g.cos32 = rope + SEQ * 64; g.sin32 = rope + SEQ * 64 + SEQ * 16;
    g.wi = (float*)(ws + WS_WI); g.ssq = (float*)(ws + WS_SSQ); g.sskv = (float*)(ws + WS_SSKV);
    switch (gi) {
        case G_FFN1A: g.A = (const f16*)(ws + WS_XH); g.Bt = (const f16*)(ws + WS_BT1); g.N = NFF; g.K = DM; g.lda = DM; g.epi = EPI_SWIGLU;
            g.ss = (const float*)(ws + WS_SS0); g.nss = 1; g.oh = (f16*)(ws + WS_H); break;
        case G_FFN1B: g.A = (const f16*)(ws + WS_H); g.Bt = (const f16*)(ws + WS_BTD1); g.N = DM; g.K = DFF; g.lda = DFF; g.epi = EPI_RESID;
            g.xin = ax; g.xout = aout; g.xh = (f16*)(ws + WS_XH); g.ssout = (float*)(ws + WS_SS16); g.rscale = 0.5f; break;
        case G_WIN: g.A = (const f16*)(ws + WS_XH); g.Bt = (const f16*)(ws + WS_BTIN); g.N = NP; g.K = DM; g.lda = DM; g.epi = EPI_WIN;
            g.ss = (const float*)(ws + WS_SS16); g.nss = 16; g.oh = (f16*)(ws + WS_P); break;
        case G_QUP: g.A = (const f16*)(ws + WS_P) + PC_CQ; g.Bt = (const f16*)(ws + WS_BTQ); g.N = NQB; g.K = QLORA; g.lda = NP; g.epi = EPI_QUP;
            g.ss = (const float*)(ws + WS_SSQ); g.nss = 8; g.invn = 1.f / QLORA; g.oh = (f16*)(ws + WS_QB); break;
        case G_KVUP: g.A = (const f16*)(ws + WS_P) + PC_CKV; g.Bt = (const f16*)(ws + WS_BTKV); g.N = NKV; g.K = KVLORA; g.lda = NP; g.epi = EPI_KVUP;
            g.ss = (const float*)(ws + WS_SSKV); g.nss = 4; g.invn = 1.f / KVLORA; g.oh = (f16*)(ws + WS_KV); break;
        case G_WOUT: g.A = (const f16*)(ws + WS_MIX); g.Bt = (const f16*)(ws + WS_BTOUT); g.N = DM; g.K = DM; g.lda = DM; g.epi = EPI_RESID;
            g.xin = aout; g.xout = aout; g.xh = (f16*)(ws + WS_XH); g.ssout = (float*)(ws + WS_SS16); g.rscale = 1.f; break;
        case G_FFN2A: g.A = (const f16*)(ws + WS_XH); g.Bt = (const f16*)(ws + WS_BT2); g.N = NFF; g.K = DM; g.lda = DM; g.epi = EPI_SWIGLU;
            g.ss = (const float*)(ws + WS_SS16); g.nss = 16; g.oh = (f16*)(ws + WS_H); break;
        default: g.A = (const f16*)(ws + WS_H); g.Bt = (const f16*)(ws + WS_BTD2); g.N = DM; g.K = DFF; g.lda = DFF; g.epi = EPI_RESID;
            g.xin = aout; g.xout = aout; g.xh = (f16*)(ws + WS_XH); g.ssout = (float*)(ws + WS_SS16); g.rscale = 0.5f; break;
    }
}

}

struct Frame {
    LAS unsigned char* lds;
    int tid, lane, wave, vcu, G;
};

__device__ __forceinline__ bool prep_rowmap(const Args& a, int mat, int R, const float*& W, int& col, int& N) {
    using pg8::perm32;
    switch (mat) {
        case 0: case 2: { const int G = R >> 5, s = R & 31, n = s >> 4, j = s & 15; col = 16 * G + j; N = DFF;
            W = (mat == 0) ? (n ? a.w1_up : a.w1_gate) : (n ? a.w2_up : a.w2_gate); return true; }
        case 1: W = a.w1_down; col = R; N = DM; return true;
        case 3: W = a.w2_down; col = R; N = DM; return true;
        case 4: { W = a.w_in; N = DPROJ;
            if (R < PC_KR) {
                int base, rr;
                if (R < PC_QI) { base = WC_QA; rr = R; } else if (R < PC_KA) { base = WC_QI; rr = R - PC_QI; } else if (R < PC_KI) { base = WC_KA; rr = R - PC_KA; } else { base = WC_KI; rr = R - PC_KI; }
                const int h = rr >> 6, w = rr & 63, g2 = w >> 5, n = (w >> 4) & 1, j = w & 15;
                col = base + h * 64 + 32 * n + 16 * g2 + j; return true; }
            if (R < PC_VA) { col = WC_KR + (R - PC_KR); return true; }
            if (R < PC_WI) { const int rr = R - PC_VA; col = WC_VA + (rr & ~31) + perm32(rr & 31); return true; }
            if (R < PC_WI + 16) { col = WC_WI + (R - PC_WI); return true; }
            if (R < PC_CQ) return false;
            if (R < PC_CQ + QLORA) { const int rr = R - PC_CQ; col = WC_CQ + (rr & ~31) + perm32(rr & 31); return true; }
            if (R < PC_CKV) return false;
            { const int rr = R - PC_CKV; col = WC_CKV + (rr & ~31) + perm32(rr & 31); return true; } }
        case 5: { W = a.w_uq; N = 768;
            if (R < 512) { const int Rp = (R & ~31) + perm32(R & 31); col = (Rp >> 6) * 96 + (Rp & 63); }
            else { const int rr = R - 512; col = (rr >> 5) * 96 + 64 + (rr & 31); }
            return true; }
        case 6: { W = a.w_ukv; N = 1024;
            const int rr = R & 511, Rp = (rr & ~31) + perm32(rr & 31);
            col = (Rp >> 6) * 128 + (R >= 512 ? 64 : 0) + (Rp & 63); return true; }
        default: W = a.w_out; col = R; N = DM; return true;
    }
}
__device__ __forceinline__ void prep_item(const Args& a, int mat, int K, const float* gain, f16* Bt, LAS float* scr, int item, int lane) {
    const int nkb = K / 64, rb = item / nkb, kb = item % nkb, k0 = 64 * kb, R0 = 32 * rb;
    const float* W; int col, N;
    const bool valid = prep_rowmap(a, mat, R0 + (lane & 31), W, col, N);
#pragma unroll 8
    for (int i = 0; i < 32; ++i) { const int kk = 2 * i + (lane >> 5);
        float v = 0.f; if (valid) { v = W[(size_t)(k0 + kk) * N + col]; if (gain) v *= gain[k0 + kk]; }
        scr[kk * 33 + (lane & 31)] = v; }
    LDS_WAIT(); asm volatile("" ::: "memory");
    const int c = lane & 7;
#pragma unroll
    for (int j = 0; j < 4; ++j) { const int n = (lane >> 3) + 8 * j; const LAS float* s = scr + (8 * c) * 33 + n;
        u32x4 o; o.x = pkh(s[0 * 33], s[1 * 33]); o.y = pkh(s[2 * 33], s[3 * 33]); o.z = pkh(s[4 * 33], s[5 * 33]); o.w = pkh(s[6 * 33], s[7 * 33]);
        *(u32x4*)(Bt + (size_t)(R0 + n) * K + k0 + 8 * c) = o; }
    LDS_WAIT(); asm volatile("" ::: "memory");
}

__device__ __forceinline__ void prep_phase(const Args& a, Frame& F) {
    unsigned char* ws = a.ws;
    LAS float* scr = (LAS float*)(F.lds + F.wave * 16384);
    const int gw = F.vcu * NWAVES + F.wave, NGW = F.G * NWAVES;
    constexpr int I0 = 16 * (NFF / 32), I1 = (DFF / 64) * 32, I4 = 16 * (NP / 32), I5 = (QLORA / 64) * (NQB / 32), I6 = (KVLORA / 64) * (NKV / 32), I7 = 16 * 32;
    constexpr int NITEMS = 2 * I0 + 2 * I1 + I4 + I5 + I6 + I7;
    for (int it = gw; it < NITEMS; it += NGW) {
        int r = it;
        if (r < I0) { prep_item(a, 0, DM, a.g_ffn1, (f16*)(ws + WS_BT1), scr, r, F.lane); continue; } r -= I0;
        if (r < I1) { prep_item(a, 1, DFF, nullptr, (f16*)(ws + WS_BTD1), scr, r, F.lane); continue; } r -= I1;
        if (r < I0) { prep_item(a, 2, DM, a.g_ffn2, (f16*)(ws + WS_BT2), scr, r, F.lane); continue; } r -= I0;
        if (r < I1) { prep_item(a, 3, DFF, nullptr, (f16*)(ws + WS_BTD2), scr, r, F.lane); continue; } r -= I1;
        if (r < I4) { prep_item(a, 4, DM, a.g_mix, (f16*)(ws + WS_BTIN), scr, r, F.lane); continue; } r -= I4;
        if (r < I5) { prep_item(a, 5, QLORA, a.g_q_lat, (f16*)(ws + WS_BTQ), scr, r, F.lane); continue; } r -= I5;
        if (r < I6) { prep_item(a, 6, KVLORA, a.g_kv_lat, (f16*)(ws + WS_BTKV), scr, r, F.lane); continue; } r -= I6;
        prep_item(a, 7, DM, nullptr, (f16*)(ws + WS_BTOUT), scr, r, F.lane);
    }
    {
        f16* XH = (f16*)(ws + WS_XH); float* SS0 = (float*)(ws + WS_SS0);
        for (int m = gw; m < M; m += NGW) {
            const f32x4* xr = (const f32x4*)(a.x + (size_t)m * DM) + F.lane;
            f32x4 v[4]; float s = 0.f;
#pragma unroll
            for (int j = 0; j < 4; ++j) { v[j] = xr[64 * j]; s += sq4(v[j]); }
            s = wave_sum(s);
            u32x2* o8 = (u32x2*)(XH + (size_t)m * DM) + F.lane;
#pragma unroll
            for (int j = 0; j < 4; ++j) { u32x2 w; w.x = pkh(v[j].x, v[j].y); w.y = pkh(v[j].z, v[j].w); o8[64 * j] = w; }
            if (F.lane == 0) SS0[m] = s;
        }
    }
    {
        float* c64 = (float*)(ws + WS_ROPE); float* s64 = c64 + SEQ * 32; float* c32 = s64 + SEQ * 32; float* s32 = c32 + SEQ * 16;
        const int gt = (F.vcu * NWAVES + F.wave) * 64 + F.lane, NT = F.G * NWAVES * 64;
        for (int e = gt; e < SEQ * 48; e += NT) {
            const int t = e / 48, j = e % 48;
            const double ex = (j < 32) ? -(double)(2 * j) / 64.0 : -(double)(2 * (j - 32)) / 32.0;
            const double xx = ex * 13.287712379549449;
            const double nf = __builtin_floor(xx), ff = (xx - nf) * 0.69314718055994530942;
            double pe = 1.0 / 1307674368000.0;
#pragma unroll
            for (int kk = 14; kk >= 1; --kk) { double fact = 1.0; for (int q2 = 2; q2 <= kk; ++q2) fact *= (double)q2; pe = pe * ff + 1.0 / fact; }
            pe = pe * ff + 1.0;
            const float inv = (float)__builtin_ldexp(pe, (int)nf);
            const float angf = (float)t * inv;
            const double ang = (double)angf;
            const double kq = __builtin_rint(ang * 0.63661977236758134308);
            double r = __builtin_fma(-kq, 1.57079632679489655800, ang);
            r = __builtin_fma(-kq, 6.12323399573676603587e-17, r);
            const double r2 = r * r;
            double sn = -1.0 / 6227020800.0; sn = sn * r2 + 1.0 / 39916800.0; sn = sn * r2 - 1.0 / 362880.0; sn = sn * r2 + 1.0 / 5040.0; sn = sn * r2 - 1.0 / 120.0; sn = sn * r2 + 1.0 / 6.0; sn = -sn * r2 * r + r;
            double cs = 1.0 / 479001600.0; cs = cs * r2 - 1.0 / 3628800.0; cs = cs * r2 + 1.0 / 40320.0; cs = cs * r2 - 1.0 / 720.0; cs = cs * r2 + 1.0 / 24.0; cs = cs * r2 - 0.5; cs = cs * r2 + 1.0;
            const int q = ((int)kq) & 3;
            const double S = (q == 0) ? sn : (q == 1) ? cs : (q == 2) ? -sn : -cs;
            const double C = (q == 0) ? cs : (q == 1) ? -sn : (q == 2) ? -cs : sn;
            if (j < 32) { c64[t * 32 + j] = (float)C; s64[t * 32 + j] = (float)S; }
            else { c32[t * 16 + (j - 32)] = (float)C; s32[t * 16 + (j - 32)] = (float)S; }
        }
    }
}


namespace att {
constexpr int KSL = 12288, VSL = 8192, SLOT = KSL + VSL;
constexpr int WSF_OFF = 2 * SLOT, OST_OFF = WSF_OFF + 2048, ATT_LDS = OST_OFF + 8 * 4096;
static_assert(ATT_LDS <= RING_BYTES, "attention LDS");
typedef short v4i16_t __attribute__((ext_vector_type(4)));
__device__ __forceinline__ int crow(int r, int hi) { return (r & 3) + 8 * (r >> 2) + 4 * hi; }
__device__ __forceinline__ h4 vtr(const LAS unsigned char* p) { return __builtin_bit_cast(h4, __builtin_amdgcn_ds_read_tr16_b64_v4i16((LAS v4i16_t*)p)); }
__device__ __forceinline__ float hmax2(float a) { return fmaxf(a, __shfl_xor(a, 32)); }
__device__ __forceinline__ float hsum2(float a) { return a + __shfl_xor(a, 32); }
#define ATT_BAR() asm volatile("s_waitcnt vmcnt(0) lgkmcnt(0)\n\ts_barrier" ::: "memory")

template <int MODE>
__device__ __forceinline__ void attn_unit(const Args& a, LAS unsigned char* lds, int b, int h, int q0) {
    constexpr int ND = (MODE == 0) ? 6 : 4;
    constexpr float THR = 8.f;
    unsigned char* ws = a.ws; asm volatile("" : "+s"(ws));
    const f16* P = (const f16*)(ws + WS_P); const f16* QB = (const f16*)(ws + WS_QB); const f16* KV = (const f16*)(ws + WS_KV); f16* MIX = (f16*)(ws + WS_MIX);
    const unsigned* MASK = (const unsigned*)(ws + WS_MASK);
    const int tid = opaque_tid(), lane = tid & 63, r32 = lane & 31, hi = lane >> 5; const int w = __builtin_amdgcn_readfirstlane(tid >> 6);
    const size_t rowbase = (size_t)b * SEQ;
    const int qw = (MODE == 0) ? q0 + 32 * w : q0;
    const int NT = (MODE == 0) ? (q0 + 256) / 64 : (q0 + 32 + 63) / 64;
    LAS float* wsf = (LAS float*)(lds + WSF_OFF) + w * 64;
    auto dma = [&](int t, int s) {
        LAS unsigned char* ks = lds + s * SLOT; LAS unsigned char* vs = ks + KSL;
        const size_t krow = rowbase + 64 * t + lane, vrow = rowbase + 64 * t + 16 * (w & 3) + (lane >> 2);
        if (MODE == 0) {
            __builtin_amdgcn_global_load_lds((const unsigned*)(KV + krow * NKV + h * 64 + 8 * w), (LAS unsigned*)(ks + w * 1024), 16, 0, 0);
            if (w < 4) __builtin_amdgcn_global_load_lds((const unsigned*)(P + krow * NP + PC_KR + 8 * w), (LAS unsigned*)(ks + (8 + w) * 1024), 16, 0, 0);
            __builtin_amdgcn_global_load_lds((const unsigned*)(KV + vrow * NKV + 512 + h * 64 + (w >> 2) * 32 + (lane & 3) * 8), (LAS unsigned*)(vs + w * 1024), 16, 0, 0);
        } else {
            __builtin_amdgcn_global_load_lds((const unsigned*)(P + krow * NP + PC_KA + 8 * w), (LAS unsigned*)(ks + w * 1024), 16, 0, 0);
            __builtin_amdgcn_global_load_lds((const unsigned*)(P + vrow * NP + PC_VA + (w >> 2) * 32 + (lane & 3) * 8), (LAS unsigned*)(vs + w * 1024), 16, 0, 0);
        }
    };
    dma(0, 0);
    h8 qr[ND];
    if (MODE == 0) {
        const f16* qp = QB + (rowbase + qw + r32) * NQB;
#pragma unroll
        for (int d0 = 0; d0 < 4; ++d0) qr[d0] = *(const h8*)(qp + h * 64 + 16 * d0 + 8 * hi);
#pragma unroll
        for (int d0 = 4; d0 < ND; ++d0) qr[d0] = *(const h8*)(qp + 512 + h * 32 + 16 * (d0 - 4) + 8 * hi);
    } else {
        const f16* qp = P + (rowbase + qw + r32) * NP + PC_QA + w * 64;
#pragma unroll
        for (int d0 = 0; d0 < ND; ++d0) qr[d0] = *(const h8*)(qp + 16 * d0 + 8 * hi);
    }
    const unsigned* mp = MASK + ((rowbase + qw + r32) * 2 + hi) * 64;
    unsigned mw_next = (MODE == 1) ? mp[0] : 0u;
    float mhat = -1e30f, lsum = 0.f;
    f32x16 o[2]; o[0] = f32x16{}; o[1] = f32x16{};
    const int vp0 = ((lane >> 4) & 1) * 32 + (lane & 3) * 8 + (4 * hi + ((lane & 15) >> 2)) * 64;
    for (int t = 0; t < NT; ++t) {
        ATT_BAR();
        if (t + 1 < NT) dma(t + 1, (t + 1) & 1);
        const unsigned mw = mw_next;
        if (MODE == 1 && t + 1 < NT) mw_next = mp[t + 1];
        if (MODE == 1 || 64 * t <= qw + 31) {
            const LAS unsigned char* ks = lds + (t & 1) * SLOT + hi * 1024 + r32 * 16; const LAS unsigned char* vs = lds + (t & 1) * SLOT + KSL + vp0;
            f32x16 p0 = f32x16{}, p1 = f32x16{};
#pragma unroll
            for (int d0 = 0; d0 < ND; ++d0) {
                const h8 b0 = *(const LAS h8*)(ks + d0 * 2048), b1 = *(const LAS h8*)(ks + d0 * 2048 + 512);
                p0 = __builtin_amdgcn_mfma_f32_32x32x16_f16(b0, qr[d0], p0, 0, 0, 0);
                p1 = __builtin_amdgcn_mfma_f32_32x32x16_f16(b1, qr[d0], p1, 0, 0, 0);
            }
            if (MODE == 0 && 64 * t + 63 > qw) {
                const int qrow = qw + r32, kb = 64 * t + 4 * hi;
#pragma unroll
                for (int r = 0; r < 16; ++r) { const int kv = kb + (r & 3) + 8 * (r >> 2); if (kv > qrow) p0[r] = -INFINITY; if (kv + 32 > qrow) p1[r] = -INFINITY; }
            }
            float rm = fmaxf(p0[0], p1[0]);
#pragma unroll
            for (int r = 1; r < 16; ++r) rm = fmaxf(rm, fmaxf(p0[r], p1[r]));
            rm = hmax2(rm);
            if (__any(rm > mhat + THR)) {
                const float mnew = fmaxf(mhat, rm), f = __builtin_amdgcn_exp2f(mhat - mnew);
                lsum *= f; mhat = mnew;
                if (hi == 0) wsf[r32] = f;
                LDS_WAIT();
#pragma unroll
                for (int r = 0; r < 16; ++r) { const float fr_ = wsf[crow(r, hi)]; o[0][r] *= fr_; o[1][r] *= fr_; }
                LDS_WAIT();
            }
#pragma unroll
            for (int r = 0; r < 16; ++r) { p0[r] = __builtin_amdgcn_exp2f(p0[r] - mhat); p1[r] = __builtin_amdgcn_exp2f(p1[r] - mhat); }
            if (MODE == 1) {
#pragma unroll
                for (int r = 0; r < 16; ++r) {
                    p0[r] = ((mw >> (15 - r)) & 1u) ? p0[r] : 0.f;
                    p1[r] = ((mw >> (31 - r)) & 1u) ? p1[r] : 0.f;
                }
            }
            float sacc = 0.f;
#pragma unroll
            for (int r = 0; r < 16; ++r) sacc += p0[r] + p1[r];
            lsum += sacc;
            h8 pa[4];
#pragma unroll
            for (int j = 0; j < 8; ++j) { pa[0][j] = (f16)p0[j]; pa[1][j] = (f16)p0[8 + j]; pa[2][j] = (f16)p1[j]; pa[3][j] = (f16)p1[8 + j]; }
#pragma unroll
            for (int d0 = 0; d0 < 2; ++d0)
#pragma unroll
                for (int k4 = 0; k4 < 4; ++k4) {
                    const h4 lo = vtr(vs + d0 * 4096 + k4 * 1024), hi4 = vtr(vs + d0 * 4096 + k4 * 1024 + 512);
                    const h8 vf = {lo[0], lo[1], lo[2], lo[3], hi4[0], hi4[1], hi4[2], hi4[3]};
                    o[d0] = __builtin_amdgcn_mfma_f32_32x32x16_f16(pa[k4], vf, o[d0], 0, 0, 0);
                }
        }
    }
    lsum = hsum2(lsum);
    if (hi == 0) wsf[32 + r32] = lsum;
    LDS_WAIT();
    float rli[16];
#pragma unroll
    for (int r = 0; r < 16; ++r) { const float lv = wsf[32 + crow(r, hi)]; rli[r] = lv > 0.f ? __builtin_amdgcn_rcpf(lv) : 0.f; }
    if (MK_DEBUG && hi == 0 && !(lsum > 0.f)) atomicAdd((unsigned*)(ws + WS_CTL) + 27, 1u);
    LAS f16* stg = (LAS f16*)(lds + OST_OFF) + w * 2048;
#pragma unroll
    for (int r = 0; r < 16; ++r) { const int orow = crow(r, hi);
#pragma unroll
        for (int d0 = 0; d0 < 2; ++d0) stg[orow * 64 + d0 * 32 + r32] = (f16)(o[d0][r] * rli[r]); }
    LDS_WAIT();
    f16* Ow = MIX + (rowbase + qw) * DM + ((MODE == 0) ? 512 + h * 64 : w * 64);
#pragma unroll
    for (int i = 0; i < 4; ++i) { const int row = i * 8 + (lane >> 3), ch = lane & 7; const u32x4 v = *(const LAS u32x4*)(stg + row * 64 + ch * 8); *(u32x4*)(Ow + (size_t)row * DM + ch * 8) = v; }
    ATT_BAR();
}

template <int MODE> __device__ __forceinline__ void attn_phase(const Args& a, Frame& F) {
    for (int k = F.vcu; k < 1024; k += F.G) {
        const int i = k >> 8, c = k & 255;
        if (MODE == 0) { const int bh = c >> 2, j = c & 3; const int qb = (i == 0) ? j : (i == 1) ? 7 - j : (i == 2) ? 8 + j : 15 - j;
            attn_unit<0>(a, F.lds, bh >> 3, bh & 7, qb * 256); }
        else { const int b = c >> 5, j = c & 31; const int u = (i == 0) ? j : (i == 1) ? 63 - j : (i == 2) ? 64 + j : 127 - j;
            attn_unit<1>(a, F.lds, b, 0, u * 32); }
    }
}
}


namespace idx {
constexpr int QL_OFF = 0;
constexpr int HIST_OFF = 69632;
constexpr int SEL_OFF = HIST_OFF, CAND_OFF = HIST_OFF + 16384;
constexpr int NH_OFF = 102400;
constexpr int QP_OFF = 104448;
constexpr int WSC_OFF = 105472;
constexpr int NCAP = 512;
static_assert(WSC_OFF + 8 * 3072 <= RING_BYTES, "indexer LDS");
constexpr float IDX_SCALE = 0.03125f;
using att::crow;
#define IDX_BAR() asm volatile("s_waitcnt vmcnt(0) lgkmcnt(0)\n\ts_barrier" ::: "memory")
__device__ __forceinline__ unsigned ordu(float f) { const unsigned u = __builtin_bit_cast(unsigned, f); return (u & 0x80000000u) ? ~u : (u | 0x80000000u); }

__device__ __forceinline__ void chunk_scores(const f16* Pk, const LAS unsigned char* QL, const LAS float* WH, int r32, int hi, f32x16 (&acc)[4]) {
    h8 kf[4][4];
#pragma unroll
    for (int kt = 0; kt < 4; ++kt)
#pragma unroll
        for (int ks = 0; ks < 4; ++ks) kf[kt][ks] = *(const h8*)(Pk + (size_t)(32 * kt + r32) * NP + 16 * ks + 8 * hi);
    const LAS unsigned char* qb = QL + (hi * 32 + r32) * 16;
    {
        h8 qf[4];
#pragma unroll
        for (int ks = 0; ks < 4; ++ks) qf[ks] = *(const LAS h8*)(qb + (16 * 8 + 2 * ks) * 512);
#pragma unroll
        for (int kt = 0; kt < 4; ++kt) { f32x16 x = f32x16{};
#pragma unroll
            for (int ks = 0; ks < 4; ++ks) x = __builtin_amdgcn_mfma_f32_32x32x16_f16(kf[kt][ks], qf[ks], x, 0, 0, 0);
            acc[kt] = x; }
    }
#pragma unroll 1
    for (int h = 0; h < 16; ++h) {
        h8 qf[4];
#pragma unroll
        for (int ks = 0; ks < 4; ++ks) qf[ks] = *(const LAS h8*)(qb + (h * 8 + 2 * ks) * 512);
        const float wv = WH[h * 32 + r32];
#pragma unroll
        for (int kt = 0; kt < 4; ++kt) { f32x16 x = f32x16{};
#pragma unroll
            for (int ks = 0; ks < 4; ++ks) x = __builtin_amdgcn_mfma_f32_32x32x16_f16(kf[kt][ks], qf[ks], x, 0, 0, 0);
#pragma unroll
            for (int r = 0; r < 16; ++r) acc[kt][r] = __builtin_fmaf(__builtin_fabsf(x[r]), wv, acc[kt][r]); }
    }
}

__device__ __forceinline__ void idx_unit(const Args& a, LAS unsigned char* lds, int b, int u) {
    unsigned char* ws = a.ws; asm volatile("" : "+s"(ws));
    const f16* P = (const f16*)(ws + WS_P); const float* WI = (const float*)(ws + WS_WI); unsigned* MASK = (unsigned*)(ws + WS_MASK);
    const int tid = opaque_tid(), lane = tid & 63, r32 = lane & 31, hi = lane >> 5; const int w = __builtin_amdgcn_readfirstlane(tid >> 6);
    const size_t rowbase = (size_t)b * SEQ; const int q0 = 32 * u, nch = (u >> 2) + 1; const bool selneeded = (u >= 8);
    LAS unsigned char* QL = lds + QL_OFF; LAS unsigned* HIST = (LAS unsigned*)(lds + HIST_OFF); LAS unsigned* SEL = (LAS unsigned*)(lds + SEL_OFF); LAS unsigned* CAND = (LAS unsigned*)(lds + CAND_OFF);
    LAS float* NH = (LAS float*)(lds + NH_OFF); LAS float* QP = (LAS float*)(lds + QP_OFF);
#pragma unroll
    for (int i = 0; i < 8; ++i) { const int p = w * 8 + i, hh = p >> 2, c = 2 * (p & 3) + (lane >> 5);
        __builtin_amdgcn_global_load_lds((const unsigned*)(P + (rowbase + q0 + r32) * NP + PC_QI + hh * 64 + c * 8), (LAS unsigned*)(QL + p * 1024), 16, 0, 0); }
#pragma unroll
    for (int i = 0; i < 4; ++i) *(LAS u32x4*)(lds + HIST_OFF + (i * 512 + tid) * 16) = (u32x4){0u, 0u, 0u, 0u};
    IDX_BAR();
    { const int q = tid & 31, hh = tid >> 5; float s = 0.f;
#pragma unroll
        for (int c = 0; c < 8; ++c) { const h8 v = *(const LAS h8*)(QL + ((hh * 8 + c) * 32 + q) * 16);
#pragma unroll
            for (int j = 0; j < 8; ++j) { const float f = (float)v[j]; s += f * f; } }
        NH[hh * 32 + q] = __builtin_sqrtf(s); }
    IDX_BAR();
    if (tid < 32) { const int q = tid; const float* wr_ = WI + (rowbase + q0 + q) * 16; float s1 = 0.f, s2 = 0.f;
#pragma unroll
        for (int hh = 0; hh < 16; ++hh) { const float wv = wr_[hh] * IDX_SCALE, n = NH[hh * 32 + q]; s1 += wv * n; s2 += wv * wv * n * n; }
        const float mu = 0.3989423f * s1, sg = fmaxf(0.5838f * __builtin_sqrtf(s2), 1e-20f);
        const float invw = 25.6f / sg, lo = mu - 5.f * sg;
        QP[q * 8 + 0] = invw; QP[q * 8 + 1] = -lo * invw;
        if (!selneeded) { QP[q * 8 + 2] = -INFINITY; QP[q * 8 + 3] = -INFINITY; QP[q * 8 + 4] = 0.f; } }
    { const int q = tid & 31, dg = tid >> 5, c = dg >> 1, hf = dg & 1; const float* wr_ = WI + (rowbase + q0 + q) * 16; float a0 = 0.f, a1 = 0.f, a2 = 0.f, a3 = 0.f;
#pragma unroll
        for (int hh = 0; hh < 16; ++hh) { const float wv = 0.5f * IDX_SCALE * wr_[hh]; const h4 v = *(const LAS h4*)(QL + ((hh * 8 + c) * 32 + q) * 16 + 8 * hf);
            a0 += wv * (float)v[0]; a1 += wv * (float)v[1]; a2 += wv * (float)v[2]; a3 += wv * (float)v[3]; }
        u32x2 o; o.x = pkh(a0, a1); o.y = pkh(a2, a3);
        *(LAS u32x2*)(QL + ((16 * 8 + c) * 32 + q) * 16 + 8 * hf) = o; }
    IDX_BAR();
    { const int q = tid & 31, hh = tid >> 5; NH[hh * 32 + q] = 0.5f * IDX_SCALE * WI[(rowbase + q0 + q) * 16 + hh]; }
    IDX_BAR();
    const LAS float* WH = NH;
    const float invw = QP[r32 * 8 + 0], yoff = QP[r32 * 8 + 1];
    unsigned cm16 = 0u;
#pragma unroll
    for (int r = 0; r < 16; ++r) cm16 |= (crow(r, hi) <= r32) ? (1u << (15 - r)) : 0u;
    const int du = u & 3;
    if (selneeded) {
        for (int c = w; c < nch; c += 8) {
            f32x16 acc[4];
            chunk_scores(P + (rowbase + 128 * c) * NP + PC_KI, QL, WH, r32, hi, acc);
            const bool last = (c == nch - 1);
#pragma unroll
            for (int kt = 0; kt < 4; ++kt) {
                const unsigned fld = !last ? 0xFFFFu : (kt < du ? 0xFFFFu : (kt == du ? cm16 : 0u));
#pragma unroll
                for (int r = 0; r < 16; ++r) {
                    const float y = __builtin_fmaf(acc[kt][r], invw, yoff);
                    int bin = (int)y; bin = bin < 0 ? 0 : (bin > 255 ? 255 : bin);
                    if ((fld >> (15 - r)) & 1u) __hip_atomic_fetch_add(HIST + bin * 32 + r32, 1u, __ATOMIC_RELAXED, __HIP_MEMORY_SCOPE_WORKGROUP);
                }
            }
        }
        IDX_BAR();
#pragma unroll 1
        for (int i = 0; i < 4; ++i) { const int q = 4 * w + i;
            unsigned v[4];
#pragma unroll
            for (int k = 0; k < 4; ++k) v[k] = HIST[(4 * lane + k) * 32 + q];
            const unsigned sm = v[0] + v[1] + v[2] + v[3]; unsigned I = sm;
#pragma unroll
            for (int d = 1; d < 64; d <<= 1) { const unsigned t = __shfl_down(I, d); if (lane + d < 64) I += t; }
            const unsigned E = I - sm;
            if (E < 256u && I >= 256u) { unsigned cum = E; int bst = 4 * lane; unsigned nab = E; bool found = false;
#pragma unroll
                for (int k = 3; k >= 0; --k) { if (!found && cum + v[k] >= 256u) { bst = 4 * lane + k; nab = cum; found = true; } cum += v[k]; }
                QP[q * 8 + 2] = (bst == 255) ? INFINITY : (float)(bst + 1); QP[q * 8 + 3] = (bst == 0) ? -INFINITY : (float)bst; QP[q * 8 + 4] = (float)(256 - (int)nab); }
        }
        IDX_BAR();
#pragma unroll
        for (int i = 0; i < 4; ++i) *(LAS u32x4*)(lds + HIST_OFF + (i * 512 + tid) * 16) = (u32x4){0u, 0u, 0u, 0u};
        IDX_BAR();
    }
    { const float c1 = QP[r32 * 8 + 2], c0 = QP[r32 * 8 + 3];
        for (int c = w; c < nch; c += 8) {
            f32x16 acc[4];
            chunk_scores(P + (rowbase + 128 * c) * NP + PC_KI, QL, WH, r32, hi, acc);
            const bool last = (c == nch - 1);
#pragma unroll
            for (int jp = 0; jp < 2; ++jp) {
                unsigned selw = 0u, gew = 0u;
#pragma unroll
                for (int r = 0; r < 16; ++r) { const float y = __builtin_fmaf(acc[2 * jp + 1][r], invw, yoff);
                    selw = __builtin_amdgcn_alignbit(selw, __builtin_bit_cast(unsigned, y - c1), 31); gew = __builtin_amdgcn_alignbit(gew, __builtin_bit_cast(unsigned, y - c0), 31); }
#pragma unroll
                for (int r = 0; r < 16; ++r) { const float y = __builtin_fmaf(acc[2 * jp][r], invw, yoff);
                    selw = __builtin_amdgcn_alignbit(selw, __builtin_bit_cast(unsigned, y - c1), 31); gew = __builtin_amdgcn_alignbit(gew, __builtin_bit_cast(unsigned, y - c0), 31); }
                unsigned sel = ~selw, cand = ~gew & selw;
                if (last) { const int k0 = 2 * jp, k1 = 2 * jp + 1;
                    const unsigned f0 = k0 < du ? 0xFFFFu : (k0 == du ? cm16 : 0u), f1 = k1 < du ? 0xFFFFu : (k1 == du ? cm16 : 0u);
                    const unsigned cmw = f0 | (f1 << 16); sel &= cmw; cand &= cmw; }
                SEL[(r32 * 2 + hi) * 64 + 2 * c + jp] = sel; CAND[(r32 * 2 + hi) * 64 + 2 * c + jp] = cand;
            }
        }
    }
    IDX_BAR();
    if (selneeded) {
        LAS u16* list = (LAS u16*)(lds + WSC_OFF + w * 3072); LAS float* scs = (LAS float*)(lds + WSC_OFF + w * 3072 + 1024);
        const int head = lane & 15, fq = lane >> 4;
#pragma unroll 1
        for (int i = 0; i < 4; ++i) { const int q = 4 * w + i;
            const int need = (int)QP[q * 8 + 4];
            const unsigned w0 = CAND[(q * 2 + 0) * 64 + lane], w1 = CAND[(q * 2 + 1) * 64 + lane];
            const int cnt = __builtin_popcount(w0) + __builtin_popcount(w1); int Pf = cnt;
#pragma unroll
            for (int d = 1; d < 64; d <<= 1) { const int t = __shfl_up(Pf, d); if (lane >= d) Pf += t; }
            int n = __shfl(Pf, 63); int pos = Pf - cnt;
            for (unsigned tmp = w0; tmp; tmp &= tmp - 1) { const int be = __builtin_ctz(tmp); if (pos < NCAP) list[pos] = (u16)(64 * lane + 32 * (be >> 4) + crow(15 - (be & 15), 0)); ++pos; }
            for (unsigned tmp = w1; tmp; tmp &= tmp - 1) { const int be = __builtin_ctz(tmp); if (pos < NCAP) list[pos] = (u16)(64 * lane + 32 * (be >> 4) + crow(15 - (be & 15), 1)); ++pos; }
            if (MK_DEBUG && lane == 0) { unsigned* ctl_ = (unsigned*)(ws + WS_CTL); if (n > NCAP) atomicAdd(ctl_ + 24, 1u); if (need > n) atomicAdd(ctl_ + 25, 1u); if (need <= 0) atomicAdd(ctl_ + 26, 1u); }
            n = n < NCAP ? n : NCAP;
            LDS_WAIT(); asm volatile("" ::: "memory");
            if (n > 0 && need > 0) {
                h8 aq[2];
#pragma unroll
                for (int ks = 0; ks < 2; ++ks) aq[ks] = *(const LAS h8*)(QL + ((head * 8 + 4 * ks + fq) * 32 + q) * 16);
                f32x4 wv4 = *(const f32x4*)(WI + (rowbase + q0 + q) * 16 + 4 * fq); wv4 = wv4 * IDX_SCALE;
                for (int g0 = 0; g0 < n; g0 += 16) { const int ci = g0 + head; const int key = list[ci < n ? ci : n - 1];
                    const f16* kp = P + (rowbase + key) * NP + PC_KI + 8 * fq;
                    const h8 bk0 = *(const h8*)kp, bk1 = *(const h8*)(kp + 32);
                    f32x4 x = __builtin_amdgcn_mfma_f32_16x16x32_f16(aq[0], bk0, (f32x4){0.f, 0.f, 0.f, 0.f}, 0, 0, 0);
                    x = __builtin_amdgcn_mfma_f32_16x16x32_f16(aq[1], bk1, x, 0, 0, 0);
                    float sc = wv4.x * fmaxf(x.x, 0.f) + wv4.y * fmaxf(x.y, 0.f) + wv4.z * fmaxf(x.z, 0.f) + wv4.w * fmaxf(x.w, 0.f);
                    sc += __shfl_xor(sc, 16); sc += __shfl_xor(sc, 32);
                    if (fq == 0 && ci < n) scs[ci] = sc; }
                LDS_WAIT(); asm volatile("" ::: "memory");
                unsigned thr = 0u;
                if (need < n) {
#pragma unroll 1
                    for (int bit = 31; bit >= 0; --bit) { const unsigned trial = thr | (1u << bit); int c2 = 0;
                        for (int i0 = 0; i0 < n; i0 += 64) { const int ii = i0 + lane; const bool ok = ii < n && ordu(scs[ii < n ? ii : 0]) >= trial; c2 += __builtin_popcountll(__ballot(ok)); }
                        if (c2 >= need) thr = trial; } }
                for (int i0 = 0; i0 < n; i0 += 64) { const int ii = i0 + lane;
                    if (ii < n && ordu(scs[ii]) >= thr) { const int key = list[ii]; const int jj = key >> 6, tp = (key >> 5) & 1, i5 = key & 31, kh = (i5 >> 2) & 1, r = (i5 & 3) | ((i5 >> 3) << 2);
                        __hip_atomic_fetch_or(SEL + (q * 2 + kh) * 64 + jj, 1u << (16 * tp + 15 - r), __ATOMIC_RELAXED, __HIP_MEMORY_SCOPE_WORKGROUP); } }
                LDS_WAIT(); asm volatile("" ::: "memory");
            }
        }
    }
    IDX_BAR();
    { u32x4* mo = (u32x4*)(MASK + (rowbase + q0) * 128);
        mo[tid] = *(const LAS u32x4*)(lds + SEL_OFF + tid * 16); mo[512 + tid] = *(const LAS u32x4*)(lds + SEL_OFF + (512 + tid) * 16); }
    IDX_BAR();
}
__device__ __forceinline__ void idx_phase(const Args& a, Frame& F) {
    for (int k = F.vcu; k < 1024; k += F.G) { const int i = k >> 8, c = k & 255; const int b = c >> 5, j = c & 31;
        const int u = (i == 0) ? j : (i == 1) ? 63 - j : (i == 2) ? 64 + j : 127 - j;
        idx_unit(a, F.lds, b, u); }
}
}


namespace dbg {
__device__ __forceinline__ int sample_t(int i) { switch (i) { case 0: return 0; case 1: return 1; case 2: return 31; case 3: return 32; case 4: return 63; case 5: return 64; case 6: return 100; case 7: return 127; case 8: return 128; case 9: return 255; case 10: return 256; case 11: return 1000; case 12: return 2047; case 13: return 2048; case 14: return 3071; default: return 4095; } }
constexpr int CW_DBG = 16;
__device__ __forceinline__ void dbg_phase(const Args& a, Frame& F) {
    if (F.vcu >= 16) return;
    unsigned char* ws = a.ws; asm volatile("" : "+s"(ws));
    const f16* P = (const f16*)(ws + WS_P); const float* WI = (const float*)(ws + WS_WI); const unsigned* MASK = (const unsigned*)(ws + WS_MASK);
    unsigned* ctl = (unsigned*)(ws + WS_CTL);
    const int t = sample_t(F.vcu);
    const int b = F.vcu & 7; const size_t rowbase = (size_t)b * SEQ;
    LAS float* qf = (LAS float*)(F.lds);
    LAS float* sc = (LAS float*)(F.lds + 4096);
    LAS unsigned* red = (LAS unsigned*)(F.lds + 4096 + 16384);
    const int tid = F.tid;
    for (int i = tid; i < 1024; i += 512) qf[i] = (float)P[(rowbase + t) * NP + PC_QI + i];
    if (tid < 2) red[tid] = 0u;
    __syncthreads();
    for (int j = tid; j <= t; j += 512) {
        const f16* kp = P + (rowbase + j) * NP + PC_KI;
        float s = 0.f;
        for (int h = 0; h < 16; ++h) { float x = 0.f;
            for (int d = 0; d < 64; ++d) x += qf[h * 64 + d] * (float)kp[d];
            s += WI[(rowbase + t) * 16 + h] * fmaxf(x, 0.f); }
        sc[j] = s * 0.03125f;
    }
    __syncthreads();
    unsigned mism = 0u, nsel = 0u;
    for (int j = tid; j <= t; j += 512) {
        const float sj = sc[j]; int rank = 0;
        for (int i = 0; i <= t; ++i) { const float si = sc[i]; rank += (si > sj || (si == sj && i < j)) ? 1 : 0; }
        const bool exp_sel = (rank < 256);
        const int jj = j >> 6, tp = (j >> 5) & 1, i5 = j & 31, kh = (i5 >> 2) & 1, r = (i5 & 3) | ((i5 >> 3) << 2);
        const unsigned wv = MASK[((rowbase + t) * 2 + kh) * 64 + jj];
        const bool act = (wv >> (16 * tp + 15 - r)) & 1u;
        mism += (exp_sel != act) ? 1u : 0u; nsel += act ? 1u : 0u;
    }
    for (int j = t + 1 + tid; j < SEQ; j += 512) {
        const int jj = j >> 6, tp = (j >> 5) & 1, i5 = j & 31, kh = (i5 >> 2) & 1, r = (i5 & 3) | ((i5 >> 3) << 2);
        const unsigned wv = MASK[((rowbase + t) * 2 + kh) * 64 + jj];
        mism += ((wv >> (16 * tp + 15 - r)) & 1u) ? 1u : 0u;
    }
    atomicAdd((unsigned*)&red[0], mism); atomicAdd((unsigned*)&red[1], nsel);
    __syncthreads();
    if (tid == 0) { atomicAdd(ctl + CW_DBG, red[0]); const unsigned want = (t + 1 < 256) ? (unsigned)(t + 1) : 256u; if (red[1] != want) atomicAdd(ctl + CW_DBG + 1, 1u); }
    __syncthreads();
}

__device__ __forceinline__ void dbg2_phase(const Args& a, Frame& F) {
    if (F.vcu >= 16) return;
    unsigned char* ws = a.ws; asm volatile("" : "+s"(ws));
    const f16* P = (const f16*)(ws + WS_P); const unsigned* MASK = (const unsigned*)(ws + WS_MASK); const f16* MIX = (const f16*)(ws + WS_MIX);
    unsigned* ctl = (unsigned*)(ws + WS_CTL);
    const int t = sample_t(F.vcu);
    const int b = F.vcu & 7; const size_t rowbase = (size_t)b * SEQ;
    const int tid = F.tid, h = tid >> 6, d = tid & 63;
    LAS unsigned* red = (LAS unsigned*)(F.lds);
    if (tid < 2) red[tid] = 0u;
    __syncthreads();
    const f16* qp = P + (rowbase + t) * NP + PC_QA + h * 64;
    float mx = -1e30f;
    for (int j = 0; j <= t; ++j) {
        const int jj = j >> 6, tp = (j >> 5) & 1, i5 = j & 31, kh = (i5 >> 2) & 1, r = (i5 & 3) | ((i5 >> 3) << 2);
        const unsigned wv = MASK[((rowbase + t) * 2 + kh) * 64 + jj];
        if (!((wv >> (16 * tp + 15 - r)) & 1u)) continue;
        const f16* kp = P + (rowbase + j) * NP + PC_KA; float sdot = 0.f;
        for (int e = 0; e < 64; ++e) sdot += (float)qp[e] * (float)kp[e];
        mx = fmaxf(mx, sdot);
    }
    float l = 0.f, o = 0.f;
    for (int j = 0; j <= t; ++j) {
        const int jj = j >> 6, tp = (j >> 5) & 1, i5 = j & 31, kh = (i5 >> 2) & 1, r = (i5 & 3) | ((i5 >> 3) << 2);
        const unsigned wv = MASK[((rowbase + t) * 2 + kh) * 64 + jj];
        if (!((wv >> (16 * tp + 15 - r)) & 1u)) continue;
        const f16* kp = P + (rowbase + j) * NP + PC_KA; float sdot = 0.f;
        for (int e = 0; e < 64; ++e) sdot += (float)qp[e] * (float)kp[e];
        const float p = __builtin_amdgcn_exp2f(sdot - mx);
        l += p; o += p * (float)P[(rowbase + j) * NP + PC_VA + d];
    }
    o /= l;
    const float got = (float)MIX[(rowbase + t) * DM + h * 64 + d];
    if (F.vcu == 0 && tid == 0) { float m64 = -1e30f, s0v = 0.f; float qn = 0.f, kn = 0.f;
        for (int j = 0; j < 64; ++j) { const f16* kp = P + (rowbase + j) * NP + PC_KA; float sd = 0.f; for (int e = 0; e < 64; ++e) sd += (float)qp[e] * (float)kp[e]; if (j == 0) s0v = sd; m64 = fmaxf(m64, sd); }
        for (int e = 0; e < 64; ++e) { qn += (float)qp[e] * (float)qp[e]; const float kv = (float)P[(rowbase + 0) * NP + PC_KA + e]; kn += kv * kv; }
        ctl[20] = (unsigned)(m64 - s0v + 0.5f); ctl[21] = (unsigned)(__builtin_sqrtf(qn) * 4.f + 0.5f); ctl[22] = (unsigned)(__builtin_sqrtf(kn) * 4.f + 0.5f); }
    if (F.vcu == 0 && h == 3) { float ratio = got / o; if (!(ratio > 0.f && ratio < 6.f)) ratio = 6.f; atomicAdd(ctl + 28, (unsigned)(ratio * 10.f + 0.5f)); }
    LAS float* redf = (LAS float*)(F.lds + 64);
    if (tid < 2) redf[tid] = 0.f;
    __syncthreads();
    atomicAdd((float*)&redf[0], (got - o) * (got - o)); atomicAdd((float*)&redf[1], o * o);
    if (F.vcu == 0 && __builtin_fabsf(got - o) > 0.01f + 0.02f * __builtin_fabsf(o)) atomicAdd(ctl + 19, 1u);
    __syncthreads();
    if (tid == 0) { const float rr = __builtin_sqrtf(redf[0] / redf[1]); unsigned c = (unsigned)(rr * 100.f + 0.5f); if (!(rr < 10.f)) c = 1000; ctl[32 + F.vcu] = c; }
    __syncthreads();
}
}

enum { ST_GEMM = 0, ST_IDX = 1, ST_MLA = 2, ST_DSA = 3, ST_FINAL = 4, ST_ZMIX = 5, ST_DBG = 6, ST_DBG2 = 7 };

#ifndef DBG_WHICH
#define DBG_WHICH 3
#endif
__device__ __forceinline__ void final_phase(const Args& a, Frame& F) {
    const int gw = F.vcu * NWAVES + F.wave, NGW = F.G * NWAVES;
    const float* SS = (const float*)(a.ws + WS_SS16);
    f32x4 gv[4];
#pragma unroll
    for (int j = 0; j < 4; ++j) gv[j] = *((const f32x4*)a.g_final + F.lane + 64 * j);
    float dscale = 1.f;
    if (MK_DEBUG) { const unsigned* ctl = (const unsigned*)(a.ws + WS_CTL); const unsigned mm = __hip_atomic_load(ctl + 16, __ATOMIC_RELAXED, __HIP_MEMORY_SCOPE_AGENT), bc = __hip_atomic_load(ctl + 17, __ATOMIC_RELAXED, __HIP_MEMORY_SCOPE_AGENT);
      const unsigned m2 = __hip_atomic_load(ctl + 18, __ATOMIC_RELAXED, __HIP_MEMORY_SCOPE_AGENT);
      unsigned code = 0; if (DBG_WHICH == 0) { if (mm) code = 1 + (31 - __builtin_clz(mm)); } else if (DBG_WHICH == 1) code = bc; else if (DBG_WHICH == 2) { if (m2) code = 1 + (31 - __builtin_clz(m2)); }
      else { unsigned nb = 0, first = 0, second = 0; for (int i = 0; i < 16; ++i) { const unsigned c = __hip_atomic_load(ctl + 32 + i, __ATOMIC_RELAXED, __HIP_MEMORY_SCOPE_AGENT); if (c > nb) nb = c; first += c; if (c > 3 && !second) second = i + 1; }
        code = (DBG_WHICH == 3) ? nb : (DBG_WHICH == 4) ? first / 16 : (DBG_WHICH == 14) ? (__hip_atomic_load(ctl + 28, __ATOMIC_RELAXED, __HIP_MEMORY_SCOPE_AGENT) / 64) : (DBG_WHICH >= 10) ? ({ const unsigned v_ = __hip_atomic_load(ctl + 14 + DBG_WHICH, __ATOMIC_RELAXED, __HIP_MEMORY_SCOPE_AGENT); v_ ? 1 + (31 - __builtin_clz(v_)) : 0u; }) : (DBG_WHICH == 5) ? second : (DBG_WHICH == 6) ? __hip_atomic_load(ctl + 19, __ATOMIC_RELAXED, __HIP_MEMORY_SCOPE_AGENT) / 8 : __hip_atomic_load(ctl + 13 + DBG_WHICH, __ATOMIC_RELAXED, __HIP_MEMORY_SCOPE_AGENT); if (code > 70) code = 70; } dscale = 1.f + (float)code; }
    for (int m = gw; m < M; m += NGW) {
        float s = (F.lane < 16) ? SS[(size_t)m * 16 + F.lane] : 0.f;
        s = wave_sum(s);
        const float rs = frsq(s * (1.f / DM) + EPS) * dscale;
        f32x4* xr = (f32x4*)(a.out + (size_t)m * DM) + F.lane;
#pragma unroll
        for (int j = 0; j < 4; ++j) { f32x4 v = xr[64 * j]; v = v * rs * gv[j]; xr[64 * j] = v; }
    }
}
__device__ __forceinline__ void zmix_phase(const Args& a, Frame& F) {
    u32x4* p = (u32x4*)(a.ws + WS_MIX);
    const size_t n = (size_t)M * DM * 2 / 16;
    for (size_t i = (size_t)F.vcu * 512 + F.tid; i < n; i += (size_t)F.G * 512) p[i] = (u32x4){0u, 0u, 0u, 0u};
}

struct Stage { int type, gi, bar; };
__device__ __forceinline__ Stage get_stage(int s) {
#if MK_DEBUG
    switch (s) {
        case 0: return {ST_GEMM, G_FFN1A, 1};
        case 1: return {ST_GEMM, G_FFN1B, 1};
        case 2: return {ST_GEMM, G_WIN, 1};
        case 3: return {ST_GEMM, G_QUP, 0};
        case 4: return {ST_GEMM, G_KVUP, 0};
        case 5: return {ST_IDX, 0, 1};
        case 6: return {ST_DBG, 0, 1};
        case 7: return {ST_MLA, 0, 0};
        case 8: return {ST_DSA, 0, 1};
        case 9: return {ST_DBG2, 0, 1};
        case 10: return {ST_GEMM, G_WOUT, 1};
        case 11: return {ST_GEMM, G_FFN2A, 1};
        case 12: return {ST_GEMM, G_FFN2B, 1};
        default: return {ST_FINAL, 0, 0};
    }
#else
    switch (s) {
        case 0: return {ST_GEMM, G_FFN1A, 1};
        case 1: return {ST_GEMM, G_FFN1B, 1};
        case 2: return {ST_GEMM, G_WIN, 1};
        case 3: return {ST_GEMM, G_QUP, 0};
        case 4: return {ST_GEMM, G_KVUP, 0};
        case 5: return {ST_IDX, 0, 1};
        case 6: return {ST_MLA, 0, 0};
        case 7: return {ST_DSA, 0, 1};
        case 8: return {ST_GEMM, G_WOUT, 1};
        case 9: return {ST_GEMM, G_FFN2A, 1};
        case 10: return {ST_GEMM, G_FFN2B, 1};
        default: return {ST_FINAL, 0, 0};
    }
#endif
}
#if MK_DEBUG
constexpr int NSTAGES = 14;
#else
constexpr int NSTAGES = 12;
#endif

__global__ void __launch_bounds__(NWAVES * 64, 2) mega_fwd(Args args) {
    extern __shared__ __attribute__((aligned(16))) unsigned char lds_raw[];
    Frame F;
    F.lds = (LAS unsigned char*)lds_raw;
    volatile LAS unsigned* MISC = (volatile LAS unsigned*)(F.lds + MISC_OFF);
    F.tid = threadIdx.x; F.lane = F.tid & 63; F.wave = __builtin_amdgcn_readfirstlane(F.tid >> 6);
    F.G = gridDim.x; { const int bx = blockIdx.x; F.vcu = (F.G % 8 == 0) ? (bx % 8) * (F.G / 8) + bx / 8 : bx; }
    for (int u = F.tid; u < (LDS_BYTES - LDSCTL_OFF) / 4; u += NWAVES * 64) ((LAS unsigned*)(F.lds + LDSCTL_OFF))[u] = 0u;
    __syncthreads();
    unsigned* ctl = (unsigned*)(args.ws + WS_CTL);
    XcdBarrier bar = xcd_barrier_post(ctl + CW_BAR, MISC + 8);

    prep_phase(args, F);
    xcd_barrier(bar);

    for (int s = 0; s < NSTAGES; ++s) {
        const Stage st = get_stage(s);
        F.tid = opaque_tid(); F.lane = F.tid & 63; F.wave = __builtin_amdgcn_readfirstlane(F.tid >> 6);
        if (st.type == ST_GEMM) {
            pg8::GemmDesc g; pg8::make_gemm(args, st.gi, g);
            pg8::StaticOrder S; S.init(g.M, g.N, F.G, (int)blockIdx.x);
            pg8::gemm_phase(F.lds, args, st.gi, g, S);
        } else if (st.type == ST_ZMIX) {
            zmix_phase(args, F);
        } else if (st.type == ST_MLA) {
            att::attn_phase<0>(args, F);
        } else if (st.type == ST_DSA) {
            att::attn_phase<1>(args, F);
        } else if (st.type == ST_IDX) {
            idx::idx_phase(args, F);
#if MK_DEBUG
        } else if (st.type == ST_DBG) {
            dbg::dbg_phase(args, F);
        } else if (st.type == ST_DBG2) {
            dbg::dbg2_phase(args, F);
#endif
        } else if (st.type == ST_FINAL) {
            final_phase(args, F);
        }
        if (st.bar) xcd_barrier(bar);
    }
}

extern "C" void kernel_launch(void* const* d_in, const int* in_sizes, int n_in, void* d_out, int out_size, void* d_ws, size_t ws_size, hipStream_t stream) {
    static int grid = 0;
    if (grid == 0) {
        if (n_in != 17 || in_sizes[0] != M * DM || out_size != M * DM || ws_size < WS_END) {
            fprintf(stderr, "kernel_launch: unexpected shapes/workspace: n_in %d in0 %d out %d ws %zu (need %zu); nothing launched\n", n_in, n_in > 0 ? in_sizes[0] : -1, out_size, ws_size, (size_t)WS_END);
            grid = -1; return; }
        int dev = 0, cus = 0;
        if (hipGetDevice(&dev) != hipSuccess || hipDeviceGetAttribute(&cus, hipDeviceAttributeMultiprocessorCount, dev) != hipSuccess) { grid = -1; return; }
        if (hipFuncSetAttribute((const void*)mega_fwd, hipFuncAttributeMaxDynamicSharedMemorySize, LDS_BYTES) != hipSuccess) { fprintf(stderr, "kernel_launch: hipFuncSetAttribute failed\n"); grid = -1; return; }
        int per_cu = 0;
        if (hipOccupancyMaxActiveBlocksPerMultiprocessor(&per_cu, (const void*)mega_fwd, NWAVES * 64, LDS_BYTES) != hipSuccess || per_cu < 1)
            fprintf(stderr, "kernel_launch: note: occupancy query reports %d workgroups per CU\n", per_cu);
        (void)hipGetLastError();
        grid = cus;
    }
    if (grid < 0) return;
    (void)hipMemsetAsync((char*)d_ws + WS_CTL, 0, CTL_ZERO_BYTES, stream);
    Args a{};
    a.x = (const float*)d_in[0]; a.g_ffn1 = (const float*)d_in[1]; a.w1_gate = (const float*)d_in[2]; a.w1_up = (const float*)d_in[3]; a.w1_down = (const float*)d_in[4];
    a.g_mix = (const float*)d_in[5]; a.w_in = (const float*)d_in[6]; a.g_q_lat = (const float*)d_in[7]; a.g_kv_lat = (const float*)d_in[8]; a.w_uq = (const float*)d_in[9]; a.w_ukv = (const float*)d_in[10];
    a.w_out = (const float*)d_in[11]; a.g_ffn2 = (const float*)d_in[12]; a.w2_gate = (const float*)d_in[13]; a.w2_up = (const float*)d_in[14]; a.w2_down = (const float*)d_in[15]; a.g_final = (const float*)d_in[16];
    a.out = (float*)d_out; a.ws = (unsigned char*)d_ws;
    hipLaunchKernelGGL(mega_fwd, dim3(grid), dim3(NWAVES * 64), LDS_BYTES, stream, a);
}
```

```cpp
#include <hip/hip_runtime.h>
#include <cstdio>
#include <cstdint>
#include <cmath>

#ifndef MK_DEBUG
#define MK_DEBUG 0
#endif
#ifndef MK_TIMING
#define MK_TIMING 0
#endif
#ifndef TSEL
#define TSEL 6
#endif
#ifndef TUNIT
#define TUNIT 4000
#endif
#ifndef TOFF
#define TOFF 0
#endif
#ifndef DUP_STAGE
#define DUP_STAGE 0
#endif
#ifndef FUSE_FINAL
#define FUSE_FINAL 1
#endif
#ifndef RSEL
#define RSEL -1
#endif
#define LAS __attribute__((address_space(3)))
#define GAS __attribute__((address_space(1)))
typedef _Float16 f16;
typedef _Float16 h8 __attribute__((ext_vector_type(8)));
typedef _Float16 h4 __attribute__((ext_vector_type(4)));
typedef _Float16 h2 __attribute__((ext_vector_type(2)));
typedef float f32x2 __attribute__((ext_vector_type(2)));
typedef float f32x4 __attribute__((ext_vector_type(4)));
typedef float f32x16 __attribute__((ext_vector_type(16)));
typedef unsigned u32x2 __attribute__((ext_vector_type(2)));
typedef unsigned u32x4 __attribute__((ext_vector_type(4)));
typedef unsigned short u16;

constexpr int BATCH = 8, SEQ = 4096, DM = 1024, M = BATCH * SEQ;
constexpr int DFF = 2816, NFF = 2 * DFF;
constexpr int DPROJ = 2416, NP = 2560;
constexpr int QLORA = 384, KVLORA = 256;
constexpr int NQB = 768, NKV = 1024;
constexpr float EPS = 1e-6f;
constexpr float LOG2E = 1.4426950408889634f;
constexpr int PC_QA = 0, PC_QI = 512, PC_KA = 1536, PC_KI = 1600, PC_KR = 1664, PC_VA = 1696, PC_WI = 1760, PC_CQ = 1792, PC_CKV = 2304;
constexpr int WC_QA = 0, WC_KA = 512, WC_VA = 576, WC_QI = 640, WC_KI = 1664, WC_WI = 1728, WC_CQ = 1744, WC_CKV = 2128, WC_KR = 2384;

constexpr size_t MiB = 1u << 20;
constexpr size_t WS_CTL = 0, CTL_ZERO_BYTES = 1 * MiB;
constexpr size_t WS_BT1 = 1 * MiB;
constexpr size_t WS_BTD1 = 12 * MiB;
constexpr size_t WS_BT2 = 18 * MiB;
constexpr size_t WS_BTD2 = 29 * MiB;
constexpr size_t WS_BTIN = 35 * MiB;
constexpr size_t WS_BTQ = 40 * MiB;
constexpr size_t WS_BTKV = 41 * MiB;
constexpr size_t WS_BTOUT = 42 * MiB;
constexpr size_t WS_ROPE = 44 * MiB;
constexpr size_t WS_SS0 = 46 * MiB;
constexpr size_t WS_SS16 = 47 * MiB;
constexpr size_t WS_SSQ = 49 * MiB;
constexpr size_t WS_SSKV = 50 * MiB;
constexpr size_t WS_WI = 51 * MiB;
constexpr size_t WS_XH = 54 * MiB;
constexpr size_t WS_H = 118 * MiB;
constexpr size_t WS_P = WS_H;
constexpr size_t WS_QB = 294 * MiB;
constexpr size_t WS_KV = 342 * MiB;
constexpr size_t WS_MIX = 406 * MiB;
constexpr size_t WS_MASK = 470 * MiB;
constexpr size_t WS_END = 486 * MiB;

constexpr int RING_BYTES = 131072;
constexpr int LDSCTL_OFF = RING_BYTES, MISC_OFF = LDSCTL_OFF + 320;
constexpr int LDS_BYTES = 147456;
constexpr int NWAVES = 8;

#define RLX_AGENT __ATOMIC_RELAXED, __HIP_MEMORY_SCOPE_AGENT
#define LDS_WAIT() asm volatile("s_waitcnt lgkmcnt(0)" ::: "memory")
#define VM_WAIT() asm volatile("s_waitcnt vmcnt(0)" ::: "memory")

__device__ __forceinline__ unsigned pkh(float a, float b) { h2 v; v.x = (f16)a; v.y = (f16)b; return __builtin_bit_cast(unsigned, v); }
__device__ __forceinline__ int opaque_tid() { int t = threadIdx.x; asm volatile("" : "+v"(t)); return t; }
__device__ __forceinline__ float frsq(float x) { return __builtin_amdgcn_rsqf(x); }
__device__ __forceinline__ float sq4(const f32x4 v) { return (v.x * v.x + v.y * v.y) + (v.z * v.z + v.w * v.w); }
__device__ __forceinline__ float wave_sum(float v) {
#pragma unroll
    for (int o = 1; o < 64; o <<= 1) v += __shfl_xor(v, o);
    return v;
}

#define XB_TMO      128
#define XB_XCNT(j)  (256  + 64 * (j))
#define XB_XSUB(j)  (1280 + 64 * (j))
#define XB_XGEN(j)  (2304 + 64 * (j))
#define XB_TOP      3328
#define XB_TOPGEN   3392
#define XCD_BAR_WORDS 3456
#define XB_SPIN_CAP (1u << 18)
constexpr int CW_BAR = 4096;

__device__ __forceinline__ unsigned xb_ld(unsigned* p)              { return __hip_atomic_load(p, __ATOMIC_RELAXED, __HIP_MEMORY_SCOPE_AGENT); }
__device__ __forceinline__ unsigned xb_add(unsigned* p, unsigned v) { return __hip_atomic_fetch_add(p, v, __ATOMIC_RELAXED, __HIP_MEMORY_SCOPE_AGENT); }
__device__ __forceinline__ unsigned xb_xcc_id() { return (unsigned)__builtin_amdgcn_s_getreg((3 << 11) | 20) & 0xFu; }
#define XB_SPIN(cond, bar) do { unsigned _sp = 0; while (cond) { __builtin_amdgcn_s_sleep(1); \
    if ((++_sp & 255u) == 0u) { if (xb_ld(&(bar)[XB_TMO])) break; if (_sp > XB_SPIN_CAP) { atomicAdd(&(bar)[XB_TMO], 1u); break; } } } } while (0)

struct XcdBarrier { unsigned* bar; unsigned x; volatile LAS unsigned* st; };

__device__ __forceinline__ XcdBarrier xcd_barrier_post(unsigned* bar, volatile LAS unsigned* st) {
    XcdBarrier b; b.bar = bar; b.x = xb_xcc_id(); b.st = st;
    if (threadIdx.x == 0) (void)xb_add(&bar[XB_XCNT(b.x)], 1u);
    return b;
}
__device__ __forceinline__ void xcd_barrier_complete(unsigned* bar, unsigned x, unsigned& nloc, unsigned& nx) {
    const unsigned G = gridDim.x * gridDim.y * gridDim.z;
    unsigned sum, cnt, mine, sp = 0u;
    for (;;) {
        sum = 0u; cnt = 0u; mine = 0u;
#pragma unroll
        for (unsigned j = 0; j < 16; ++j) { const unsigned c = xb_ld(&bar[XB_XCNT(j)]); sum += c; cnt += (c > 0u) ? 1u : 0u; mine = (j == x) ? c : mine; }
        if (sum == G) break;
        __builtin_amdgcn_s_sleep(1);
        if ((++sp & 255u) == 0u) { if (xb_ld(&bar[XB_TMO])) break; if (sp > XB_SPIN_CAP) { atomicAdd(&bar[XB_TMO], 1u); break; } }
    }
    nloc = mine > 0u ? mine : 1u; nx = cnt > 0u ? cnt : 1u;
}
__device__ __forceinline__ void xcd_barrier(const XcdBarrier& b) {
    asm volatile("s_waitcnt vmcnt(0)" ::: "memory");
    __syncthreads();
    if (threadIdx.x == 0) {
        unsigned* bar = b.bar; unsigned bx_ = b.x;
        asm volatile("" : "+s"(bar), "+s"(bx_));
        __builtin_amdgcn_s_waitcnt(0);
        unsigned nloc = b.st[0], nx = b.st[1];
        if (nloc == 0u) { xcd_barrier_complete(bar, bx_, nloc, nx); b.st[0] = nloc; b.st[1] = nx; }
        const unsigned old = xb_add(&bar[XB_XSUB(bx_)], 1u);
        const unsigned gen = old / nloc;
        if (old + 1u == (gen + 1u) * nloc) {
            __builtin_amdgcn_fence(__ATOMIC_RELEASE, "agent");
            asm volatile("s_waitcnt vmcnt(0)" ::: "memory");
            const unsigned og = xb_add(&bar[XB_TOP], 1u);
            const unsigned tg = og / nx;
            if (og + 1u == (tg + 1u) * nx) xb_add(&bar[XB_TOPGEN], 1u);
            else XB_SPIN(xb_ld(&bar[XB_TOPGEN]) == tg, bar);
            __builtin_amdgcn_fence(__ATOMIC_ACQUIRE, "agent");
            xb_add(&bar[XB_XGEN(bx_)], 1u);
            asm volatile("s_waitcnt vmcnt(0)" ::: "memory");
        } else {
            XB_SPIN(xb_ld(&bar[XB_XGEN(bx_)]) == gen, bar);
            __builtin_amdgcn_fence(__ATOMIC_ACQUIRE, "agent");
            asm volatile("s_waitcnt vmcnt(0)" ::: "memory");
        }
    }
    __syncthreads();
}

struct Args {
    const float* x; const float* g_ffn1; const float* w1_gate; const float* w1_up; const float* w1_down;
    const float* g_mix; const float* w_in; const float* g_q_lat; const float* g_kv_lat; const float* w_uq; const float* w_ukv;
    const float* w_out; const float* g_ffn2; const float* w2_gate; const float* w2_up; const float* w2_down; const float* g_final;
    float* out; unsigned char* ws;
};

constexpr int G_FFN1A = 0, G_FFN1B = 1, G_WIN = 2, G_QUP = 3, G_KVUP = 4, G_WOUT = 5, G_FFN2A = 6, G_FFN2B = 7;
namespace pg8 {
constexpr int BM = 256, BK = 64, HALF = 128, HTB = HALF * BK * 2, STAGE_BYTES = 8 * HTB, NXCD = 8, WGM = 8;
__host__ __device__ __forceinline__ int lds_byte(int r, int c) { const int st = (r >> 4) * 2 + (c >> 5), rr = r & 15, cc = c & 31, ob = rr * 64 + cc * 2; return st * 1024 + (ob ^ (((ob >> 9) & 1) << 5)); }
__host__ __device__ __forceinline__ void stage_rc(int b, int& R, int& C) { const int st = b / 1024, sb = b % 1024, swz = sb ^ (((sb >> 9) & 1) << 5); R = (st >> 1) * 16 + swz / 64; C = (st & 1) * 32 + (swz % 64) / 2; }
__host__ __device__ __forceinline__ int perm32(int rho) { const int n = rho >> 4, i = rho & 15; return 8 * (i >> 2) + 4 * n + (i & 3); }

struct Unit { int pm, pn; };
struct StaticOrder {
    int nM, nN, nwg, G, c;
    __device__ void init(int M_, int N_, int G_, int c_) { nM = M_ / BM; nN = N_ / BM; nwg = nM * nN; G = G_; c = c_; }
    __device__ bool next(int i, Unit& u) const {
        const long L = (long)i * G + c; if (L >= nwg) return false;
        int wgid = (int)L; { const int q = nwg / NXCD, r = nwg % NXCD, xcd = wgid % NXCD, off = wgid / NXCD; wgid = (xcd < r ? xcd * (q + 1) : r * (q + 1) + (xcd - r) * q) + off; }
        const int nig = WGM * nN, gid = wgid / nig, fm = gid * WGM, gsz = (nM - fm) < WGM ? (nM - fm) : WGM;
        u.pm = fm + ((wgid % nig) % gsz); u.pn = (wgid % nig) / gsz; return true;
    }
};

enum { EPI_SWIGLU = 0, EPI_RESID = 1, EPI_WIN = 2, EPI_QUP = 3, EPI_KVUP = 4, EPI_FINAL = 5 };
struct GemmDesc {
    const f16* A; const f16* Bt; int M, N, K, lda;
    int epi;
    const float* ss; int nss;
    float invn;
    f16* oh; int ldo;
    const float* xin; float* xout; f16* xh; float* ssout; float rscale;
    const float* cos64; const float* sin64; const float* cos32; const float* sin32;
    float* wi; float* ssq; float* sskv;
};

template <int NSS> __device__ __forceinline__ float row_rstd(const float* ss, int row, float invn) {
    float s;
    if (NSS == 1) s = ss[row];
    else { s = 0.f;
#pragma unroll
        for (int j = 0; j < NSS / 4; ++j) { const f32x4 v = *(const f32x4*)(ss + (size_t)row * NSS + 4 * j); s += (v.x + v.y) + (v.z + v.w); } }
    return frsq(s * invn + EPS);
}
__device__ __forceinline__ float row_rstd_rt(const float* ss, int nss, int row, float invn) {
    if (nss == 1) return row_rstd<1>(ss, row, invn);
    if (nss == 4) return row_rstd<4>(ss, row, invn);
    if (nss == 8) return row_rstd<8>(ss, row, invn);
    return row_rstd<16>(ss, row, invn);
}

__device__ __forceinline__ void make_gemm(const Args& a, int gi, GemmDesc& g);
__device__ __forceinline__ void epilogue(const Args& a, int gi, f32x4 (&acc)[2][2][4][2], const Unit& u, int wr, int wc, int fr, int fq, LAS unsigned char* lds, int upar) {
    asm volatile("" : "+s"(gi), "+s"(wr), "+s"(wc), "+v"(fr), "+v"(fq));
    GemmDesc g; make_gemm(a, gi, g);
    const LAS float* RST = (const LAS float*)(lds + LDSCTL_OFF + 7168) + upar * 256;
    const int rl0 = wr * 64 + fr;
    const int row0 = u.pm * BM + wr * 64 + fr;
    if (g.epi == EPI_SWIGLU) {
        const int hc0 = 128 * u.pn + 32 * wc + 8 * fq;
#pragma unroll
        for (int ai = 0; ai < 2; ++ai)
#pragma unroll
            for (int m = 0; m < 4; ++m) {
                const int row = row0 + ai * HALF + m * 16;
                const float rs = RST[rl0 + ai * HALF + m * 16];
                u32x4 w;
#pragma unroll
                for (int bj = 0; bj < 2; ++bj) {
                    const f32x4 ga = acc[ai][bj][m][0] * rs, ua = acc[ai][bj][m][1] * rs;
                    float hv[4];
#pragma unroll
                    for (int i = 0; i < 4; ++i) { const float sg = __builtin_amdgcn_rcpf(1.f + __builtin_amdgcn_exp2f(-ga[i] * LOG2E)); hv[i] = ga[i] * sg * ua[i]; }
                    if (bj == 0) { w.x = pkh(hv[0], hv[1]); w.y = pkh(hv[2], hv[3]); } else { w.z = pkh(hv[0], hv[1]); w.w = pkh(hv[2], hv[3]); }
                }
                *(u32x4*)(g.oh + (size_t)row * DFF + hc0) = w;
            }
    } else if (g.epi == EPI_RESID) {
        const int col0 = u.pn * BM + wc * 32 + 8 * fq;
#pragma unroll
        for (int ai = 0; ai < 2; ++ai)
#pragma unroll
            for (int m = 0; m < 4; ++m) {
                const int row = row0 + ai * HALF + m * 16;
                const size_t off = (size_t)row * DM + col0;
                float q = 0.f;
#pragma unroll
                for (int bj = 0; bj < 2; ++bj) {
                    const h8 hv = *(const h8*)(g.xh + off + bj * HALF);
                    const f32x4 x0 = (f32x4){(float)hv[0], (float)hv[1], (float)hv[2], (float)hv[3]} + acc[ai][bj][m][0] * g.rscale;
                    const f32x4 x1 = (f32x4){(float)hv[4], (float)hv[5], (float)hv[6], (float)hv[7]} + acc[ai][bj][m][1] * g.rscale;
                    u32x4 w; w.x = pkh(x0[0], x0[1]); w.y = pkh(x0[2], x0[3]); w.z = pkh(x1[0], x1[1]); w.w = pkh(x1[2], x1[3]);
                    *(u32x4*)(g.xh + off + bj * HALF) = w;
                    q += sq4(x0) + sq4(x1);
                }
                q += __shfl_xor(q, 16); q += __shfl_xor(q, 32);
                if (fq == 0) g.ssout[(size_t)row * 16 + u.pn * 4 + wc] = q;
                if (m == 3) asm volatile("" ::: "memory");
            }
    } else if (g.epi == EPI_FINAL) {
        LAS float* Pss = (LAS float*)(lds + LDSCTL_OFF + 1024);
        LAS float* Srs = (LAS float*)(lds + LDSCTL_OFF + 1024 + 4096);
        const int col0 = u.pn * BM + wc * 32 + 8 * fq;
        const int tid_ = opaque_tid();
#pragma unroll
        for (int ai = 0; ai < 2; ++ai)
#pragma unroll
            for (int m = 0; m < 4; ++m) {
                const int rl = ai * HALF + wr * 64 + m * 16 + fr;
                const size_t off = (size_t)(u.pm * BM + rl) * DM + col0;
                float q = 0.f;
#pragma unroll
                for (int bj = 0; bj < 2; ++bj) {
                    const h8 hv = *(const h8*)(g.xh + off + bj * HALF);
                    const f32x4 x0 = (f32x4){(float)hv[0], (float)hv[1], (float)hv[2], (float)hv[3]} + acc[ai][bj][m][0] * g.rscale;
                    const f32x4 x1 = (f32x4){(float)hv[4], (float)hv[5], (float)hv[6], (float)hv[7]} + acc[ai][bj][m][1] * g.rscale;
                    u32x4 w; w.x = pkh(x0[0], x0[1]); w.y = pkh(x0[2], x0[3]); w.z = pkh(x1[0], x1[1]); w.w = pkh(x1[2], x1[3]);
                    *(u32x4*)(g.xh + off + bj * HALF) = w;
                    q += sq4(x0) + sq4(x1);
                }
                q += __shfl_xor(q, 16); q += __shfl_xor(q, 32);
                if (fq == 0) Pss[rl * 4 + wc] = q;
                if (m == 3) asm volatile("" ::: "memory");
            }
        asm volatile("s_waitcnt vmcnt(0) lgkmcnt(0)\n\ts_barrier" ::: "memory");
        unsigned char* wsq = a.ws; asm volatile("" : "+s"(wsq));
        unsigned* cntw = (unsigned*)(wsq + WS_CTL) + 8192 + 64 * u.pm;
        if (tid_ < 256) {
            const f32x4 p4 = *(const LAS f32x4*)(Pss + tid_ * 4);
            const float sv = (p4.x + p4.y) + (p4.z + p4.w);
            __hip_atomic_store((unsigned*)(g.ssout + (size_t)(u.pm * BM + tid_) * 4 + u.pn), __builtin_bit_cast(unsigned, sv), __ATOMIC_RELAXED, __HIP_MEMORY_SCOPE_AGENT);
            asm volatile("s_waitcnt vmcnt(0)" ::: "memory");
            if ((tid_ & 63) == 0) __hip_atomic_fetch_add(cntw, 1u, __ATOMIC_RELAXED, __HIP_MEMORY_SCOPE_AGENT);
        }
        if (tid_ < 64) {
            unsigned sp = 0;
            while ((unsigned)__builtin_amdgcn_readfirstlane(__hip_atomic_load(cntw, __ATOMIC_RELAXED, __HIP_MEMORY_SCOPE_AGENT)) < 16u) { __builtin_amdgcn_s_sleep(2); if (++sp > (1u << 22)) break; }
            __builtin_amdgcn_fence(__ATOMIC_ACQUIRE, "agent");
            asm volatile("s_waitcnt vmcnt(0)" ::: "memory");
        }
        asm volatile("s_waitcnt vmcnt(0) lgkmcnt(0)\n\ts_barrier" ::: "memory");
        if (tid_ < 256) {
            const unsigned* sl = (const unsigned*)(g.ssout + (size_t)(u.pm * BM + tid_) * 4);
            float sv = 0.f;
#pragma unroll
            for (int k = 0; k < 4; ++k) sv += __builtin_bit_cast(float, __hip_atomic_load(sl + k, __ATOMIC_RELAXED, __HIP_MEMORY_SCOPE_AGENT));
            Srs[tid_] = frsq(sv * (1.f / DM) + EPS);
        }
        asm volatile("s_waitcnt vmcnt(0) lgkmcnt(0)\n\ts_barrier" ::: "memory");
        int fr2 = fr, col2 = col0; asm volatile("" : "+v"(fr2), "+v"(col2));
        f32x4 gv[2][2];
#pragma unroll
        for (int bj = 0; bj < 2; ++bj)
#pragma unroll
            for (int n = 0; n < 2; ++n) gv[bj][n] = *(const f32x4*)(a.g_final + col2 + bj * HALF + n * 4);
#pragma unroll
        for (int ai = 0; ai < 2; ++ai)
#pragma unroll
            for (int m = 0; m < 4; ++m) {
                const int rl = ai * HALF + wr * 64 + m * 16 + fr2;
                const float rs = Srs[rl];
                const size_t off = (size_t)(u.pm * BM + rl) * DM + col2;
                asm volatile("" ::: "memory");
#pragma unroll
                for (int bj = 0; bj < 2; ++bj) { const h8 hv = *(const h8*)(g.xh + off + bj * HALF);
                    const f32x4 x0 = (f32x4){(float)hv[0], (float)hv[1], (float)hv[2], (float)hv[3]}, x1 = (f32x4){(float)hv[4], (float)hv[5], (float)hv[6], (float)hv[7]};
                    *(f32x4*)(g.xout + off + bj * HALF) = x0 * rs * gv[bj][0]; *(f32x4*)(g.xout + off + bj * HALF + 4) = x1 * rs * gv[bj][1]; }
            }
        asm volatile("s_waitcnt lgkmcnt(0)\n\ts_barrier" ::: "memory");
    } else if (g.epi == EPI_WIN && u.pn < 6) {
        const float sc = (u.pn < 2) ? 0.125f * LOG2E : 1.f;
#pragma unroll
        for (int ai = 0; ai < 2; ++ai)
#pragma unroll
            for (int mp = 0; mp < 2; ++mp) {
                f32x4 cv[2][2], sv[2][2];
#pragma unroll
                for (int k = 0; k < 2; ++k) { const int t_ = (row0 + ai * HALF + (2 * mp + k) * 16) & (SEQ - 1);
                    cv[k][0] = *(const f32x4*)(g.cos64 + t_ * 32 + 8 * fq); cv[k][1] = *(const f32x4*)(g.cos64 + t_ * 32 + 8 * fq + 4);
                    sv[k][0] = *(const f32x4*)(g.sin64 + t_ * 32 + 8 * fq); sv[k][1] = *(const f32x4*)(g.sin64 + t_ * 32 + 8 * fq + 4); }
#pragma unroll
                for (int k = 0; k < 2; ++k) { const int m = 2 * mp + k;
                    const int row = row0 + ai * HALF + m * 16;
                    const float rs = RST[rl0 + ai * HALF + m * 16] * sc;
                    f16* prow = g.oh + (size_t)row * NP + 256 * u.pn + 64 * wc + 8 * fq;
                    u32x4 w1, w2;
#pragma unroll
                    for (int bj = 0; bj < 2; ++bj) {
                        const f32x4 v0 = acc[ai][bj][m][0] * rs, v1 = acc[ai][bj][m][1] * rs;
                        const f32x4 o1 = v0 * cv[k][bj] - v1 * sv[k][bj], o2 = v0 * sv[k][bj] + v1 * cv[k][bj];
                        if (bj == 0) { w1.x = pkh(o1[0], o1[1]); w1.y = pkh(o1[2], o1[3]); w2.x = pkh(o2[0], o2[1]); w2.y = pkh(o2[2], o2[3]); }
                        else { w1.z = pkh(o1[0], o1[1]); w1.w = pkh(o1[2], o1[3]); w2.z = pkh(o2[0], o2[1]); w2.w = pkh(o2[2], o2[3]); }
                    }
                    *(u32x4*)prow = w1; *(u32x4*)(prow + 32) = w2;
                }
            }
    } else if (g.epi == EPI_WIN) {
        const int pn = u.pn;
#pragma unroll
        for (int ai = 0; ai < 2; ++ai) {
            f32x4 c64v[4], s64v[4];
            if (pn <= 6) {
#pragma unroll
                for (int m = 0; m < 4; ++m) { const int t_ = (row0 + ai * HALF + m * 16) & (SEQ - 1);
                    c64v[m] = *(const f32x4*)(g.cos64 + t_ * 32 + 16 * (wc & 1) + 4 * fq); s64v[m] = *(const f32x4*)(g.sin64 + t_ * 32 + 16 * (wc & 1) + 4 * fq); }
            }
#pragma unroll
            for (int m = 0; m < 4; ++m) {
                const int row = row0 + ai * HALF + m * 16;
                const int t = row & (SEQ - 1);
                const float rs = RST[rl0 + ai * HALF + m * 16];
                f16* prow = g.oh + (size_t)row * NP;
                float ssacc = 0.f;
#pragma unroll
                for (int bj = 0; bj < 2; ++bj) {
                    const f32x4 v0 = acc[ai][bj][m][0] * rs, v1 = acc[ai][bj][m][1] * rs;
                    int type, pcol;
                    float sc = 1.f;
                    if (pn < 6) { type = 0; pcol = 256 * pn + 128 * bj + 64 * (wc >> 1); if (pn < 2) sc = 0.125f * LOG2E; }
                    else if (pn == 6) {
                        if (bj == 0) { type = 0; pcol = PC_KA + 64 * (wc >> 1); }
                        else if (wc == 0) { type = 1; pcol = PC_KR; }
                        else if (wc < 3) { type = 2; pcol = PC_VA + 32 * (wc - 1); }
                        else { type = 3; pcol = 0; }
                    } else if (pn == 7) { type = 2; pcol = PC_CQ + 128 * bj + 32 * wc; }
                    else if (pn == 8) { if (bj == 0) { type = 2; pcol = PC_CQ + 256 + 32 * wc; } else { type = 4; pcol = 0; } }
                    else { type = 2; pcol = PC_CKV + 128 * bj + 32 * wc; }
                    if (type == 0) {
                        const int g2 = wc & 1;
                        const f32x4 c4 = c64v[m], s4 = s64v[m];
                        const f32x4 o1 = (v0 * c4 - v1 * s4) * sc, o2 = (v0 * s4 + v1 * c4) * sc;
                        u32x2 w1; w1.x = pkh(o1[0], o1[1]); w1.y = pkh(o1[2], o1[3]);
                        u32x2 w2; w2.x = pkh(o2[0], o2[1]); w2.y = pkh(o2[2], o2[3]);
                        *(u32x2*)(prow + pcol + 16 * g2 + 4 * fq) = w1;
                        *(u32x2*)(prow + pcol + 32 + 16 * g2 + 4 * fq) = w2;
                    } else if (type == 1) {
                        const f32x4 c4 = *(const f32x4*)(g.cos32 + t * 16 + 4 * fq), s4 = *(const f32x4*)(g.sin32 + t * 16 + 4 * fq);
                        const f32x4 o1 = v0 * c4 - v1 * s4, o2 = v0 * s4 + v1 * c4;
                        u32x2 w1; w1.x = pkh(o1[0], o1[1]); w1.y = pkh(o1[2], o1[3]);
                        u32x2 w2; w2.x = pkh(o2[0], o2[1]); w2.y = pkh(o2[2], o2[3]);
                        *(u32x2*)(prow + pcol + 4 * fq) = w1;
                        *(u32x2*)(prow + pcol + 16 + 4 * fq) = w2;
                    } else if (type == 2) {
                        u32x4 w; w.x = pkh(v0[0], v0[1]); w.y = pkh(v0[2], v0[3]); w.z = pkh(v1[0], v1[1]); w.w = pkh(v1[2], v1[3]);
                        *(u32x4*)(prow + pcol + 8 * fq) = w;
                        ssacc += sq4(v0) + sq4(v1);
                    } else if (type == 3) {
                        *(f32x4*)(g.wi + (size_t)row * 16 + 4 * fq) = v0;
                    }
                }
                if (pn >= 7) {
                    ssacc += __shfl_xor(ssacc, 16); ssacc += __shfl_xor(ssacc, 32);
                    if (fq == 0) {
                        if (pn == 7) g.ssq[(size_t)row * 8 + wc] = ssacc;
                        else if (pn == 8) g.ssq[(size_t)row * 8 + 4 + wc] = ssacc;
                        else g.sskv[(size_t)row * 4 + wc] = ssacc;
                    }
                }
            }
        }
    } else if (g.epi == EPI_QUP) {
        const float c2b = 0.10206207261596577f * LOG2E;
#pragma unroll
        for (int ai = 0; ai < 2; ++ai)
#pragma unroll
            for (int m = 0; m < 4; ++m) {
                const int row = row0 + ai * HALF + m * 16;
                const int t = row & (SEQ - 1);
                const float rs = RST[rl0 + ai * HALF + m * 16] * c2b;
                f16* prow = g.oh + (size_t)row * NQB;
#pragma unroll
                for (int bj = 0; bj < 2; ++bj) {
                    const f32x4 v0 = acc[ai][bj][m][0] * rs, v1 = acc[ai][bj][m][1] * rs;
                    if (u.pn < 2) {
                        u32x4 w; w.x = pkh(v0[0], v0[1]); w.y = pkh(v0[2], v0[3]); w.z = pkh(v1[0], v1[1]); w.w = pkh(v1[2], v1[3]);
                        *(u32x4*)(prow + 256 * u.pn + 128 * bj + 32 * wc + 8 * fq) = w;
                    } else {
                        const int head = 4 * bj + wc;
                        const f32x4 c4 = *(const f32x4*)(g.cos32 + t * 16 + 4 * fq), s4 = *(const f32x4*)(g.sin32 + t * 16 + 4 * fq);
                        const f32x4 o1 = v0 * c4 - v1 * s4, o2 = v0 * s4 + v1 * c4;
                        u32x2 w1; w1.x = pkh(o1[0], o1[1]); w1.y = pkh(o1[2], o1[3]);
                        u32x2 w2; w2.x = pkh(o2[0], o2[1]); w2.y = pkh(o2[2], o2[3]);
                        *(u32x2*)(prow + 512 + 32 * head + 4 * fq) = w1;
                        *(u32x2*)(prow + 512 + 32 * head + 16 + 4 * fq) = w2;
                    }
                }
            }
    } else {
#pragma unroll
        for (int ai = 0; ai < 2; ++ai)
#pragma unroll
            for (int m = 0; m < 4; ++m) {
                const int row = row0 + ai * HALF + m * 16;
                const float rs = RST[rl0 + ai * HALF + m * 16];
                f16* prow = g.oh + (size_t)row * NKV;
#pragma unroll
                for (int bj = 0; bj < 2; ++bj) {
                    const f32x4 v0 = acc[ai][bj][m][0] * rs, v1 = acc[ai][bj][m][1] * rs;
                    u32x4 w; w.x = pkh(v0[0], v0[1]); w.y = pkh(v0[2], v0[3]); w.z = pkh(v1[0], v1[1]); w.w = pkh(v1[2], v1[3]);
                    *(u32x4*)(prow + 256 * u.pn + 128 * bj + 32 * wc + 8 * fq) = w;
                }
            }
    }
}

__device__ __forceinline__ void gemm_phase(LAS unsigned char* lds, const Args& args, const int gi, const GemmDesc& g, const StaticOrder& S) {
    const int tid = opaque_tid(), wid = __builtin_amdgcn_readfirstlane(tid >> 6), lane = tid & 63, wr = wid >> 2, wc = wid & 3, fr = lane & 15, fq = lane >> 4;
    const int K = g.K, nt = K / BK, lda = g.lda;
    unsigned voffA[2], voffB[2];
#pragma unroll
    for (int i = 0; i < 2; ++i) { int R, C; stage_rc(tid * 16 + i * 8192, R, C);
        voffA[i] = (unsigned)(R * lda + C) * 2u; voffB[i] = (unsigned)(R * K + C) * 2u; }
    const size_t kstep = (size_t)(BK * 2);
    const size_t hstepA = (size_t)HALF * lda * 2, hstepB = (size_t)HALF * K * 2;
    const size_t tstepA = 2 * hstepA, tstepB = 2 * hstepB;
    const unsigned ldsw = (unsigned)wid * 1024u;
    const int aoff = lds_byte(wr * 64 + fr, fq * 8), boff = lds_byte(wc * 32 + fr, fq * 8);
#define PG8_SA(b, h) (((b) * 2 + (h)) * HTB)
#define PG8_SB(b, h) ((4 + (b) * 2 + (h)) * HTB)
#define PG8_STAGE(bufoff, gbase, voff) do { _Pragma("unroll") for (int _i = 0; _i < 2; ++_i) \
        __builtin_amdgcn_global_load_lds((const unsigned*)((const char*)(gbase) + (voff)[_i]), (LAS unsigned*)(lds + (bufoff) + ldsw + _i * 8192), 16, 0, 0); } while (0)
#define PG8_LDA(dst, b, h) do { _Pragma("unroll") for (int m = 0; m < 4; ++m) _Pragma("unroll") for (int k = 0; k < 2; ++k) dst[m][k] = *(const LAS h8*)(lds + PG8_SA(b, h) + aoff + m * 2048 + k * 1024); } while (0)
#define PG8_LDB(dst, b, h) do { _Pragma("unroll") for (int n = 0; n < 2; ++n) _Pragma("unroll") for (int k = 0; k < 2; ++k) dst[n][k] = *(const LAS h8*)(lds + PG8_SB(b, h) + boff + n * 2048 + k * 1024); } while (0)
#define PG8_MMA(ai, bj, At, Bt) do { __builtin_amdgcn_s_setprio(1); _Pragma("unroll") for (int m = 0; m < 4; ++m) _Pragma("unroll") for (int n = 0; n < 2; ++n) _Pragma("unroll") for (int k = 0; k < 2; ++k) \
        acc[ai][bj][m][n] = __builtin_amdgcn_mfma_f32_16x16x32_f16(Bt[n][k], At[m][k], acc[ai][bj][m][n], 0, 0, 0); __builtin_amdgcn_s_setprio(0); } while (0)
#define PG8_WAIT_V(n) asm volatile("s_waitcnt vmcnt(" #n ")" ::: "memory")
#define PG8_WAIT_L(n) asm volatile("s_waitcnt lgkmcnt(" #n ")" ::: "memory")
#define PG8_BAR __builtin_amdgcn_s_barrier()
#define PG8_SCHED __builtin_amdgcn_sched_barrier(0)
    Unit cur, nxt; int ui = 0;
    if (!S.next(0, cur)) return;
    f32x4 acc[2][2][4][2];
#pragma unroll
    for (int a = 0; a < 2; ++a)
#pragma unroll
        for (int b = 0; b < 2; ++b)
#pragma unroll
            for (int m = 0; m < 4; ++m)
#pragma unroll
                for (int n = 0; n < 2; ++n) acc[a][b][m][n] = (f32x4){0.f, 0.f, 0.f, 0.f};
    h8 At[4][2], B0[2][2], B1[2][2];
    LAS float* RSTw = (LAS float*)(lds + LDSCTL_OFF + 7168);
    if (g.ss && tid < 256) RSTw[tid] = row_rstd_rt(g.ss, g.nss, cur.pm * BM + tid, g.invn);
    const char* cA = (const char*)g.A + (size_t)cur.pm * tstepA; const char* cB = (const char*)g.Bt + (size_t)cur.pn * tstepB;
    PG8_STAGE(PG8_SB(0, 0), cB, voffB); PG8_STAGE(PG8_SB(0, 1), cB + hstepB, voffB); PG8_STAGE(PG8_SA(0, 0), cA, voffA); PG8_STAGE(PG8_SA(0, 1), cA + hstepA, voffA);
    if (wr == 1) PG8_BAR;
    PG8_WAIT_V(2); PG8_BAR;
    PG8_STAGE(PG8_SB(1, 0), cB + kstep, voffB); PG8_STAGE(PG8_SA(1, 0), cA + kstep, voffA); PG8_STAGE(PG8_SB(1, 1), cB + hstepB + kstep, voffB);
    PG8_WAIT_V(6); PG8_BAR;
    for (;;) {
        const bool has_next = S.next(ui + 1, nxt);
        const char* nA = has_next ? (const char*)g.A + (size_t)nxt.pm * tstepA : cA; const char* nB = has_next ? (const char*)g.Bt + (size_t)nxt.pn * tstepB : cB;
        for (int t = 0; t < nt; t += 2) {
            const bool last = (t == nt - 2);
            const char* a1 = cA + (size_t)(t + 1) * kstep;
            const char* a2 = last ? nA : cA + (size_t)(t + 2) * kstep; const char* b2 = last ? nB : cB + (size_t)(t + 2) * kstep;
            const char* a3 = a2 + kstep; const char* b3 = b2 + kstep;
            PG8_LDB(B0, 0, 0); PG8_LDB(B1, 0, 1); PG8_SCHED; PG8_LDA(At, 0, 0); PG8_STAGE(PG8_SA(1, 1), a1 + hstepA, voffA);
            PG8_WAIT_V(8); PG8_WAIT_L(0); PG8_BAR; PG8_MMA(0, 0, At, B0); PG8_MMA(0, 1, At, B1); PG8_BAR; PG8_SCHED;
            PG8_LDA(At, 0, 1); PG8_STAGE(PG8_SB(0, 0), b2, voffB); PG8_STAGE(PG8_SB(0, 1), b2 + hstepB, voffB); PG8_STAGE(PG8_SA(0, 0), a2, voffA);
            PG8_WAIT_V(8); PG8_WAIT_L(0); PG8_BAR; PG8_MMA(1, 0, At, B0); PG8_MMA(1, 1, At, B1); PG8_BAR; PG8_SCHED;
            PG8_LDB(B0, 1, 0); PG8_LDB(B1, 1, 1); PG8_SCHED; PG8_LDA(At, 1, 0); PG8_STAGE(PG8_SA(0, 1), a2 + hstepA, voffA);
            PG8_WAIT_V(8); PG8_WAIT_L(0); PG8_BAR; PG8_MMA(0, 0, At, B0); PG8_MMA(0, 1, At, B1); PG8_BAR; PG8_SCHED;
            PG8_LDA(At, 1, 1); PG8_STAGE(PG8_SB(1, 0), b3, voffB); PG8_STAGE(PG8_SB(1, 1), b3 + hstepB, voffB); PG8_STAGE(PG8_SA(1, 0), a3, voffA);
            PG8_WAIT_V(8); PG8_WAIT_L(0); PG8_BAR; PG8_MMA(1, 0, At, B0); PG8_MMA(1, 1, At, B1); PG8_BAR; PG8_SCHED;
        }
        if (wr == 0) PG8_BAR;
        epilogue(args, gi, acc, cur, wr, wc, fr, fq, lds, ui & 1);
        if (!has_next) break;
#pragma unroll
        for (int a = 0; a < 2; ++a)
#pragma unroll
            for (int b = 0; b < 2; ++b)
#pragma unroll
                for (int m = 0; m < 4; ++m)
#pragma unroll
                    for (int n = 0; n < 2; ++n) acc[a][b][m][n] = (f32x4){0.f, 0.f, 0.f, 0.f};
        cur = nxt; cA = nA; cB = nB; ++ui;
        if (g.ss && tid < 256) RSTw[(ui & 1) * 256 + tid] = row_rstd_rt(g.ss, g.nss, cur.pm * BM + tid, g.invn);
        if (wr == 1) PG8_BAR;
    }
    PG8_WAIT_V(0);
    PG8_BAR;
#undef PG8_SA
#undef PG8_SB
#undef PG8_STAGE
#undef PG8_LDA
#undef PG8_LDB
#undef PG8_MMA
#undef PG8_WAIT_V
#undef PG8_WAIT_L
#undef PG8_BAR
#undef PG8_SCHED
}
__device__ __forceinline__ void make_gemm(const Args& a, int gi, GemmDesc& g) {
    unsigned char* ws = a.ws; const float* ax = a.x; float* aout = a.out;
    asm volatile("" : "+s"(ws), "+s"(ax), "+s"(aout));
    float* rope = (float*)(ws + WS_ROPE);
    g.M = M; g.ss = nullptr; g.nss = 1; g.invn = 1.f / DM; g.oh = nullptr; g.ldo = 0; g.xin = nullptr; g.xout = nullptr; g.xh = nullptr; g.ssout = nullptr; g.rscale = 1.f;
    g.cos64 = rope; g.sin64 = rope + SEQ * 32; g.cos32 = rope + SEQ * 64; g.sin32 = rope + SEQ * 64 + SEQ * 16;
    g.wi = (float*)(ws + WS_WI); g.ssq = (float*)(ws + WS_SSQ); g.sskv = (float*)(ws + WS_SSKV);
    switch (gi) {
        case G_FFN1A: g.A = (const f16*)(ws + WS_XH); g.Bt = (const f16*)(ws + WS_BT1); g.N = NFF; g.K = DM; g.lda = DM; g.epi = EPI_SWIGLU;
            g.ss = (const float*)(ws + WS_SS0); g.nss = 1; g.oh = (f16*)(ws + WS_H); break;
        case G_FFN1B: g.A = (const f16*)(ws + WS_H); g.Bt = (const f16*)(ws + WS_BTD1); g.N = DM; g.K = DFF; g.lda = DFF; g.epi = EPI_RESID;
            g.xin = nullptr; g.xout = aout; g.xh = (f16*)(ws + WS_XH); g.ssout = (float*)(ws + WS_SS16); g.rscale = 0.5f; break;
        case G_WIN: g.A = (const f16*)(ws + WS_XH); g.Bt = (const f16*)(ws + WS_BTIN); g.N = NP; g.K = DM; g.lda = DM; g.epi = EPI_WIN;
            g.ss = (const float*)(ws + WS_SS16); g.nss = 16; g.oh = (f16*)(ws + WS_P); break;
        case G_QUP: g.A = (const f16*)(ws + WS_P) + PC_CQ; g.Bt = (const f16*)(ws + WS_BTQ); g.N = NQB; g.K = QLORA; g.lda = NP; g.epi = EPI_QUP;
            g.ss = (const float*)(ws + WS_SSQ); g.nss = 8; g.invn = 1.f / QLORA; g.oh = (f16*)(ws + WS_QB); break;
        case G_KVUP: g.A = (const f16*)(ws + WS_P) + PC_CKV; g.Bt = (const f16*)(ws + WS_BTKV); g.N = NKV; g.K = KVLORA; g.lda = NP; g.epi = EPI_KVUP;
            g.ss = (const float*)(ws + WS_SSKV); g.nss = 4; g.invn = 1.f / KVLORA; g.oh = (f16*)(ws + WS_KV); break;
        case G_WOUT: g.A = (const f16*)(ws + WS_MIX); g.Bt = (const f16*)(ws + WS_BTOUT); g.N = DM; g.K = DM; g.lda = DM; g.epi = EPI_RESID;
            g.xin = nullptr; g.xout = aout; g.xh = (f16*)(ws + WS_XH); g.ssout = (float*)(ws + WS_SS16); g.rscale = 1.f; break;
        case G_FFN2A: g.A = (const f16*)(ws + WS_XH); g.Bt = (const f16*)(ws + WS_BT2); g.N = NFF; g.K = DM; g.lda = DM; g.epi = EPI_SWIGLU;
            g.ss = (const float*)(ws + WS_SS16); g.nss = 16; g.oh = (f16*)(ws + WS_H); break;
        default: g.A = (const f16*)(ws + WS_H); g.Bt = (const f16*)(ws + WS_BTD2); g.N = DM; g.K = DFF; g.lda = DFF; g.epi = (FUSE_FINAL && gridDim.x == 256) ? EPI_FINAL : EPI_RESID;
            g.xin = nullptr; g.xout = aout; g.xh = (f16*)(ws + WS_XH); g.ssout = (float*)(ws + WS_SS16); g.rscale = 0.5f; break;
    }
}

}

struct Frame {
    LAS unsigned char* lds;
    int tid, lane, wave, vcu, G;
};

__device__ __forceinline__ bool prep_rowmap(const Args& a, int mat, int R, const float*& W, int& col, int& N) {
    using pg8::perm32;
    switch (mat) {
        case 0: case 2: { const int pn_ = R >> 8, rr = R & 255, bj = rr >> 7, wc_ = (rr >> 5) & 3, n = (rr >> 4) & 1, fq_ = (rr >> 2) & 3; col = 128 * pn_ + 32 * wc_ + 8 * fq_ + 4 * bj + (rr & 3); N = DFF;
            W = (mat == 0) ? (n ? a.w1_up : a.w1_gate) : (n ? a.w2_up : a.w2_gate); return true; }
        case 1: W = a.w1_down; col = (R & ~31) + perm32(R & 31); N = DM; return true;
        case 3: W = a.w2_down; col = (R & ~31) + perm32(R & 31); N = DM; return true;
        case 4: { W = a.w_in; N = DPROJ;
            if (R < PC_KR) {
                int base, rr;
                if (R < PC_KA) {
                    if (R < PC_QI) { base = WC_QA; rr = R; } else { base = WC_QI; rr = R - PC_QI; }
                    const int tl = rr >> 8, sl = rr & 255, bj = sl >> 7, wc_ = (sl >> 5) & 3, n = (sl >> 4) & 1, fq_ = (sl >> 2) & 3;
                    col = base + (4 * tl + wc_) * 64 + 32 * n + 8 * fq_ + 4 * bj + (sl & 3); return true; }
                if (R < PC_KI) { base = WC_KA; rr = R - PC_KA; } else { base = WC_KI; rr = R - PC_KI; }
                const int h = rr >> 6, w = rr & 63, g2 = w >> 5, n = (w >> 4) & 1, j = w & 15;
                col = base + h * 64 + 32 * n + 16 * g2 + j; return true; }
            if (R < PC_VA) { col = WC_KR + (R - PC_KR); return true; }
            if (R < PC_WI) { const int rr = R - PC_VA; col = WC_VA + (rr & ~31) + perm32(rr & 31); return true; }
            if (R < PC_WI + 16) { col = WC_WI + (R - PC_WI); return true; }
            if (R < PC_CQ) return false;
            if (R < PC_CQ + QLORA) { const int rr = R - PC_CQ; col = WC_CQ + (rr & ~31) + perm32(rr & 31); return true; }
            if (R < PC_CKV) return false;
            { const int rr = R - PC_CKV; col = WC_CKV + (rr & ~31) + perm32(rr & 31); return true; } }
        case 5: { W = a.w_uq; N = 768;
            if (R < 512) { const int Rp = (R & ~31) + perm32(R & 31); col = (Rp >> 6) * 96 + (Rp & 63); }
            else { const int rr = R - 512; col = (rr >> 5) * 96 + 64 + (rr & 31); }
            return true; }
        case 6: { W = a.w_ukv; N = 1024;
            const int rr = R & 511, Rp = (rr & ~31) + perm32(rr & 31);
            col = (Rp >> 6) * 128 + (R >= 512 ? 64 : 0) + (Rp & 63); return true; }
        default: W = a.w_out; col = (R & ~31) + perm32(R & 31); N = DM; return true;
    }
}
__device__ __forceinline__ void prep_item(const Args& a, int mat, int K, const float* gain, f16* Bt, LAS float* scr, int item, int lane) {
    const int nkb = K / 64, rb = item / nkb, kb = item % nkb, k0 = 64 * kb, R0 = 32 * rb;
    const float* W; int col, N;
    const int cg = lane & 7, kr = lane >> 3;
    const bool valid = prep_rowmap(a, mat, R0 + 4 * cg, W, col, N);
#pragma unroll
    for (int i = 0; i < 8; ++i) { const int kk = 8 * i + kr;
        f32x4 v = (f32x4){0.f, 0.f, 0.f, 0.f};
        if (valid) { v = *(const f32x4*)(W + (size_t)(k0 + kk) * N + col); if (gain) v = v * gain[k0 + kk]; }
        LAS float* d = scr + kk * 33 + 4 * cg; d[0] = v.x; d[1] = v.y; d[2] = v.z; d[3] = v.w; }
    LDS_WAIT(); asm volatile("" ::: "memory");
    const int c = lane & 7;
#pragma unroll
    for (int j = 0; j < 4; ++j) { const int n = (lane >> 3) + 8 * j; const LAS float* s = scr + (8 * c) * 33 + n;
        u32x4 o; o.x = pkh(s[0 * 33], s[1 * 33]); o.y = pkh(s[2 * 33], s[3 * 33]); o.z = pkh(s[4 * 33], s[5 * 33]); o.w = pkh(s[6 * 33], s[7 * 33]);
        *(u32x4*)(Bt + (size_t)(R0 + n) * K + k0 + 8 * c) = o; }
    LDS_WAIT(); asm volatile("" ::: "memory");
}
__device__ __forceinline__ void prep_phase(const Args& a, Frame& F) {
    unsigned char* ws = a.ws;
    LAS float* scr = (LAS float*)(F.lds + F.wave * 16384);
    const int gw = F.vcu * NWAVES + F.wave, NGW = F.G * NWAVES;
    constexpr int I0 = 16 * (NFF / 32), I1 = (DFF / 64) * 32, I4 = 16 * (NP / 32), I5 = (QLORA / 64) * (NQB / 32), I6 = (KVLORA / 64) * (NKV / 32), I7 = 16 * 32;
    constexpr int NITEMS = 2 * I0 + 2 * I1 + I4 + I5 + I6 + I7;
    for (int it = gw; it < NITEMS; it += NGW) {
        int r = it;
        if (r < I0) { prep_item(a, 0, DM, a.g_ffn1, (f16*)(ws + WS_BT1), scr, r, F.lane); continue; } r -= I0;
        if (r < I1) { prep_item(a, 1, DFF, nullptr, (f16*)(ws + WS_BTD1), scr, r, F.lane); continue; } r -= I1;
        if (r < I0) { prep_item(a, 2, DM, a.g_ffn2, (f16*)(ws + WS_BT2), scr, r, F.lane); continue; } r -= I0;
        if (r < I1) { prep_item(a, 3, DFF, nullptr, (f16*)(ws + WS_BTD2), scr, r, F.lane); continue; } r -= I1;
        if (r < I4) { prep_item(a, 4, DM, a.g_mix, (f16*)(ws + WS_BTIN), scr, r, F.lane); continue; } r -= I4;
        if (r < I5) { prep_item(a, 5, QLORA, a.g_q_lat, (f16*)(ws + WS_BTQ), scr, r, F.lane); continue; } r -= I5;
        if (r < I6) { prep_item(a, 6, KVLORA, a.g_kv_lat, (f16*)(ws + WS_BTKV), scr, r, F.lane); continue; } r -= I6;
        prep_item(a, 7, DM, nullptr, (f16*)(ws + WS_BTOUT), scr, r, F.lane);
    }
    {
        f16* XH = (f16*)(ws + WS_XH); float* SS0 = (float*)(ws + WS_SS0);
        for (int m = gw; m < M; m += NGW) {
            const f32x4* xr = (const f32x4*)(a.x + (size_t)m * DM) + F.lane;
            f32x4 v[4]; float s = 0.f;
#pragma unroll
            for (int j = 0; j < 4; ++j) { v[j] = xr[64 * j]; s += sq4(v[j]); }
            s = wave_sum(s);
            u32x2* o8 = (u32x2*)(XH + (size_t)m * DM) + F.lane;
#pragma unroll
            for (int j = 0; j < 4; ++j) { u32x2 w; w.x = pkh(v[j].x, v[j].y); w.y = pkh(v[j].z, v[j].w); o8[64 * j] = w; }
            if (F.lane == 0) SS0[m] = s;
        }
    }
    {
        float* c64 = (float*)(ws + WS_ROPE); float* s64 = c64 + SEQ * 32; float* c32 = s64 + SEQ * 32; float* s32 = c32 + SEQ * 16;
        const int gt = (F.vcu * NWAVES + F.wave) * 64 + F.lane, NT = F.G * NWAVES * 64;
        for (int e = gt; e < SEQ * 48; e += NT) {
            const int t = e / 48, j = e % 48;
            const double ex = (j < 32) ? -(double)(2 * j) / 64.0 : -(double)(2 * (j - 32)) / 32.0;
            const double xx = ex * 13.287712379549449;
            const double nf = __builtin_floor(xx), ff = (xx - nf) * 0.69314718055994530942;
            double pe = 1.0 / 1307674368000.0;
#pragma unroll
            for (int kk = 14; kk >= 1; --kk) { double fact = 1.0; for (int q2 = 2; q2 <= kk; ++q2) fact *= (double)q2; pe = pe * ff + 1.0 / fact; }
            pe = pe * ff + 1.0;
            const float inv = (float)__builtin_ldexp(pe, (int)nf);
            const float angf = (float)t * inv;
            const double ang = (double)angf;
            const double kq = __builtin_rint(ang * 0.63661977236758134308);
            double r = __builtin_fma(-kq, 1.57079632679489655800, ang);
            r = __builtin_fma(-kq, 6.12323399573676603587e-17, r);
            const double r2 = r * r;
            double sn = -1.0 / 6227020800.0; sn = sn * r2 + 1.0 / 39916800.0; sn = sn * r2 - 1.0 / 362880.0; sn = sn * r2 + 1.0 / 5040.0; sn = sn * r2 - 1.0 / 120.0; sn = sn * r2 + 1.0 / 6.0; sn = -sn * r2 * r + r;
            double cs = 1.0 / 479001600.0; cs = cs * r2 - 1.0 / 3628800.0; cs = cs * r2 + 1.0 / 40320.0; cs = cs * r2 - 1.0 / 720.0; cs = cs * r2 + 1.0 / 24.0; cs = cs * r2 - 0.5; cs = cs * r2 + 1.0;
            const int q = ((int)kq) & 3;
            const double S = (q == 0) ? sn : (q == 1) ? cs : (q == 2) ? -sn : -cs;
            const double C = (q == 0) ? cs : (q == 1) ? -sn : (q == 2) ? -cs : sn;
            if (j < 32) { c64[t * 32 + j] = (float)C; s64[t * 32 + j] = (float)S; }
            else { c32[t * 16 + (j - 32)] = (float)C; s32[t * 16 + (j - 32)] = (float)S; }
        }
    }
}


namespace att {
constexpr int KSL = 12288, VSL = 8192, SLOT = KSL + VSL;
constexpr int WSF_OFF = 2 * SLOT, OST_OFF = WSF_OFF + 2048, ATT_LDS = OST_OFF + 8 * 4096;
static_assert(ATT_LDS <= RING_BYTES, "attention LDS");
typedef short v4i16_t __attribute__((ext_vector_type(4)));
__device__ __forceinline__ int crow(int r, int hi) { return (r & 3) + 8 * (r >> 2) + 4 * hi; }
__device__ __forceinline__ h4 vtr(const LAS unsigned char* p) { return __builtin_bit_cast(h4, __builtin_amdgcn_ds_read_tr16_b64_v4i16((LAS v4i16_t*)p)); }
__device__ __forceinline__ float hmax2(float a) { return fmaxf(a, __shfl_xor(a, 32)); }
__device__ __forceinline__ float hsum2(float a) { return a + __shfl_xor(a, 32); }
#define ATT_BAR() asm volatile("s_waitcnt vmcnt(0) lgkmcnt(0)\n\ts_barrier" ::: "memory")

template <int MODE>
__device__ __forceinline__ void attn_unit(const Args& a, LAS unsigned char* lds, int b, int h, int q0) {
    constexpr int ND = (MODE == 0) ? 6 : 4;
    constexpr float THR = 8.f;
    unsigned char* ws = a.ws; asm volatile("" : "+s"(ws));
    const f16* P = (const f16*)(ws + WS_P); const f16* QB = (const f16*)(ws + WS_QB); const f16* KV = (const f16*)(ws + WS_KV); f16* MIX = (f16*)(ws + WS_MIX);
    const unsigned* MASK = (const unsigned*)(ws + WS_MASK);
    const int tid = opaque_tid(), lane = tid & 63, r32 = lane & 31, hi = lane >> 5; const int w = __builtin_amdgcn_readfirstlane(tid >> 6);
    const size_t rowbase = (size_t)b * SEQ;
    const int qw = (MODE == 0) ? q0 + 32 * w : q0;
    const int NT = (MODE == 0) ? (q0 + 256) / 64 : (q0 + 32 + 63) / 64;
    LAS float* wsf = (LAS float*)(lds + WSF_OFF) + w * 64;
    auto dma = [&](int t, int s) {
        LAS unsigned char* ks = lds + s * SLOT; LAS unsigned char* vs = ks + KSL;
        const size_t krow = rowbase + 64 * t + lane, vrow = rowbase + 64 * t + 16 * (w & 3) + (lane >> 2);
        if (MODE == 0) {
            __builtin_amdgcn_global_load_lds((const unsigned*)(KV + krow * NKV + h * 64 + 8 * w), (LAS unsigned*)(ks + w * 1024), 16, 0, 0);
            if (w < 4) __builtin_amdgcn_global_load_lds((const unsigned*)(P + krow * NP + PC_KR + 8 * w), (LAS unsigned*)(ks + (8 + w) * 1024), 16, 0, 0);
            __builtin_amdgcn_global_load_lds((const unsigned*)(KV + vrow * NKV + 512 + h * 64 + (w >> 2) * 32 + (lane & 3) * 8), (LAS unsigned*)(vs + w * 1024), 16, 0, 0);
        } else {
            __builtin_amdgcn_global_load_lds((const unsigned*)(P + krow * NP + PC_KA + 8 * w), (LAS unsigned*)(ks + w * 1024), 16, 0, 0);
            __builtin_amdgcn_global_load_lds((const unsigned*)(P + vrow * NP + PC_VA + (w >> 2) * 32 + (lane & 3) * 8), (LAS unsigned*)(vs + w * 1024), 16, 0, 0);
        }
    };
    dma(0, 0);
    h8 qr[ND];
    if (MODE == 0) {
        const f16* qp = QB + (rowbase + qw + r32) * NQB;
#pragma unroll
        for (int d0 = 0; d0 < 4; ++d0) qr[d0] = *(const h8*)(qp + h * 64 + 16 * d0 + 8 * hi);
#pragma unroll
        for (int d0 = 4; d0 < ND; ++d0) qr[d0] = *(const h8*)(qp + 512 + h * 32 + 16 * (d0 - 4) + 8 * hi);
    } else {
        const f16* qp = P + (rowbase + qw + r32) * NP + PC_QA + w * 64;
#pragma unroll
        for (int d0 = 0; d0 < ND; ++d0) qr[d0] = *(const h8*)(qp + 16 * d0 + 8 * hi);
    }
    const unsigned* mp = MASK + ((rowbase + qw + r32) * 2 + hi) * 64;
    unsigned mw_next = (MODE == 1) ? mp[0] : 0u;
    float mhat = 0.f, lsum = 0.f;
    f32x16 o[2]; o[0] = f32x16{}; o[1] = f32x16{};
    f32x16 negm = f32x16{};
    const int vp0 = ((lane >> 4) & 1) * 32 + (lane & 3) * 8 + (4 * hi + ((lane & 15) >> 2)) * 64;
    for (int t = 0; t < NT; ++t) {
        ATT_BAR();
        if (t + 1 < NT) dma(t + 1, (t + 1) & 1);
        const unsigned mw = mw_next;
        if (MODE == 1 && t + 1 < NT) mw_next = mp[t + 1];
        if (MODE == 1 || 64 * t <= qw + 31) {
            const LAS unsigned char* ks = lds + (t & 1) * SLOT + hi * 1024 + r32 * 16; const LAS unsigned char* vs = lds + (t & 1) * SLOT + KSL + vp0;
            f32x16 p0 = negm, p1 = negm;
#pragma unroll
            for (int d0 = 0; d0 < ND; ++d0) {
                const h8 b0 = *(const LAS h8*)(ks + d0 * 2048), b1 = *(const LAS h8*)(ks + d0 * 2048 + 512);
                p0 = __builtin_amdgcn_mfma_f32_32x32x16_f16(b0, qr[d0], p0, 0, 0, 0);
                p1 = __builtin_amdgcn_mfma_f32_32x32x16_f16(b1, qr[d0], p1, 0, 0, 0);
            }
            if (MODE == 0 && 64 * t + 63 > qw) {
                const int qrow = qw + r32, kb = 64 * t + 4 * hi;
#pragma unroll
                for (int r = 0; r < 16; ++r) { const int kv = kb + (r & 3) + 8 * (r >> 2); if (kv > qrow) p0[r] = -INFINITY; if (kv + 32 > qrow) p1[r] = -INFINITY; }
            }
            float rm = fmaxf(fmaxf(p0[0], p1[0]), fmaxf(p0[1], p1[1]));
#pragma unroll
            for (int r = 2; r < 16; r += 2) rm = fmaxf(fmaxf(rm, p0[r]), fmaxf(p1[r], fmaxf(p0[r + 1], p1[r + 1])));
            rm = hmax2(rm);
            if (t == 0 || __any(rm > THR)) {
                const float dl = (t == 0) ? rm : fmaxf(rm, 0.f), f = (t == 0) ? 1.f : __builtin_amdgcn_exp2f(-dl);
                lsum *= f; mhat += dl;
#pragma unroll
                for (int r = 0; r < 16; ++r) { p0[r] -= dl; p1[r] -= dl; negm[r] = -mhat; }
                if (hi == 0) wsf[r32] = f;
                LDS_WAIT();
#pragma unroll
                for (int r = 0; r < 16; ++r) { const float fr_ = wsf[crow(r, hi)]; o[0][r] *= fr_; o[1][r] *= fr_; }
                LDS_WAIT();
            }
#pragma unroll
            for (int r = 0; r < 16; ++r) { p0[r] = __builtin_amdgcn_exp2f(p0[r]); p1[r] = __builtin_amdgcn_exp2f(p1[r]); }
            if (MODE == 1) {
#pragma unroll
                for (int r = 0; r < 16; ++r) {
                    p0[r] = ((mw >> (15 - r)) & 1u) ? p0[r] : 0.f;
                    p1[r] = ((mw >> (31 - r)) & 1u) ? p1[r] : 0.f;
                }
            }
            float sacc0 = 0.f, sacc1 = 0.f;
#pragma unroll
            for (int r = 0; r < 16; ++r) { sacc0 += p0[r]; sacc1 += p1[r]; }
            lsum += sacc0 + sacc1;
            h8 pa[4];
#pragma unroll
            for (int j = 0; j < 4; ++j) {
                const h2 a0 = __builtin_bit_cast(h2, __builtin_amdgcn_cvt_pkrtz(p0[2 * j], p0[2 * j + 1])), a1 = __builtin_bit_cast(h2, __builtin_amdgcn_cvt_pkrtz(p0[8 + 2 * j], p0[8 + 2 * j + 1]));
                const h2 a2 = __builtin_bit_cast(h2, __builtin_amdgcn_cvt_pkrtz(p1[2 * j], p1[2 * j + 1])), a3 = __builtin_bit_cast(h2, __builtin_amdgcn_cvt_pkrtz(p1[8 + 2 * j], p1[8 + 2 * j + 1]));
                pa[0][2 * j] = a0.x; pa[0][2 * j + 1] = a0.y; pa[1][2 * j] = a1.x; pa[1][2 * j + 1] = a1.y;
                pa[2][2 * j] = a2.x; pa[2][2 * j + 1] = a2.y; pa[3][2 * j] = a3.x; pa[3][2 * j + 1] = a3.y; }
#pragma unroll
            for (int d0 = 0; d0 < 2; ++d0)
#pragma unroll
                for (int k4 = 0; k4 < 4; ++k4) {
                    const h4 lo = vtr(vs + d0 * 4096 + k4 * 1024), hi4 = vtr(vs + d0 * 4096 + k4 * 1024 + 512);
                    const h8 vf = {lo[0], lo[1], lo[2], lo[3], hi4[0], hi4[1], hi4[2], hi4[3]};
                    o[d0] = __builtin_amdgcn_mfma_f32_32x32x16_f16(pa[k4], vf, o[d0], 0, 0, 0);
                }
        }
    }
    lsum = hsum2(lsum);
    if (hi == 0) wsf[32 + r32] = lsum;
    LDS_WAIT();
    float rli[16];
#pragma unroll
    for (int r = 0; r < 16; ++r) { const float lv = wsf[32 + crow(r, hi)]; rli[r] = lv > 0.f ? __builtin_amdgcn_rcpf(lv) : 0.f; }
    if (MK_DEBUG && hi == 0 && !(lsum > 0.f)) atomicAdd((unsigned*)(ws + WS_CTL) + 27, 1u);
    LAS f16* stg = (LAS f16*)(lds + OST_OFF) + w * 2048;
#pragma unroll
    for (int r = 0; r < 16; ++r) { const int orow = crow(r, hi);
#pragma unroll
        for (int d0 = 0; d0 < 2; ++d0) stg[orow * 64 + d0 * 32 + r32] = (f16)(o[d0][r] * rli[r]); }
    LDS_WAIT();
    f16* Ow = MIX + (rowbase + qw) * DM + ((MODE == 0) ? 512 + h * 64 : w * 64);
#pragma unroll
    for (int i = 0; i < 4; ++i) { const int row = i * 8 + (lane >> 3), ch = lane & 7; const u32x4 v = *(const LAS u32x4*)(stg + row * 64 + ch * 8); *(u32x4*)(Ow + (size_t)row * DM + ch * 8) = v; }
    ATT_BAR();
}


constexpr int P_KOFF = 0, P_VOFF = 3 * KSL, P_WSF = P_VOFF + 4 * VSL, P_OST = P_WSF + 2048, P_MSK = P_OST + 8 * 4096, P_LDS = P_MSK + 4 * 256;
static_assert(P_LDS <= RING_BYTES, "pipelined attention LDS");
#define AT_SB() __builtin_amdgcn_sched_barrier(0)
template <int MODE>
__device__ __forceinline__ void attn_unit_p(const Args& a, LAS unsigned char* lds, int b, int h, int q0) {
    constexpr int ND = (MODE == 0) ? 6 : 4, NQK = 2 * ND;
    constexpr float THR = 8.f;
    unsigned char* ws = a.ws; asm volatile("" : "+s"(ws));
    typedef const GAS f16* gp;
    gp P = (gp)(ws + WS_P); gp QB = (gp)(ws + WS_QB); gp KV = (gp)(ws + WS_KV); GAS f16* MIX = (GAS f16*)(ws + WS_MIX);
    const GAS unsigned* MASK = (const GAS unsigned*)(ws + WS_MASK);
    const int tid = opaque_tid(), lane = tid & 63, r32 = lane & 31, hi = lane >> 5; const int w = __builtin_amdgcn_readfirstlane(tid >> 6);
    const size_t rowbase = (size_t)b * SEQ;
    const int qw = (MODE == 0) ? q0 + 32 * w : q0;
    const int NT = (MODE == 0) ? (q0 + 256) / 64 : (q0 + 32 + 63) / 64;
    const int NTw = (MODE == 0) ? (qw + 31) / 64 + 1 : NT;
    LAS float* wsf = (LAS float*)(lds + P_WSF) + w * 64;
    auto dma = [&](int t) {
        LAS unsigned char* ks = lds + P_KOFF + (t % 3) * KSL; LAS unsigned char* vs = lds + P_VOFF + (t & 3) * VSL;
        int ln = lane; asm volatile("" : "+v"(ln));
        const size_t krow = rowbase + 64 * t + ln, vrow = rowbase + 64 * t + 16 * (w & 3) + (ln >> 2);
        if (MODE == 0) {
            __builtin_amdgcn_global_load_lds((const GAS unsigned*)(KV + krow * NKV + h * 64 + 8 * w), (LAS unsigned*)(ks + w * 1024), 16, 0, 0);
            if (w < 4) __builtin_amdgcn_global_load_lds((const GAS unsigned*)(P + krow * NP + PC_KR + 8 * w), (LAS unsigned*)(ks + (8 + w) * 1024), 16, 0, 0);
            __builtin_amdgcn_global_load_lds((const GAS unsigned*)(KV + vrow * NKV + 512 + h * 64 + (w >> 2) * 32 + (ln & 3) * 8), (LAS unsigned*)(vs + w * 1024), 16, 0, 0);
        } else {
            __builtin_amdgcn_global_load_lds((const GAS unsigned*)(P + krow * NP + PC_KA + 8 * w), (LAS unsigned*)(ks + w * 1024), 16, 0, 0);
            __builtin_amdgcn_global_load_lds((const GAS unsigned*)(P + vrow * NP + PC_VA + (w >> 2) * 32 + (ln & 3) * 8), (LAS unsigned*)(vs + w * 1024), 16, 0, 0);
            if (w == 0) __builtin_amdgcn_global_load_lds((const GAS unsigned*)(MASK + ((rowbase + qw + (ln & 31)) * 2 + (ln >> 5)) * 64 + t), (LAS unsigned*)(lds + P_MSK + (t & 3) * 256), 4, 0, 0);
        }
    };
    h8 qr[ND];
    if (MODE == 0) {
        gp qp = QB + (rowbase + qw + r32) * NQB;
#pragma unroll
        for (int d0 = 0; d0 < 4; ++d0) qr[d0] = *(const GAS h8*)(qp + h * 64 + 16 * d0 + 8 * hi);
#pragma unroll
        for (int d0 = 4; d0 < ND; ++d0) qr[d0] = *(const GAS h8*)(qp + 512 + h * 32 + 16 * (d0 - 4) + 8 * hi);
    } else {
        gp qp = P + (rowbase + qw + r32) * NP + PC_QA + w * 64;
#pragma unroll
        for (int d0 = 0; d0 < ND; ++d0) qr[d0] = *(const GAS h8*)(qp + 16 * d0 + 8 * hi);
    }
    asm volatile("" :: "v"(qr[0]), "v"(qr[ND - 1]));
    dma(0); if (NT > 1) dma(1);
    float mhat = 0.f, lsum = 0.f;
    f32x16 o[2]; o[0] = f32x16{}; o[1] = f32x16{};
    f32x16 negm = f32x16{};
    const int kfo = hi * 1024 + r32 * 16;
    const int vfo = ((lane >> 4) & 1) * 32 + (lane & 3) * 8 + (4 * hi + ((lane & 15) >> 2)) * 64;
    bool resc = false;
    f32x16 pA0, pA1, pB0, pB1;
    h4 vlo[3], vhi[3]; u32x4 pw[4];
    unsigned mw = 0u;
#define AT_CMASK(C0, C1, t) do { if (MODE == 0 && 64 * (t) + 63 > qw) { const int qrow = qw + r32, kb = 64 * (t) + 4 * hi; \
        _Pragma("unroll") for (int r = 0; r < 16; ++r) { const int kv = kb + (r & 3) + 8 * (r >> 2); if (kv > qrow) C0[r] = -INFINITY; if (kv + 32 > qrow) C1[r] = -INFINITY; } } } while (0)
#define AT_DECIDE(C0, C1, FIRST) do { float rm = fmaxf(fmaxf(C0[0], C1[0]), fmaxf(C0[1], C1[1])); \
        _Pragma("unroll") for (int r = 2; r < 16; r += 2) rm = fmaxf(fmaxf(rm, C0[r]), fmaxf(C1[r], fmaxf(C0[r + 1], C1[r + 1]))); \
        rm = hmax2(rm); resc = false; \
        if ((FIRST) || __any(rm > THR)) { const float dl = (FIRST) ? rm : fmaxf(rm, 0.f), f = (FIRST) ? 1.f : __builtin_amdgcn_exp2f(-dl); \
            lsum *= f; mhat += dl; \
            _Pragma("unroll") for (int r = 0; r < 16; ++r) { C0[r] -= dl; C1[r] -= dl; negm[r] = -mhat; } \
            if (!(FIRST)) { if (hi == 0) wsf[r32] = f; resc = true; } } } while (0)
#define AT_RESC() do { if (resc) { LDS_WAIT(); _Pragma("unroll") for (int r = 0; r < 16; ++r) { const float fr_ = wsf[crow(r, hi)]; o[0][r] *= fr_; o[1][r] *= fr_; } LDS_WAIT(); } } while (0)
#define AT_EXP4(C, R0) do { _Pragma("unroll") for (int r_ = (R0); r_ < (R0) + 4; ++r_) C[r_] = __builtin_amdgcn_exp2f(C[r_]); } while (0)
#define AT_EXPM4(C, R0, SH) do { float c0_ = C[(R0)], c1_ = C[(R0) + 1], c2_ = C[(R0) + 2], c3_ = C[(R0) + 3]; \
        const unsigned m0_ = (unsigned)((int)(mw << (31 - ((SH) - (R0)))) >> 31), m1_ = (unsigned)((int)(mw << (31 - ((SH) - (R0) - 1))) >> 31), m2_ = (unsigned)((int)(mw << (31 - ((SH) - (R0) - 2))) >> 31), m3_ = (unsigned)((int)(mw << (31 - ((SH) - (R0) - 3))) >> 31); \
        asm volatile("v_exp_f32 %0, %0\n\tv_exp_f32 %1, %1\n\tv_exp_f32 %2, %2\n\tv_exp_f32 %3, %3\n\tv_and_b32 %0, %0, %4\n\tv_and_b32 %1, %1, %5\n\tv_and_b32 %2, %2, %6\n\tv_and_b32 %3, %3, %7" \
            : "+v"(c0_), "+v"(c1_), "+v"(c2_), "+v"(c3_) : "v"(m0_), "v"(m1_), "v"(m2_), "v"(m3_)); \
        C[(R0)] = c0_; C[(R0) + 1] = c1_; C[(R0) + 2] = c2_; C[(R0) + 3] = c3_; } while (0)
#define AT_EX(C, R0, SH) do { if (MODE == 1) AT_EXPM4(C, R0, SH); else AT_EXP4(C, R0); } while (0)
#define AT_MSK4(C, R0, SH) do { } while (0)
#define AT_PK(P, J) __builtin_bit_cast(unsigned, __builtin_amdgcn_cvt_pkrtz(P[J], P[(J) + 1]))
#define AT_VIDX(i) ((((i) & 1) * 4) + ((i) >> 1))
#define AT_VRD(i, vsb) do { vlo[(i) % 3] = vtr((vsb) + (AT_VIDX(i) >> 2) * 4096 + (AT_VIDX(i) & 3) * 1024); vhi[(i) % 3] = vtr((vsb) + (AT_VIDX(i) >> 2) * 4096 + (AT_VIDX(i) & 3) * 1024 + 512); } while (0)
#define AT_VFR(i) ((h8){vlo[(i) % 3][0], vlo[(i) % 3][1], vlo[(i) % 3][2], vlo[(i) % 3][3], vhi[(i) % 3][0], vhi[(i) % 3][1], vhi[(i) % 3][2], vhi[(i) % 3][3]})
#define AT_PAF(k) __builtin_bit_cast(h8, pw[k])
#define AT_FIN(P0, P1, i, vsb) do { \
        if ((i) < 4) { sacc += (P0[4 * (i)] + P0[4 * (i) + 1]) + (P0[4 * (i) + 2] + P0[4 * (i) + 3]); pw[(i) >> 1][2 * ((i) & 1)] = AT_PK(P0, 4 * (i)); pw[(i) >> 1][2 * ((i) & 1) + 1] = AT_PK(P0, 4 * (i) + 2); asm volatile("" : "+v"(sacc)); asm volatile("" : "+v"(pw[(i) >> 1])); } \
        else { sacc += (P1[4 * ((i) - 4)] + P1[4 * ((i) - 4) + 1]) + (P1[4 * ((i) - 4) + 2] + P1[4 * ((i) - 4) + 3]); pw[2 + (((i) - 4) >> 1)][2 * ((i) & 1)] = AT_PK(P1, 4 * ((i) - 4)); pw[2 + (((i) - 4) >> 1)][2 * ((i) & 1) + 1] = AT_PK(P1, 4 * ((i) - 4) + 2); asm volatile("" : "+v"(sacc)); asm volatile("" : "+v"(pw[2 + (((i) - 4) >> 1)])); } } while (0)
#define AT_KRD(j, ksb) (*(const LAS h8*)((ksb) + ((j) >> 1) * 2048 + ((j) & 1) * 512))
#define AT_QKSLOT(C0, C1, P0, P1, j, ksb, vsb, FIN) do { \
        if ((j) + 4 < NQK) kfr[((j) + 4) % 5] = AT_KRD((j) + 4, ksb); \
        AT_SB(); \
        if (((j) & 1) == 0) C0 = __builtin_amdgcn_mfma_f32_32x32x16_f16(kfr[(j) % 5], qr[(j) >> 1], ((j) < 2) ? negm : C0, 0, 0, 0); \
        else C1 = __builtin_amdgcn_mfma_f32_32x32x16_f16(kfr[(j) % 5], qr[(j) >> 1], ((j) < 2) ? negm : C1, 0, 0, 0); \
        AT_SB(); \
        if ((FIN) && (j) < 8) AT_FIN(P0, P1, ((j) & 7), vsb); \
        AT_SB(); } while (0)
#define AT_QK(C0, C1, P0, P1, ksb, vsb, FIN) do { h8 kfr[5]; kfr[0] = AT_KRD(0, ksb); kfr[1] = AT_KRD(1, ksb); kfr[2] = AT_KRD(2, ksb); kfr[3] = AT_KRD(3, ksb); AT_SB(); \
        AT_QKSLOT(C0, C1, P0, P1, 0, ksb, vsb, FIN); AT_QKSLOT(C0, C1, P0, P1, 1, ksb, vsb, FIN); AT_QKSLOT(C0, C1, P0, P1, 2, ksb, vsb, FIN); AT_QKSLOT(C0, C1, P0, P1, 3, ksb, vsb, FIN); \
        AT_QKSLOT(C0, C1, P0, P1, 4, ksb, vsb, FIN); AT_QKSLOT(C0, C1, P0, P1, 5, ksb, vsb, FIN); AT_QKSLOT(C0, C1, P0, P1, 6, ksb, vsb, FIN); AT_QKSLOT(C0, C1, P0, P1, 7, ksb, vsb, FIN); \
        if (NQK > 8) { AT_QKSLOT(C0, C1, P0, P1, 8, ksb, vsb, FIN); AT_QKSLOT(C0, C1, P0, P1, 9, ksb, vsb, FIN); AT_QKSLOT(C0, C1, P0, P1, 10, ksb, vsb, FIN); AT_QKSLOT(C0, C1, P0, P1, 11, ksb, vsb, FIN); } } while (0)
#define AT_PVSLOT(C0, C1, i, DOEXP, vsb) do { o[(i) & 1] = __builtin_amdgcn_mfma_f32_32x32x16_f16(AT_PAF((i) >> 1), AT_VFR(i), o[(i) & 1], 0, 0, 0); AT_SB(); \
        if ((i) + 2 < 8) AT_VRD(((i) + 2) & 7, vsb); \
        if (DOEXP) { if ((i) < 4) { AT_EX(C0, 4 * (i), 15); asm volatile("" : "+v"(C0)); } else { AT_EX(C1, 4 * ((i) - 4), 31); asm volatile("" : "+v"(C1)); } } \
        AT_SB(); } while (0)
#define AT_PV(C0, C1, DOEXP, vsb) do { AT_VRD(0, vsb); AT_VRD(1, vsb); AT_SB(); AT_PVSLOT(C0, C1, 0, DOEXP, vsb); AT_PVSLOT(C0, C1, 1, DOEXP, vsb); AT_PVSLOT(C0, C1, 2, DOEXP, vsb); AT_PVSLOT(C0, C1, 3, DOEXP, vsb); \
        AT_PVSLOT(C0, C1, 4, DOEXP, vsb); AT_PVSLOT(C0, C1, 5, DOEXP, vsb); AT_PVSLOT(C0, C1, 6, DOEXP, vsb); AT_PVSLOT(C0, C1, 7, DOEXP, vsb); } while (0)
#define AT_STEP(C0, C1, P0, P1, t) do { \
        const LAS unsigned char* ksb_ = lds + P_KOFF + ((t) % 3) * KSL + kfo; const LAS unsigned char* vsb_ = lds + P_VOFF + (((t) - 1) & 3) * VSL + vfo; \
        if (MODE == 1) mw = *(const LAS unsigned*)(lds + P_MSK + ((t) & 3) * 256 + lane * 4); \
        float sacc = 0.f; \
        AT_QK(C0, C1, P0, P1, ksb_, vsb_, true); \
        lsum += sacc; \
        AT_CMASK(C0, C1, t); \
        AT_DECIDE(C0, C1, false); AT_SB(); \
        AT_PV(C0, C1, true, vsb_); \
        AT_RESC(); } while (0)
#define AT_DRAIN(P0, P1, t) do { const LAS unsigned char* vsb_ = lds + P_VOFF + (((t) - 1) & 3) * VSL + vfo; float sacc = 0.f; \
        AT_FIN(P0, P1, 0, vsb_); AT_FIN(P0, P1, 1, vsb_); AT_FIN(P0, P1, 2, vsb_); AT_FIN(P0, P1, 3, vsb_); AT_FIN(P0, P1, 4, vsb_); AT_FIN(P0, P1, 5, vsb_); AT_FIN(P0, P1, 6, vsb_); AT_FIN(P0, P1, 7, vsb_); \
        lsum += sacc; AT_SB(); AT_PV(P0, P1, false, vsb_); } while (0)

    const bool w3 = (MODE == 0) ? (w < 4) : (w == 0);
#define AT_WAITBAR(NEWER) do { if (NEWER) { if (w3) asm volatile("s_waitcnt vmcnt(3) lgkmcnt(0)\n\ts_barrier" ::: "memory"); else asm volatile("s_waitcnt vmcnt(2) lgkmcnt(0)\n\ts_barrier" ::: "memory"); } \
        else asm volatile("s_waitcnt vmcnt(0) lgkmcnt(0)\n\ts_barrier" ::: "memory"); } while (0)
    AT_WAITBAR(NT > 1);
    if (NT > 2) dma(2);
    {
        const LAS unsigned char* ksb_ = lds + P_KOFF + kfo; const LAS unsigned char* vsb_ = lds + P_VOFF + vfo;
        if (MODE == 1) mw = *(const LAS unsigned*)(lds + P_MSK + lane * 4);
        float sacc = 0.f;
        AT_QK(pA0, pA1, pA0, pA1, ksb_, vsb_, false);
        (void)sacc;
        AT_CMASK(pA0, pA1, 0);
        AT_DECIDE(pA0, pA1, true);
#pragma unroll
        for (int i = 0; i < 4; ++i) { AT_EX(pA0, 4 * i, 15); AT_EX(pA1, 4 * i, 31); }
    }
    AT_WAITBAR(NT > 2);
    int t = 1; bool lastB = false;
    for (; t + 1 < NTw; t += 2) {
        if (t + 2 < NT) dma(t + 2);
        AT_STEP(pB0, pB1, pA0, pA1, t);
        AT_WAITBAR(t + 2 < NT);
        if (t + 3 < NT) dma(t + 3);
        AT_STEP(pA0, pA1, pB0, pB1, t + 1);
        AT_WAITBAR(t + 3 < NT);
    }
    if (t < NTw) {
        if (t + 2 < NT) dma(t + 2);
        AT_STEP(pB0, pB1, pA0, pA1, t);
        AT_WAITBAR(t + 2 < NT);
        ++t; lastB = true;
    }
    if (lastB) { AT_DRAIN(pB0, pB1, t); } else { AT_DRAIN(pA0, pA1, t); }
    for (; t < NT; ++t) { if (t + 2 < NT) dma(t + 2); AT_WAITBAR(t + 2 < NT); }
    lsum = hsum2(lsum);
    if (hi == 0) wsf[32 + r32] = lsum;
    LDS_WAIT();
    float rli[16];
#pragma unroll
    for (int r = 0; r < 16; ++r) { const float lv = wsf[32 + crow(r, hi)]; rli[r] = lv > 0.f ? __builtin_amdgcn_rcpf(lv) : 0.f; }
    LAS f16* stg = (LAS f16*)(lds + P_OST) + w * 2048;
#pragma unroll
    for (int r = 0; r < 16; ++r) { const int orow = crow(r, hi);
#pragma unroll
        for (int d0 = 0; d0 < 2; ++d0) stg[orow * 64 + d0 * 32 + r32] = (f16)(o[d0][r] * rli[r]); }
    LDS_WAIT();
    GAS f16* Ow = MIX + (rowbase + qw) * DM + ((MODE == 0) ? 512 + h * 64 : w * 64);
#pragma unroll
    for (int i = 0; i < 4; ++i) { const int row = i * 8 + (lane >> 3), ch = lane & 7; const u32x4 v = *(const LAS u32x4*)(stg + row * 64 + ch * 8); *(GAS u32x4*)(Ow + (size_t)row * DM + ch * 8) = v; }
    ATT_BAR();
}

#ifndef ATT_PIPE
#define ATT_PIPE 1
#endif
template <int MODE> __device__ __forceinline__ void attn_phase(const Args& a, Frame& F) {
    for (int k = F.vcu; k < 1024; k += F.G) {
        const int i = k >> 8, c = k & 255;
        if (MODE == 0) { const int bh = c >> 2, j = c & 3; const int qb = (i == 0) ? j : (i == 1) ? 7 - j : (i == 2) ? 8 + j : 15 - j;
            if (ATT_PIPE) attn_unit_p<0>(a, F.lds, bh >> 3, bh & 7, qb * 256); else attn_unit<0>(a, F.lds, bh >> 3, bh & 7, qb * 256); }
        else { const int b = c >> 5, j = c & 31; const int u = (i == 0) ? j : (i == 1) ? 63 - j : (i == 2) ? 64 + j : 127 - j;
            if (ATT_PIPE) attn_unit_p<1>(a, F.lds, b, 0, u * 32); else attn_unit<1>(a, F.lds, b, 0, u * 32); }
    }
}
}


namespace idx {
constexpr int QL_OFF = 0;
constexpr int HIST_OFF = 69632;
constexpr int SEL_OFF = HIST_OFF, CAND_OFF = HIST_OFF + 16384;
__device__ __forceinline__ int selix(int row, int col) { return row * 64 + (col ^ ((row & 15) << 2)); }
constexpr int NH_OFF = 102400;
constexpr int QP_OFF = 104448;
constexpr int WSC_OFF = 105472;
constexpr int NCAP = 512;
static_assert(WSC_OFF + 8 * 3072 <= RING_BYTES, "indexer LDS");
constexpr float IDX_SCALE = 0.03125f;
using att::crow;
#define IDX_BAR() asm volatile("s_waitcnt vmcnt(0) lgkmcnt(0)\n\ts_barrier" ::: "memory")
__device__ __forceinline__ unsigned ordu(float f) { const unsigned u = __builtin_bit_cast(unsigned, f); return (u & 0x80000000u) ? ~u : (u | 0x80000000u); }

#define IDX_CHAIN(X, KT) do { X = __builtin_amdgcn_mfma_f32_32x32x16_f16(kf[KT][0], qf[0], zero16, 0, 0, 0); X = __builtin_amdgcn_mfma_f32_32x32x16_f16(kf[KT][1], qf[1], X, 0, 0, 0); \
        X = __builtin_amdgcn_mfma_f32_32x32x16_f16(kf[KT][2], qf[2], X, 0, 0, 0); X = __builtin_amdgcn_mfma_f32_32x32x16_f16(kf[KT][3], qf[3], X, 0, 0, 0); } while (0)
#define IDX_FMA4(XV, KTV, W, R0) do { _Pragma("unroll") for (int r_ = (R0); r_ < (R0) + 4; ++r_) { float t_ = __builtin_fmaf(__builtin_fabsf(XV[r_]), W, acc[KTV][r_]); asm("" : "+v"(t_)); acc[KTV][r_] = t_; } } while (0)
#define IDX_SLOT(XD, KT, KS, XV, KTV, W, R0, EXTRA) do { XD = __builtin_amdgcn_mfma_f32_32x32x16_f16(kf[KT][KS], qf[KS], XD, 0, 0, 0); __builtin_amdgcn_sched_barrier(0); EXTRA; IDX_FMA4(XV, KTV, W, R0); __builtin_amdgcn_sched_barrier(0); } while (0)
typedef const GAS f16* gf16p;
__device__ __forceinline__ void load_kf(h8 (&kf)[4][4], gf16p Pk, int r32, int hi) {
#pragma unroll
    for (int kt = 0; kt < 4; ++kt)
#pragma unroll
        for (int ks = 0; ks < 4; ++ks) kf[kt][ks] = *(const GAS h8*)(Pk + (size_t)(32 * kt + r32) * NP + 16 * ks + 8 * hi);
}
__device__ __forceinline__ void chunk_scores(const h8 (&kf)[4][4], const LAS unsigned char* QL, const LAS float* WH, int r32, int hi, f32x16 (&acc)[4]) {
    const LAS unsigned char* qb = QL + (hi * 32 + r32) * 16;
    const f32x16 zero16 = f32x16{};
    {
        h8 qf[4];
#pragma unroll
        for (int ks = 0; ks < 4; ++ks) qf[ks] = *(const LAS h8*)(qb + (16 * 8 + 2 * ks) * 512);
#pragma unroll
        for (int kt = 0; kt < 4; ++kt) IDX_CHAIN(acc[kt], kt);
    }
    f32x16 x0 = zero16, x1 = zero16, x2 = zero16, x3 = zero16; float wprev = 0.f;
    h8 qf[4];
#pragma unroll
    for (int ks = 0; ks < 4; ++ks) qf[ks] = *(const LAS h8*)(qb + (2 * ks) * 512);
    float wv = WH[r32];
#pragma unroll 1
    for (int h = 0; h < 16; ++h) {
        const LAS unsigned char* qn = qb + ((h + 1) * 8) * 512;
        float wnext;
        x0 = zero16; __builtin_amdgcn_sched_barrier(0);
        IDX_SLOT(x0, 0, 0, x2, 2, wprev, 8, (void)0);
        IDX_SLOT(x0, 0, 1, x2, 2, wprev, 12, (void)0);
        IDX_SLOT(x0, 0, 2, x3, 3, wprev, 0, (void)0);
        IDX_SLOT(x0, 0, 3, x3, 3, wprev, 4, x1 = zero16);
        IDX_SLOT(x1, 1, 0, x3, 3, wprev, 8, (void)0);
        IDX_SLOT(x1, 1, 1, x3, 3, wprev, 12, (void)0);
        IDX_SLOT(x1, 1, 2, x0, 0, wv, 0, (void)0);
        IDX_SLOT(x1, 1, 3, x0, 0, wv, 4, x2 = zero16);
        IDX_SLOT(x2, 2, 0, x0, 0, wv, 8, (void)0);
        IDX_SLOT(x2, 2, 1, x0, 0, wv, 12, (void)0);
        IDX_SLOT(x2, 2, 2, x1, 1, wv, 0, (void)0);
        IDX_SLOT(x2, 2, 3, x1, 1, wv, 4, x3 = zero16);
        IDX_SLOT(x3, 3, 0, x1, 1, wv, 8, qf[0] = *(const LAS h8*)(qn));
        IDX_SLOT(x3, 3, 1, x1, 1, wv, 12, qf[1] = *(const LAS h8*)(qn + 1024));
        IDX_SLOT(x3, 3, 2, x2, 2, wv, 0, qf[2] = *(const LAS h8*)(qn + 2048));
        IDX_SLOT(x3, 3, 3, x2, 2, wv, 4, qf[3] = *(const LAS h8*)(qn + 3072); wnext = WH[((h + 1) & 15) * 32 + r32]);
        wprev = wv; wv = wnext;
    }
    IDX_FMA4(x2, 2, wprev, 8); IDX_FMA4(x2, 2, wprev, 12); IDX_FMA4(x3, 3, wprev, 0); IDX_FMA4(x3, 3, wprev, 4); IDX_FMA4(x3, 3, wprev, 8); IDX_FMA4(x3, 3, wprev, 12);
}

__device__ __forceinline__ void tile_flags(const u32x4 p, unsigned Kgt, unsigned Kge, unsigned& gt, unsigned& ge) {
    unsigned Qg = 0u, Qe = 0u;
#pragma unroll
    for (int j = 3; j >= 0; --j) {
        const unsigned x = p[j];
        const unsigned e = x & 0x00FF00FFu, o = __builtin_amdgcn_perm(x, x, 0x0C030C01u);
        const unsigned Pg = __builtin_amdgcn_perm(o + Kgt, e + Kgt, 0x07030501u), Pe = __builtin_amdgcn_perm(o + Kge, e + Kge, 0x07030501u);
        Qg = (Qg << 1) | Pg; Qe = (Qe << 1) | Pe;
    }
    gt = Qg | (Qg >> 12); ge = Qe | (Qe >> 12);
}
__device__ __forceinline__ void idx_unit(const Args& a, LAS unsigned char* lds, int b, int u, int uslot) {
    unsigned char* ws = a.ws; asm volatile("" : "+s"(ws));
    gf16p P = (gf16p)(ws + WS_P); const GAS float* WI = (const GAS float*)(ws + WS_WI); GAS unsigned* MASK = (GAS unsigned*)(ws + WS_MASK);
    const int tid = opaque_tid(), lane = tid & 63, r32 = lane & 31, hi = lane >> 5; const int w = __builtin_amdgcn_readfirstlane(tid >> 6);
    const size_t rowbase = (size_t)b * SEQ; const int q0 = 32 * u, nch = (u >> 2) + 1; const bool selneeded = (u >= 8);
    LAS unsigned char* QL = lds + QL_OFF; LAS unsigned* HIST = (LAS unsigned*)(lds + HIST_OFF); LAS unsigned* SEL = (LAS unsigned*)(lds + SEL_OFF); LAS unsigned* CAND = (LAS unsigned*)(lds + CAND_OFF);
    LAS float* NH = (LAS float*)(lds + NH_OFF); LAS float* QP = (LAS float*)(lds + QP_OFF);
#pragma unroll
    for (int i = 0; i < 8; ++i) { const int p = w * 8 + i, hh = p >> 2, c = 2 * (p & 3) + (lane >> 5);
        __builtin_amdgcn_global_load_lds((const GAS unsigned*)(P + (rowbase + q0 + r32) * NP + PC_QI + hh * 64 + c * 8), (LAS unsigned*)(QL + p * 1024), 16, 0, 0); }
#pragma unroll
    for (int i = 0; i < 4; ++i) *(LAS u32x4*)(lds + HIST_OFF + (i * 512 + tid) * 16) = (u32x4){0u, 0u, 0u, 0u};
    const int tq = tid & 31, th = tid >> 5;
    f32x4 wq[4];
#pragma unroll
    for (int j = 0; j < 4; ++j) wq[j] = *(const GAS f32x4*)(WI + (rowbase + q0 + tq) * 16 + 4 * j);
    h8 kf[4][4];
    if (selneeded && w < nch) load_kf(kf, P + rowbase * NP + PC_KI + (size_t)(128 * w) * NP, r32, hi);
    IDX_BAR();
    { float s = 0.f;
#pragma unroll
        for (int c = 0; c < 8; ++c) { const h8 v = *(const LAS h8*)(QL + ((th * 8 + c) * 32 + tq) * 16);
#pragma unroll
            for (int j = 0; j < 8; ++j) { const float f = (float)v[j]; s += f * f; } }
        NH[th * 32 + tq] = __builtin_sqrtf(s); }
    IDX_BAR();
    if (tid < 32) { float s1 = 0.f, s2 = 0.f;
#pragma unroll
        for (int hh = 0; hh < 16; ++hh) { const float wv = wq[hh >> 2][hh & 3] * IDX_SCALE, n = NH[hh * 32 + tq]; s1 += wv * n; s2 += wv * wv * n * n; }
        const float mu = 0.3989423f * s1, sg = fmaxf(0.5838f * __builtin_sqrtf(s2), 1e-20f);
        const float invw = 25.6f / sg, lo = mu - 5.f * sg;
        QP[tq * 8 + 0] = invw; QP[tq * 8 + 1] = -lo * invw;
    }
    { const int c = th >> 1, hf = th & 1; float a0 = 0.f, a1 = 0.f, a2 = 0.f, a3 = 0.f;
#pragma unroll
        for (int hh = 0; hh < 16; ++hh) { const float wv = 0.5f * IDX_SCALE * wq[hh >> 2][hh & 3]; const h4 v = *(const LAS h4*)(QL + ((hh * 8 + c) * 32 + tq) * 16 + 8 * hf);
            a0 += wv * (float)v[0]; a1 += wv * (float)v[1]; a2 += wv * (float)v[2]; a3 += wv * (float)v[3]; }
        u32x2 o; o.x = pkh(a0, a1); o.y = pkh(a2, a3);
        *(LAS u32x2*)(QL + ((16 * 8 + c) * 32 + tq) * 16 + 8 * hf) = o; }
    IDX_BAR();
    { float wsel = wq[0][0];
#pragma unroll
        for (int hh = 1; hh < 16; ++hh) wsel = (th == hh) ? wq[hh >> 2][hh & 3] : wsel;
        NH[th * 32 + tq] = 0.5f * IDX_SCALE * wsel; }
    IDX_BAR();
    const LAS float* WH = NH;
    const float invw = QP[r32 * 8 + 0], yoff = QP[r32 * 8 + 1];
    unsigned cm16 = 0u;
#pragma unroll
    for (int r = 0; r < 16; ++r) cm16 |= (crow(r, hi) <= r32) ? (1u << (15 - r)) : 0u;
    const int du = u & 3;
    gf16p Pki = P + rowbase * NP + PC_KI;
    GAS u32x4* binbuf = (GAS u32x4*)(ws + WS_MIX + (size_t)blockIdx.x * 262144 + (size_t)(uslot & 1) * 131072);
    u32x4 pkf[4][4];
    if (selneeded) {
        const float a1 = invw * (1.f / 256.f), b1 = yoff * (1.f / 256.f);
        const unsigned hbase = (unsigned)(size_t)(lds + HIST_OFF) + 4u * (unsigned)r32 - 0x80000000u;
        for (int c = w; c < nch; c += 8) {
            f32x16 acc[4];
            chunk_scores(kf, QL, WH, r32, hi, acc);
            if (c + 8 < nch) load_kf(kf, Pki + (size_t)(128 * (c + 8)) * NP, r32, hi);
            const bool last = (c == nch - 1);
#define IDX_BINZ(R) float y01_; asm("v_fma_f32 %0, %1, %2, %3 clamp" : "=v"(y01_) : "v"(acc[kt][R]), "v"(a1), "v"(b1)); \
                    const unsigned zi_ = __builtin_bit_cast(unsigned, __builtin_fmaf(y01_, 255.f, 8388608.f)); \
                    if (((R) >> 2) == 0) pk[3 - ((R) & 3)] = zi_ << 24; else if (((R) >> 2) == 1) pk[3 - ((R) & 3)] |= zi_ << 8; else if (((R) >> 2) == 2) pk[3 - ((R) & 3)] |= zi_ << 16; else pk[3 - ((R) & 3)] |= zi_ & 255u;
#pragma unroll
            for (int kt = 0; kt < 4; ++kt) {
                const int full = !last ? 1 : (kt < du ? 1 : 0);
                u32x4 pk;
                if (full) {
#pragma unroll
                    for (int r = 0; r < 16; ++r) { IDX_BINZ(r)
                        __hip_atomic_fetch_add((LAS unsigned*)(size_t)((zi_ << 7) + hbase), 1u, __ATOMIC_RELAXED, __HIP_MEMORY_SCOPE_WORKGROUP); }
                } else {
                    const unsigned fld = (kt == du) ? cm16 : 0u;
#pragma unroll
                    for (int r = 0; r < 16; ++r) { IDX_BINZ(r)
                        if ((fld >> (15 - r)) & 1u) __hip_atomic_fetch_add((LAS unsigned*)(size_t)((zi_ << 7) + hbase), 1u, __ATOMIC_RELAXED, __HIP_MEMORY_SCOPE_WORKGROUP); }
                }
                binbuf[(c * 64 + lane) * 4 + kt] = pk;
            }
        }
        IDX_BAR();
#pragma unroll
        for (int ci = 0; ci < 4; ++ci) { const int c = w + 8 * ci;
            if (c < nch) {
#pragma unroll
                for (int kt = 0; kt < 4; ++kt) pkf[ci][kt] = binbuf[(c * 64 + lane) * 4 + kt]; } }
        { unsigned v[4][4], sm[4], I[4];
#pragma unroll
            for (int i = 0; i < 4; ++i) {
#pragma unroll
                for (int k = 0; k < 4; ++k) v[i][k] = HIST[(4 * lane + k) * 32 + 4 * w + i];
                sm[i] = v[i][0] + v[i][1] + v[i][2] + v[i][3]; I[i] = sm[i]; }
#pragma unroll
            for (int d = 1; d < 64; d <<= 1) {
#pragma unroll
                for (int i = 0; i < 4; ++i) { const unsigned t = __shfl_down(I[i], d); if (lane + d < 64) I[i] += t; } }
#pragma unroll
            for (int i = 0; i < 4; ++i) { const int q = 4 * w + i; const unsigned E = I[i] - sm[i];
                if (E < 256u && I[i] >= 256u) { unsigned cum = E; int bst = 4 * lane; unsigned nab = E; bool found = false;
#pragma unroll
                    for (int k = 3; k >= 0; --k) { if (!found && cum + v[i][k] >= 256u) { bst = 4 * lane + k; nab = cum; found = true; } cum += v[i][k]; }
                    QP[q * 8 + 2] = (float)bst; QP[q * 8 + 4] = (float)(256 - (int)nab); } }
        }
        IDX_BAR();
#pragma unroll
        for (int i = 0; i < 4; ++i) *(LAS u32x4*)(lds + HIST_OFF + (i * 512 + tid) * 16) = (u32x4){0u, 0u, 0u, 0u};
        IDX_BAR();
    }
    if (selneeded) {
        const int bst = (int)QP[r32 * 8 + 2];
        const unsigned Kgt = (unsigned)(255 - bst) * 0x00010001u, Kge = Kgt + 0x00010001u;
#pragma unroll
        for (int ci = 0; ci < 4; ++ci) { const int c = w + 8 * ci;
          if (c < nch) {
            u32x4 pk[4];
#pragma unroll
            for (int kt = 0; kt < 4; ++kt) pk[kt] = pkf[ci][kt];
            const bool last = (c == nch - 1);
#pragma unroll
            for (int jp = 0; jp < 2; ++jp) {
                unsigned g0, e0, g1, e1;
                tile_flags(pk[2 * jp], Kgt, Kge, g0, e0); tile_flags(pk[2 * jp + 1], Kgt, Kge, g1, e1);
                const unsigned selw = __builtin_amdgcn_perm(g1, g0, 0x05040100u), gew = __builtin_amdgcn_perm(e1, e0, 0x05040100u);
                unsigned sel = selw, cand = gew & ~selw;
                if (last) { const int k0 = 2 * jp, k1 = 2 * jp + 1;
                    const unsigned f0 = k0 < du ? 0xFFFFu : (k0 == du ? cm16 : 0u), f1 = k1 < du ? 0xFFFFu : (k1 == du ? cm16 : 0u);
                    const unsigned cmw = f0 | (f1 << 16); sel &= cmw; cand &= cmw; }
                SEL[selix(r32 * 2 + hi, 2 * c + jp)] = sel; CAND[selix(r32 * 2 + hi, 2 * c + jp)] = cand;
            }
          }
        }
    } else {
#pragma unroll
        for (int i = 0; i < 8; ++i) { const int widx = i * 512 + tid, q = widx >> 7, h2 = (widx >> 6) & 1, jj = widx & 63;
            unsigned cmq = 0u;
#pragma unroll
            for (int r = 0; r < 16; ++r) cmq |= (crow(r, h2) <= q) ? (1u << (15 - r)) : 0u;
            const int t0 = 2 * jj, t1 = 2 * jj + 1;
            const unsigned f0 = t0 < u ? 0xFFFFu : (t0 == u ? cmq : 0u), f1 = t1 < u ? 0xFFFFu : (t1 == u ? cmq : 0u);
            SEL[selix(widx >> 6, jj)] = f0 | (f1 << 16); }
    }
    IDX_BAR();
    if (selneeded) {
        LAS u16* list = (LAS u16*)(lds + WSC_OFF + w * 3072); LAS float* scs = (LAS float*)(lds + WSC_OFF + w * 3072 + 1024);
        const int head = lane & 15, fq = lane >> 4;
        int need[4], n[4], off[4]; unsigned w0[4], w1[4];
#pragma unroll
        for (int i = 0; i < 4; ++i) { const int q = 4 * w + i; need[i] = (int)QP[q * 8 + 4]; w0[i] = CAND[selix(q * 2 + 0, lane)]; w1[i] = CAND[selix(q * 2 + 1, lane)];
            off[i] = __builtin_popcount(w0[i]) + __builtin_popcount(w1[i]); n[i] = off[i]; }
#pragma unroll
        for (int d = 1; d < 64; d <<= 1) {
#pragma unroll
            for (int i = 0; i < 4; ++i) { const int t = __shfl_up(n[i], d); if (lane >= d) n[i] += t; } }
#pragma unroll
        for (int i = 0; i < 4; ++i) { off[i] = n[i] - off[i]; n[i] = __builtin_amdgcn_readlane(n[i], 63); }
        const bool fast = (n[0] <= 64) && (n[1] <= 64) && (n[2] <= 64) && (n[3] <= 64);
        if (fast) {
#pragma unroll
            for (int i = 0; i < 4; ++i) { int pos = off[i];
                for (unsigned tmp = w0[i]; tmp; tmp &= tmp - 1) { const int be = __builtin_ctz(tmp); list[i * 64 + pos] = (u16)(64 * lane + 32 * (be >> 4) + crow(15 - (be & 15), 0)); ++pos; }
                for (unsigned tmp = w1[i]; tmp; tmp &= tmp - 1) { const int be = __builtin_ctz(tmp); list[i * 64 + pos] = (u16)(64 * lane + 32 * (be >> 4) + crow(15 - (be & 15), 1)); ++pos; } }
            LDS_WAIT(); asm volatile("" ::: "memory");
            float sc[4] = {0.f, 0.f, 0.f, 0.f}; int mykey[4];
#pragma unroll
            for (int i = 0; i < 4; ++i) { const int li = lane < n[i] ? lane : (n[i] > 0 ? n[i] - 1 : 0); mykey[i] = list[i * 64 + li]; }
#pragma unroll
            for (int p = 0; p < 2; ++p) {
                const int nm = n[2 * p] > n[2 * p + 1] ? n[2 * p] : n[2 * p + 1]; const int gmax = (nm + 15) >> 4;
                h8 aq[2][2]; f32x4 wv4[2]; h8 bk[2][4][2];
#pragma unroll
                for (int ii = 0; ii < 2; ++ii) { const int i = 2 * p + ii, q = 4 * w + i;
#pragma unroll
                    for (int ks = 0; ks < 2; ++ks) aq[ii][ks] = *(const LAS h8*)(QL + ((head * 8 + 4 * ks + fq) * 32 + q) * 16);
                    wv4[ii] = *(const GAS f32x4*)(WI + (rowbase + q0 + q) * 16 + 4 * fq); wv4[ii] = wv4[ii] * IDX_SCALE;
#pragma unroll
                    for (int g = 0; g < 4; ++g) if (g < gmax) { const int ci = 16 * g + head; const int li = ci < n[i] ? ci : (n[i] > 0 ? n[i] - 1 : 0); const int key = list[i * 64 + li];
                        gf16p kp = Pki + (size_t)key * NP + 8 * fq; bk[ii][g][0] = *(const GAS h8*)kp; bk[ii][g][1] = *(const GAS h8*)(kp + 32); } }
#pragma unroll
                for (int ii = 0; ii < 2; ++ii) { const int i = 2 * p + ii;
#pragma unroll
                    for (int g = 0; g < 4; ++g) if (g < gmax) {
                        f32x4 x = __builtin_amdgcn_mfma_f32_16x16x32_f16(aq[ii][0], bk[ii][g][0], (f32x4){0.f, 0.f, 0.f, 0.f}, 0, 0, 0);
                        x = __builtin_amdgcn_mfma_f32_16x16x32_f16(aq[ii][1], bk[ii][g][1], x, 0, 0, 0);
                        float sv = wv4[ii].x * fmaxf(x.x, 0.f) + wv4[ii].y * fmaxf(x.y, 0.f) + wv4[ii].z * fmaxf(x.z, 0.f) + wv4[ii].w * fmaxf(x.w, 0.f);
                        sv += __shfl_xor(sv, 16); sv += __shfl_xor(sv, 32);
                        if (fq == g) sc[i] = sv; } }
            }
            int rank[4] = {0, 0, 0, 0};
            int nmax = n[0]; nmax = n[1] > nmax ? n[1] : nmax; nmax = n[2] > nmax ? n[2] : nmax; nmax = n[3] > nmax ? n[3] : nmax;
            for (int j = 0; j < nmax; ++j) {
#pragma unroll
                for (int i = 0; i < 4; ++i) { const float sj = __builtin_bit_cast(float, __builtin_amdgcn_readlane(__builtin_bit_cast(int, sc[i]), j));
                    rank[i] += (j < n[i] && (sj > sc[i] || (sj == sc[i] && j < lane))) ? 1 : 0; } }
#pragma unroll
            for (int i = 0; i < 4; ++i) if (lane < n[i] && rank[i] < need[i]) { const int q = 4 * w + i, key = mykey[i]; const int jj = key >> 6, tp = (key >> 5) & 1, i5 = key & 31, kh = (i5 >> 2) & 1, r = (i5 & 3) | ((i5 >> 3) << 2);
                __hip_atomic_fetch_or(SEL + selix(q * 2 + kh, jj), 1u << (16 * tp + 15 - r), __ATOMIC_RELAXED, __HIP_MEMORY_SCOPE_WORKGROUP); }
        } else {
#pragma unroll 1
            for (int i = 0; i < 4; ++i) { const int q = 4 * w + i;
                const int needq = (int)QP[q * 8 + 4];
                const unsigned v0 = CAND[selix(q * 2 + 0, lane)], v1 = CAND[selix(q * 2 + 1, lane)];
                const int cnt = __builtin_popcount(v0) + __builtin_popcount(v1); int Pf = cnt;
#pragma unroll
                for (int d = 1; d < 64; d <<= 1) { const int t = __shfl_up(Pf, d); if (lane >= d) Pf += t; }
                int nq = __shfl(Pf, 63); int pos = Pf - cnt;
                for (unsigned tmp = v0; tmp; tmp &= tmp - 1) { const int be = __builtin_ctz(tmp); if (pos < NCAP) list[pos] = (u16)(64 * lane + 32 * (be >> 4) + crow(15 - (be & 15), 0)); ++pos; }
                for (unsigned tmp = v1; tmp; tmp &= tmp - 1) { const int be = __builtin_ctz(tmp); if (pos < NCAP) list[pos] = (u16)(64 * lane + 32 * (be >> 4) + crow(15 - (be & 15), 1)); ++pos; }
                nq = nq < NCAP ? nq : NCAP;
                LDS_WAIT(); asm volatile("" ::: "memory");
                if (nq > 0 && needq > 0) {
                    h8 aq[2];
#pragma unroll
                    for (int ks = 0; ks < 2; ++ks) aq[ks] = *(const LAS h8*)(QL + ((head * 8 + 4 * ks + fq) * 32 + q) * 16);
                    f32x4 wv4 = *(const GAS f32x4*)(WI + (rowbase + q0 + q) * 16 + 4 * fq); wv4 = wv4 * IDX_SCALE;
                    for (int g0 = 0; g0 < nq; g0 += 16) { const int ci = g0 + head; const int key = list[ci < nq ? ci : nq - 1];
                        gf16p kp = Pki + (size_t)key * NP + 8 * fq;
                        const h8 bk0 = *(const GAS h8*)kp, bk1 = *(const GAS h8*)(kp + 32);
                        f32x4 x = __builtin_amdgcn_mfma_f32_16x16x32_f16(aq[0], bk0, (f32x4){0.f, 0.f, 0.f, 0.f}, 0, 0, 0);
                        x = __builtin_amdgcn_mfma_f32_16x16x32_f16(aq[1], bk1, x, 0, 0, 0);
                        float sv = wv4.x * fmaxf(x.x, 0.f) + wv4.y * fmaxf(x.y, 0.f) + wv4.z * fmaxf(x.z, 0.f) + wv4.w * fmaxf(x.w, 0.f);
                        sv += __shfl_xor(sv, 16); sv += __shfl_xor(sv, 32);
                        if (fq == 0 && ci < nq) scs[ci] = sv; }
                    LDS_WAIT(); asm volatile("" ::: "memory");
                    unsigned thr = 0u;
                    if (needq < nq) {
#pragma unroll 1
                        for (int bit = 31; bit >= 0; --bit) { const unsigned trial = thr | (1u << bit); int c2 = 0;
                            for (int i0 = 0; i0 < nq; i0 += 64) { const int ii = i0 + lane; const bool ok = ii < nq && ordu(scs[ii < nq ? ii : 0]) >= trial; c2 += __builtin_popcountll(__ballot(ok)); }
                            if (c2 >= needq) thr = trial; } }
                    for (int i0 = 0; i0 < nq; i0 += 64) { const int ii = i0 + lane;
                        if (ii < nq && ordu(scs[ii]) >= thr) { const int key = list[ii]; const int jj = key >> 6, tp = (key >> 5) & 1, i5 = key & 31, kh = (i5 >> 2) & 1, r = (i5 & 3) | ((i5 >> 3) << 2);
                            __hip_atomic_fetch_or(SEL + selix(q * 2 + kh, jj), 1u << (16 * tp + 15 - r), __ATOMIC_RELAXED, __HIP_MEMORY_SCOPE_WORKGROUP); } }
                    LDS_WAIT(); asm volatile("" ::: "memory");
                }
            }
        }
    }
    IDX_BAR();
    { GAS u32x4* mo = (GAS u32x4*)(MASK + (rowbase + q0) * 128);
        const int sv = (tid & ~15) | ((tid & 15) ^ ((tid >> 4) & 15));
        mo[tid] = *(const LAS u32x4*)(lds + SEL_OFF + sv * 16); mo[512 + tid] = *(const LAS u32x4*)(lds + SEL_OFF + (512 + sv) * 16); }
    IDX_BAR();
}
__device__ __forceinline__ void idx_phase(const Args& a, Frame& F) {
    for (int k = F.vcu; k < 1024; k += F.G) { const int i = k >> 8, c = k & 255; const int b = c >> 5, j = c & 31;
        const int u = (i == 0) ? j : (i == 1) ? 63 - j : (i == 2) ? 64 + j : 127 - j;
        idx_unit(a, F.lds, b, u, i); }
}
}


namespace dbg {
__device__ __forceinline__ int sample_t(int i) { switch (i) { case 0: return 0; case 1: return 1; case 2: return 31; case 3: return 32; case 4: return 63; case 5: return 64; case 6: return 100; case 7: return 127; case 8: return 128; case 9: return 255; case 10: return 256; case 11: return 1000; case 12: return 2047; case 13: return 2048; case 14: return 3071; default: return 4095; } }
constexpr int CW_DBG = 16;
__device__ __forceinline__ void dbg_phase(const Args& a, Frame& F) {
    if (F.vcu >= 16) return;
    unsigned char* ws = a.ws; asm volatile("" : "+s"(ws));
    const f16* P = (const f16*)(ws + WS_P); const float* WI = (const float*)(ws + WS_WI); const unsigned* MASK = (const unsigned*)(ws + WS_MASK);
    unsigned* ctl = (unsigned*)(ws + WS_CTL);
    const int t = sample_t(F.vcu);
    const int b = F.vcu & 7; const size_t rowbase = (size_t)b * SEQ;
    LAS float* qf = (LAS float*)(F.lds);
    LAS float* sc = (LAS float*)(F.lds + 4096);
    LAS unsigned* red = (LAS unsigned*)(F.lds + 4096 + 16384);
    const int tid = F.tid;
    for (int i = tid; i < 1024; i += 512) qf[i] = (float)P[(rowbase + t) * NP + PC_QI + i];
    if (tid < 2) red[tid] = 0u;
    __syncthreads();
    for (int j = tid; j <= t; j += 512) {
        const f16* kp = P + (rowbase + j) * NP + PC_KI;
        float s = 0.f;
        for (int h = 0; h < 16; ++h) { float x = 0.f;
            for (int d = 0; d < 64; ++d) x += qf[h * 64 + d] * (float)kp[d];
            s += WI[(rowbase + t) * 16 + h] * fmaxf(x, 0.f); }
        sc[j] = s * 0.03125f;
    }
    __syncthreads();
    unsigned mism = 0u, nsel = 0u;
    for (int j = tid; j <= t; j += 512) {
        const float sj = sc[j]; int rank = 0;
        for (int i = 0; i <= t; ++i) { const float si = sc[i]; rank += (si > sj || (si == sj && i < j)) ? 1 : 0; }
        const bool exp_sel = (rank < 256);
        const int jj = j >> 6, tp = (j >> 5) & 1, i5 = j & 31, kh = (i5 >> 2) & 1, r = (i5 & 3) | ((i5 >> 3) << 2);
        const unsigned wv = MASK[((rowbase + t) * 2 + kh) * 64 + jj];
        const bool act = (wv >> (16 * tp + 15 - r)) & 1u;
        mism += (exp_sel != act) ? 1u : 0u; nsel += act ? 1u : 0u;
    }
    for (int j = t + 1 + tid; j < SEQ; j += 512) {
        const int jj = j >> 6, tp = (j >> 5) & 1, i5 = j & 31, kh = (i5 >> 2) & 1, r = (i5 & 3) | ((i5 >> 3) << 2);
        const unsigned wv = MASK[((rowbase + t) * 2 + kh) * 64 + jj];
        mism += ((wv >> (16 * tp + 15 - r)) & 1u) ? 1u : 0u;
    }
    atomicAdd((unsigned*)&red[0], mism); atomicAdd((unsigned*)&red[1], nsel);
    __syncthreads();
    if (tid == 0) { atomicAdd(ctl + CW_DBG, red[0]); const unsigned want = (t + 1 < 256) ? (unsigned)(t + 1) : 256u; if (red[1] != want) atomicAdd(ctl + CW_DBG + 1, 1u); }
    __syncthreads();
}

__device__ __forceinline__ void dbg2_phase(const Args& a, Frame& F) {
    if (F.vcu >= 16) return;
    unsigned char* ws = a.ws; asm volatile("" : "+s"(ws));
    const f16* P = (const f16*)(ws + WS_P); const unsigned* MASK = (const unsigned*)(ws + WS_MASK); const f16* MIX = (const f16*)(ws + WS_MIX);
    unsigned* ctl = (unsigned*)(ws + WS_CTL);
    const int t = sample_t(F.vcu);
    const int b = F.vcu & 7; const size_t rowbase = (size_t)b * SEQ;
    const int tid = F.tid, h = tid >> 6, d = tid & 63;
    LAS unsigned* red = (LAS unsigned*)(F.lds);
    if (tid < 2) red[tid] = 0u;
    __syncthreads();
    const f16* qp = P + (rowbase + t) * NP + PC_QA + h * 64;
    float mx = -1e30f;
    for (int j = 0; j <= t; ++j) {
        const int jj = j >> 6, tp = (j >> 5) & 1, i5 = j & 31, kh = (i5 >> 2) & 1, r = (i5 & 3) | ((i5 >> 3) << 2);
        const unsigned wv = MASK[((rowbase + t) * 2 + kh) * 64 + jj];
        if (!((wv >> (16 * tp + 15 - r)) & 1u)) continue;
        const f16* kp = P + (rowbase + j) * NP + PC_KA; float sdot = 0.f;
        for (int e = 0; e < 64; ++e) sdot += (float)qp[e] * (float)kp[e];
        mx = fmaxf(mx, sdot);
    }
    float l = 0.f, o = 0.f;
    for (int j = 0; j <= t; ++j) {
        const int jj = j >> 6, tp = (j >> 5) & 1, i5 = j & 31, kh = (i5 >> 2) & 1, r = (i5 & 3) | ((i5 >> 3) << 2);
        const unsigned wv = MASK[((rowbase + t) * 2 + kh) * 64 + jj];
        if (!((wv >> (16 * tp + 15 - r)) & 1u)) continue;
        const f16* kp = P + (rowbase + j) * NP + PC_KA; float sdot = 0.f;
        for (int e = 0; e < 64; ++e) sdot += (float)qp[e] * (float)kp[e];
        const float p = __builtin_amdgcn_exp2f(sdot - mx);
        l += p; o += p * (float)P[(rowbase + j) * NP + PC_VA + d];
    }
    o /= l;
    const float got = (float)MIX[(rowbase + t) * DM + h * 64 + d];
    if (F.vcu == 0 && tid == 0) { float m64 = -1e30f, s0v = 0.f; float qn = 0.f, kn = 0.f;
        for (int j = 0; j < 64; ++j) { const f16* kp = P + (rowbase + j) * NP + PC_KA; float sd = 0.f; for (int e = 0; e < 64; ++e) sd += (float)qp[e] * (float)kp[e]; if (j == 0) s0v = sd; m64 = fmaxf(m64, sd); }
        for (int e = 0; e < 64; ++e) { qn += (float)qp[e] * (float)qp[e]; const float kv = (float)P[(rowbase + 0) * NP + PC_KA + e]; kn += kv * kv; }
        ctl[20] = (unsigned)(m64 - s0v + 0.5f); ctl[21] = (unsigned)(__builtin_sqrtf(qn) * 4.f + 0.5f); ctl[22] = (unsigned)(__builtin_sqrtf(kn) * 4.f + 0.5f); }
    if (F.vcu == 0 && h == 3) { float ratio = got / o; if (!(ratio > 0.f && ratio < 6.f)) ratio = 6.f; atomicAdd(ctl + 28, (unsigned)(ratio * 10.f + 0.5f)); }
    LAS float* redf = (LAS float*)(F.lds + 64);
    if (tid < 2) redf[tid] = 0.f;
    __syncthreads();
    atomicAdd((float*)&redf[0], (got - o) * (got - o)); atomicAdd((float*)&redf[1], o * o);
    if (F.vcu == 0 && __builtin_fabsf(got - o) > 0.01f + 0.02f * __builtin_fabsf(o)) atomicAdd(ctl + 19, 1u);
    __syncthreads();
    if (tid == 0) { const float rr = __builtin_sqrtf(redf[0] / redf[1]); unsigned c = (unsigned)(rr * 100.f + 0.5f); if (!(rr < 10.f)) c = 1000; ctl[32 + F.vcu] = c; }
    __syncthreads();
}
}

enum { ST_GEMM = 0, ST_IDX = 1, ST_MLA = 2, ST_DSA = 3, ST_FINAL = 4, ST_ZMIX = 5, ST_DBG = 6, ST_DBG2 = 7, ST_NONE = 8 };

#ifndef DBG_WHICH
#define DBG_WHICH 3
#endif
__device__ __forceinline__ void final_phase(const Args& a, Frame& F) {
    const int gw = F.vcu * NWAVES + F.wave, NGW = F.G * NWAVES;
    const float* SS = (const float*)(a.ws + WS_SS16);
    f32x4 gv[4];
#pragma unroll
    for (int j = 0; j < 4; ++j) gv[j] = *((const f32x4*)a.g_final + F.lane + 64 * j);
    float dscale = 1.f;
    if (MK_TIMING) { const unsigned* ctl = (const unsigned*)(a.ws + WS_CTL); unsigned tk = 0; if (TSEL >= 100) { for (int i = 0; i < 12; ++i) tk += __hip_atomic_load(ctl + 48 + i, __ATOMIC_RELAXED, __HIP_MEMORY_SCOPE_AGENT); tk /= 5; } else if (TSEL == 67) tk = __hip_atomic_load(ctl + 48 + 6, __ATOMIC_RELAXED, __HIP_MEMORY_SCOPE_AGENT) + __hip_atomic_load(ctl + 48 + 7, __ATOMIC_RELAXED, __HIP_MEMORY_SCOPE_AGENT); else tk = __hip_atomic_load(ctl + 48 + TSEL, __ATOMIC_RELAXED, __HIP_MEMORY_SCOPE_AGENT); dscale = 1.f + (float)((tk + TOFF) / TUNIT); }
    if (MK_DEBUG) { const unsigned* ctl = (const unsigned*)(a.ws + WS_CTL); const unsigned mm = __hip_atomic_load(ctl + 16, __ATOMIC_RELAXED, __HIP_MEMORY_SCOPE_AGENT), bc = __hip_atomic_load(ctl + 17, __ATOMIC_RELAXED, __HIP_MEMORY_SCOPE_AGENT);
      const unsigned m2 = __hip_atomic_load(ctl + 18, __ATOMIC_RELAXED, __HIP_MEMORY_SCOPE_AGENT);
      unsigned code = 0; if (DBG_WHICH == 0) { if (mm) code = 1 + (31 - __builtin_clz(mm)); } else if (DBG_WHICH == 1) code = bc; else if (DBG_WHICH == 2) { if (m2) code = 1 + (31 - __builtin_clz(m2)); }
      else { unsigned nb = 0, first = 0, second = 0; for (int i = 0; i < 16; ++i) { const unsigned c = __hip_atomic_load(ctl + 32 + i, __ATOMIC_RELAXED, __HIP_MEMORY_SCOPE_AGENT); if (c > nb) nb = c; first += c; if (c > 3 && !second) second = i + 1; }
        code = (DBG_WHICH == 3) ? nb : (DBG_WHICH == 4) ? first / 16 : (DBG_WHICH == 14) ? (__hip_atomic_load(ctl + 28, __ATOMIC_RELAXED, __HIP_MEMORY_SCOPE_AGENT) / 64) : (DBG_WHICH >= 10) ? ({ const unsigned v_ = __hip_atomic_load(ctl + 14 + DBG_WHICH, __ATOMIC_RELAXED, __HIP_MEMORY_SCOPE_AGENT); v_ ? 1 + (31 - __builtin_clz(v_)) : 0u; }) : (DBG_WHICH == 5) ? second : (DBG_WHICH == 6) ? __hip_atomic_load(ctl + 19, __ATOMIC_RELAXED, __HIP_MEMORY_SCOPE_AGENT) / 8 : __hip_atomic_load(ctl + 13 + DBG_WHICH, __ATOMIC_RELAXED, __HIP_MEMORY_SCOPE_AGENT); if (code > 70) code = 70; } dscale = 1.f + (float)code; }
    for (int m = gw; m < M; m += NGW) {
        float s = (F.lane < 16) ? SS[(size_t)m * 16 + F.lane] : 0.f;
        s = wave_sum(s);
        const float rs = frsq(s * (1.f / DM) + EPS) * dscale;
        f32x4* xr = (f32x4*)(a.out + (size_t)m * DM) + F.lane; const h4* hr = (const h4*)((const f16*)(a.ws + WS_XH) + (size_t)m * DM) + F.lane;
#pragma unroll
        for (int j = 0; j < 4; ++j) { const h4 hv = hr[64 * j]; f32x4 v = (f32x4){(float)hv[0], (float)hv[1], (float)hv[2], (float)hv[3]}; v = v * rs * gv[j]; xr[64 * j] = v; }
    }
}
__device__ __forceinline__ void zmix_phase(const Args& a, Frame& F) {
    u32x4* p = (u32x4*)(a.ws + WS_MIX);
    const size_t n = (size_t)M * DM * 2 / 16;
    for (size_t i = (size_t)F.vcu * 512 + F.tid; i < n; i += (size_t)F.G * 512) p[i] = (u32x4){0u, 0u, 0u, 0u};
}

struct Stage { int type, gi, bar; };
__device__ __forceinline__ Stage get_stage(int s) {
#if MK_DEBUG
    switch (s) {
        case 0: return {ST_GEMM, G_FFN1A, 1};
        case 1: return {ST_GEMM, G_FFN1B, 1};
        case 2: return {ST_GEMM, G_WIN, 1};
        case 3: return {ST_GEMM, G_QUP, 0};
        case 4: return {ST_GEMM, G_KVUP, 0};
        case 5: return {ST_IDX, 0, 1};
        case 6: return {ST_DBG, 0, 1};
        case 7: return {ST_MLA, 0, 0};
        case 8: return {ST_DSA, 0, 1};
        case 9: return {ST_DBG2, 0, 1};
        case 10: return {ST_GEMM, G_WOUT, 1};
        case 11: return {ST_GEMM, G_FFN2A, 1};
        case 12: return {ST_GEMM, G_FFN2B, 1};
        default: return {ST_FINAL, 0, 0};
    }
#else
    switch (s) {
        case 0: return {ST_GEMM, G_FFN1A, 1};
        case 1: return {ST_GEMM, G_FFN1B, 1};
        case 2: return {ST_GEMM, G_WIN, 1};
        case 3: return {ST_GEMM, G_QUP, 0};
        case 4: return {ST_GEMM, G_KVUP, 0};
        case 5: return {ST_IDX, 0, 1};
        case 6: return {ST_MLA, 0, 0};
        case 7: return {ST_DSA, 0, 1};
#if DUP_STAGE == 6
        case 8: return {ST_MLA, 0, 1};
#elif DUP_STAGE == 7
        case 8: return {ST_DSA, 0, 1};
#elif DUP_STAGE == 5
        case 8: return {ST_IDX, 0, 1};
#endif
        case 8 + (DUP_STAGE ? 1 : 0): return {ST_GEMM, G_WOUT, 1};
        case 9 + (DUP_STAGE ? 1 : 0): return {ST_GEMM, G_FFN2A, 1};
        case 10 + (DUP_STAGE ? 1 : 0): return {ST_GEMM, G_FFN2B, (FUSE_FINAL && gridDim.x == 256) ? 0 : 1};
        default: return {(FUSE_FINAL && gridDim.x == 256) ? ST_NONE : ST_FINAL, 0, 0};
    }
#endif
}
#if MK_DEBUG
constexpr int NSTAGES = 14;
#else
constexpr int NSTAGES = 12 + (DUP_STAGE ? 1 : 0);
#endif

__global__ void __launch_bounds__(NWAVES * 64, 2) mega_fwd(Args args) {
    extern __shared__ __attribute__((aligned(16))) unsigned char lds_raw[];
    Frame F;
    F.lds = (LAS unsigned char*)lds_raw;
    volatile LAS unsigned* MISC = (volatile LAS unsigned*)(F.lds + MISC_OFF);
    F.tid = threadIdx.x; F.lane = F.tid & 63; F.wave = __builtin_amdgcn_readfirstlane(F.tid >> 6);
    F.G = gridDim.x; { const int bx = blockIdx.x; F.vcu = (F.G % 8 == 0) ? (bx % 8) * (F.G / 8) + bx / 8 : bx; }
    for (int u = F.tid; u < (LDS_BYTES - LDSCTL_OFF) / 4; u += NWAVES * 64) ((LAS unsigned*)(F.lds + LDSCTL_OFF))[u] = 0u;
    __syncthreads();
    unsigned* ctl = (unsigned*)(args.ws + WS_CTL);
    XcdBarrier bar = xcd_barrier_post(ctl + CW_BAR, MISC + 8);

    for (int rep = 0; rep < ((RSEL == 100) ? 2 : 1); ++rep) prep_phase(args, F);
    xcd_barrier(bar);

    for (int s = 0; s < NSTAGES; ++s) {
        const Stage st = get_stage(s);
        unsigned long long tq0 = 0; if (MK_TIMING && blockIdx.x == 0 && threadIdx.x == 0) tq0 = __builtin_amdgcn_s_memrealtime();
        F.tid = opaque_tid(); F.lane = F.tid & 63; F.wave = __builtin_amdgcn_readfirstlane(F.tid >> 6);
        for (int rep = 0; rep < ((s == RSEL) ? 2 : 1); ++rep) {
        if (st.type == ST_GEMM) {
            pg8::GemmDesc g; pg8::make_gemm(args, st.gi, g);
            pg8::StaticOrder S; S.init(g.M, g.N, F.G, (int)blockIdx.x);
            pg8::gemm_phase(F.lds, args, st.gi, g, S);
        } else if (st.type == ST_MLA) {
            if (F.wave >= 4) __builtin_amdgcn_s_setprio(1);
            att::attn_phase<0>(args, F);
            __builtin_amdgcn_s_setprio(0);
        } else if (st.type == ST_DSA) {
            if (F.wave >= 4) __builtin_amdgcn_s_setprio(1);
            att::attn_phase<1>(args, F);
            __builtin_amdgcn_s_setprio(0);
        } else if (st.type == ST_IDX) {
            idx::idx_phase(args, F);
#if MK_DEBUG
        } else if (st.type == ST_DBG) {
            dbg::dbg_phase(args, F);
        } else if (st.type == ST_DBG2) {
            dbg::dbg2_phase(args, F);
#endif
        } else if (st.type == ST_FINAL) {
            final_phase(args, F);
        }
        }
        if (st.bar) xcd_barrier(bar);
        if (MK_TIMING && blockIdx.x == 0 && threadIdx.x == 0) { const unsigned long long tq1 = __builtin_amdgcn_s_memrealtime(); __hip_atomic_store(ctl + 48 + s, (unsigned)(tq1 - tq0), __ATOMIC_RELAXED, __HIP_MEMORY_SCOPE_AGENT); }
    }
}

extern "C" void kernel_launch(void* const* d_in, const int* in_sizes, int n_in, void* d_out, int out_size, void* d_ws, size_t ws_size, hipStream_t stream) {
    static int grid = 0;
    if (grid == 0) {
        if (n_in != 17 || in_sizes[0] != M * DM || out_size != M * DM || ws_size < WS_END) {
            fprintf(stderr, "kernel_launch: unexpected shapes/workspace: n_in %d in0 %d out %d ws %zu (need %zu); nothing launched\n", n_in, n_in > 0 ? in_sizes[0] : -1, out_size, ws_size, (size_t)WS_END);
            grid = -1; return; }
        int dev = 0, cus = 0;
        if (hipGetDevice(&dev) != hipSuccess || hipDeviceGetAttribute(&cus, hipDeviceAttributeMultiprocessorCount, dev) != hipSuccess) { grid = -1; return; }
        if (hipFuncSetAttribute((const void*)mega_fwd, hipFuncAttributeMaxDynamicSharedMemorySize, LDS_BYTES) != hipSuccess) { fprintf(stderr, "kernel_launch: hipFuncSetAttribute failed\n"); grid = -1; return; }
        int per_cu = 0;
        if (hipOccupancyMaxActiveBlocksPerMultiprocessor(&per_cu, (const void*)mega_fwd, NWAVES * 64, LDS_BYTES) != hipSuccess || per_cu < 1)
            fprintf(stderr, "kernel_launch: note: occupancy query reports %d workgroups per CU\n", per_cu);
        (void)hipGetLastError();
        grid = cus < 256 ? cus : 256;
    }
    if (grid < 0) return;
    (void)hipMemsetAsync((char*)d_ws + WS_CTL, 0, CTL_ZERO_BYTES, stream);
    Args a{};
    a.x = (const float*)d_in[0]; a.g_ffn1 = (const float*)d_in[1]; a.w1_gate = (const float*)d_in[2]; a.w1_up = (const float*)d_in[3]; a.w1_down = (const float*)d_in[4];
    a.g_mix = (const float*)d_in[5]; a.w_in = (const float*)d_in[6]; a.g_q_lat = (const float*)d_in[7]; a.g_kv_lat = (const float*)d_in[8]; a.w_uq = (const float*)d_in[9]; a.w_ukv = (const float*)d_in[10];
    a.w_out = (const float*)d_in[11]; a.g_ffn2 = (const float*)d_in[12]; a.w2_gate = (const float*)d_in[13]; a.w2_up = (const float*)d_in[14]; a.w2_down = (const float*)d_in[15]; a.g_final = (const float*)d_in[16];
    a.out = (float*)d_out; a.ws = (unsigned char*)d_ws;
    hipLaunchKernelGGL(mega_fwd, dim3(grid), dim3(NWAVES * 64), LDS_BYTES, stream, a);
}
```

```cpp
#include <hip/hip_runtime.h>
#include <cstdio>
#include <cstdint>
#include <cmath>

#ifndef MK_DEBUG
#define MK_DEBUG 0
#endif
#ifndef MK_TIMING
#define MK_TIMING 0
#endif
#ifndef TSEL
#define TSEL 6
#endif
#ifndef TUNIT
#define TUNIT 4000
#endif
#ifndef TOFF
#define TOFF 0
#endif
#ifndef DUP_STAGE
#define DUP_STAGE 0
#endif
#ifndef FUSE_FINAL
#define FUSE_FINAL 1
#endif
#ifndef RSEL
#define RSEL -1
#endif
#define LAS __attribute__((address_space(3)))
#define GAS __attribute__((address_space(1)))
typedef _Float16 f16;
typedef _Float16 h8 __attribute__((ext_vector_type(8)));
typedef _Float16 h4 __attribute__((ext_vector_type(4)));
typedef _Float16 h2 __attribute__((ext_vector_type(2)));
typedef float f32x2 __attribute__((ext_vector_type(2)));
typedef float f32x4 __attribute__((ext_vector_type(4)));
typedef float f32x16 __attribute__((ext_vector_type(16)));
typedef unsigned u32x2 __attribute__((ext_vector_type(2)));
typedef unsigned u32x4 __attribute__((ext_vector_type(4)));
typedef unsigned short u16;

constexpr int BATCH = 8, SEQ = 4096, DM = 1024, M = BATCH * SEQ;
constexpr int DFF = 2816, NFF = 2 * DFF;
constexpr int DPROJ = 2416, NP = 2560;
constexpr int QLORA = 384, KVLORA = 256;
constexpr int NQB = 768, NKV = 1024;
constexpr float EPS = 1e-6f;
constexpr float LOG2E = 1.4426950408889634f;
constexpr int PC_QA = 0, PC_QI = 512, PC_KA = 1536, PC_KI = 1600, PC_KR = 1664, PC_VA = 1696, PC_WI = 1760, PC_CQ = 1792, PC_CKV = 2304;
constexpr int WC_QA = 0, WC_KA = 512, WC_VA = 576, WC_QI = 640, WC_KI = 1664, WC_WI = 1728, WC_CQ = 1744, WC_CKV = 2128, WC_KR = 2384;

constexpr size_t MiB = 1u << 20;
constexpr size_t WS_CTL = 0, CTL_ZERO_BYTES = 1 * MiB;
constexpr size_t WS_BT1 = 1 * MiB;
constexpr size_t WS_BTD1 = 12 * MiB;
constexpr size_t WS_BT2 = 18 * MiB;
constexpr size_t WS_BTD2 = 29 * MiB;
constexpr size_t WS_BTIN = 35 * MiB;
constexpr size_t WS_BTQ = 40 * MiB;
constexpr size_t WS_BTKV = 41 * MiB;
constexpr size_t WS_BTOUT = 42 * MiB;
constexpr size_t WS_ROPE = 44 * MiB;
constexpr size_t WS_SS0 = 46 * MiB;
constexpr size_t WS_SS16 = 47 * MiB;
constexpr size_t WS_SSQ = 49 * MiB;
constexpr size_t WS_SSKV = 50 * MiB;
constexpr size_t WS_WI = 51 * MiB;
constexpr size_t WS_XH = 54 * MiB;
constexpr size_t WS_H = 118 * MiB;
constexpr size_t WS_P = WS_H;
constexpr size_t WS_QB = 294 * MiB;
constexpr size_t WS_KV = 342 * MiB;
constexpr size_t WS_MIX = 406 * MiB;
constexpr size_t WS_MASK = 470 * MiB;
constexpr size_t WS_END = 486 * MiB;

constexpr int RING_BYTES = 131072;
constexpr int LDSCTL_OFF = RING_BYTES, MISC_OFF = LDSCTL_OFF + 320;
constexpr int LDS_BYTES = 147456;
constexpr int NWAVES = 8;

#define RLX_AGENT __ATOMIC_RELAXED, __HIP_MEMORY_SCOPE_AGENT
#define LDS_WAIT() asm volatile("s_waitcnt lgkmcnt(0)" ::: "memory")
#define VM_WAIT() asm volatile("s_waitcnt vmcnt(0)" ::: "memory")

__device__ __forceinline__ unsigned pkh(float a, float b) { h2 v; v.x = (f16)a; v.y = (f16)b; return __builtin_bit_cast(unsigned, v); }
__device__ __forceinline__ int opaque_tid() { int t = threadIdx.x; asm volatile("" : "+v"(t)); return t; }
__device__ __forceinline__ float frsq(float x) { return __builtin_amdgcn_rsqf(x); }
__device__ __forceinline__ float sq4(const f32x4 v) { return (v.x * v.x + v.y * v.y) + (v.z * v.z + v.w * v.w); }
__device__ __forceinline__ float wave_sum(float v) {
#pragma unroll
    for (int o = 1; o < 64; o <<= 1) v += __shfl_xor(v, o);
    return v;
}

#define XB_TMO      128
#define XB_XCNT(j)  (256  + 64 * (j))
#define XB_XSUB(j)  (1280 + 64 * (j))
#define XB_XGEN(j)  (2304 + 64 * (j))
#define XB_TOP      3328
#define XB_TOPGEN   3392
#define XCD_BAR_WORDS 3456
#define XB_SPIN_CAP (1u << 18)
constexpr int CW_BAR = 4096;

__device__ __forceinline__ unsigned xb_ld(unsigned* p)              { return __hip_atomic_load(p, __ATOMIC_RELAXED, __HIP_MEMORY_SCOPE_AGENT); }
__device__ __forceinline__ unsigned xb_add(unsigned* p, unsigned v) { return __hip_atomic_fetch_add(p, v, __ATOMIC_RELAXED, __HIP_MEMORY_SCOPE_AGENT); }
__device__ __forceinline__ unsigned xb_xcc_id() { return (unsigned)__builtin_amdgcn_s_getreg((3 << 11) | 20) & 0xFu; }
#define XB_SPIN(cond, bar) do { unsigned _sp = 0; while (cond) { __builtin_amdgcn_s_sleep(1); \
    if ((++_sp & 255u) == 0u) { if (xb_ld(&(bar)[XB_TMO])) break; if (_sp > XB_SPIN_CAP) { atomicAdd(&(bar)[XB_TMO], 1u); break; } } } } while (0)

struct XcdBarrier { unsigned* bar; unsigned x; volatile LAS unsigned* st; };

__device__ __forceinline__ XcdBarrier xcd_barrier_post(unsigned* bar, volatile LAS unsigned* st) {
    XcdBarrier b; b.bar = bar; b.x = xb_xcc_id(); b.st = st;
    if (threadIdx.x == 0) (void)xb_add(&bar[XB_XCNT(b.x)], 1u);
    return b;
}
__device__ __forceinline__ void xcd_barrier_complete(unsigned* bar, unsigned x, unsigned& nloc, unsigned& nx) {
    const unsigned G = gridDim.x * gridDim.y * gridDim.z;
    unsigned sum, cnt, mine, sp = 0u;
    for (;;) {
        sum = 0u; cnt = 0u; mine = 0u;
#pragma unroll
        for (unsigned j = 0; j < 16; ++j) { const unsigned c = xb_ld(&bar[XB_XCNT(j)]); sum += c; cnt += (c > 0u) ? 1u : 0u; mine = (j == x) ? c : mine; }
        if (sum == G) break;
        __builtin_amdgcn_s_sleep(1);
        if ((++sp & 255u) == 0u) { if (xb_ld(&bar[XB_TMO])) break; if (sp > XB_SPIN_CAP) { atomicAdd(&bar[XB_TMO], 1u); break; } }
    }
    nloc = mine > 0u ? mine : 1u; nx = cnt > 0u ? cnt : 1u;
}
__device__ __forceinline__ void xcd_barrier(const XcdBarrier& b) {
    asm volatile("s_waitcnt vmcnt(0)" ::: "memory");
    __syncthreads();
    if (threadIdx.x == 0) {
        unsigned* bar = b.bar; unsigned bx_ = b.x;
        asm volatile("" : "+s"(bar), "+s"(bx_));
        __builtin_amdgcn_s_waitcnt(0);
        unsigned nloc = b.st[0], nx = b.st[1];
        if (nloc == 0u) { xcd_barrier_complete(bar, bx_, nloc, nx); b.st[0] = nloc; b.st[1] = nx; }
        const unsigned old = xb_add(&bar[XB_XSUB(bx_)], 1u);
        const unsigned gen = old / nloc;
        if (old + 1u == (gen + 1u) * nloc) {
            __builtin_amdgcn_fence(__ATOMIC_RELEASE, "agent");
            asm volatile("s_waitcnt vmcnt(0)" ::: "memory");
            const unsigned og = xb_add(&bar[XB_TOP], 1u);
            const unsigned tg = og / nx;
            if (og + 1u == (tg + 1u) * nx) xb_add(&bar[XB_TOPGEN], 1u);
            else XB_SPIN(xb_ld(&bar[XB_TOPGEN]) == tg, bar);
            __builtin_amdgcn_fence(__ATOMIC_ACQUIRE, "agent");
            xb_add(&bar[XB_XGEN(bx_)], 1u);
            asm volatile("s_waitcnt vmcnt(0)" ::: "memory");
        } else {
            XB_SPIN(xb_ld(&bar[XB_XGEN(bx_)]) == gen, bar);
            __builtin_amdgcn_fence(__ATOMIC_ACQUIRE, "agent");
            asm volatile("s_waitcnt vmcnt(0)" ::: "memory");
        }
    }
    __syncthreads();
}

struct Args {
    const float* x; const float* g_ffn1; const float* w1_gate; const float* w1_up; const float* w1_down;
    const float* g_mix; const float* w_in; const float* g_q_lat; const float* g_kv_lat; const float* w_uq; const float* w_ukv;
    const float* w_out; const float* g_ffn2; const float* w2_gate; const float* w2_up; const float* w2_down; const float* g_final;
    float* out; unsigned char* ws;
};

constexpr int G_FFN1A = 0, G_FFN1B = 1, G_WIN = 2, G_QUP = 3, G_KVUP = 4, G_WOUT = 5, G_FFN2A = 6, G_FFN2B = 7;
namespace pg8 {
constexpr int BM = 256, BK = 64, HALF = 128, HTB = HALF * BK * 2, STAGE_BYTES = 8 * HTB, NXCD = 8, WGM = 8;
__host__ __device__ __forceinline__ int lds_byte(int r, int c) { const int st = (r >> 4) * 2 + (c >> 5), rr = r & 15, cc = c & 31, ob = rr * 64 + cc * 2; return st * 1024 + (ob ^ (((ob >> 9) & 1) << 5)); }
__host__ __device__ __forceinline__ void stage_rc(int b, int& R, int& C) { const int st = b / 1024, sb = b % 1024, swz = sb ^ (((sb >> 9) & 1) << 5); R = (st >> 1) * 16 + swz / 64; C = (st & 1) * 32 + (swz % 64) / 2; }
__host__ __device__ __forceinline__ int perm32(int rho) { const int n = rho >> 4, i = rho & 15; return 8 * (i >> 2) + 4 * n + (i & 3); }

struct Unit { int pm, pn; };
struct StaticOrder {
    int nM, nN, nwg, G, c;
    __device__ void init(int M_, int N_, int G_, int c_) { nM = M_ / BM; nN = N_ / BM; nwg = nM * nN; G = G_; c = c_; }
    __device__ bool next(int i, Unit& u) const {
        const long L = (long)i * G + c; if (L >= nwg) return false;
        int wgid = (int)L; { const int q = nwg / NXCD, r = nwg % NXCD, xcd = wgid % NXCD, off = wgid / NXCD; wgid = (xcd < r ? xcd * (q + 1) : r * (q + 1) + (xcd - r) * q) + off; }
        const int nig = WGM * nN, gid = wgid / nig, fm = gid * WGM, gsz = (nM - fm) < WGM ? (nM - fm) : WGM;
        u.pm = fm + ((wgid % nig) % gsz); u.pn = (wgid % nig) / gsz; return true;
    }
};

enum { EPI_SWIGLU = 0, EPI_RESID = 1, EPI_WIN = 2, EPI_QUP = 3, EPI_KVUP = 4, EPI_FINAL = 5 };
struct GemmDesc {
    const f16* A; const f16* Bt; int M, N, K, lda;
    int epi;
    const float* ss; int nss;
    float invn;
    f16* oh; int ldo;
    const float* xin; float* xout; f16* xh; float* ssout; float rscale;
    const float* cos64; const float* sin64; const float* cos32; const float* sin32;
    float* wi; float* ssq; float* sskv;
};

template <int NSS> __device__ __forceinline__ float row_rstd(const float* ss, int row, float invn) {
    float s;
    if (NSS == 1) s = ss[row];
    else { s = 0.f;
#pragma unroll
        for (int j = 0; j < NSS / 4; ++j) { const f32x4 v = *(const f32x4*)(ss + (size_t)row * NSS + 4 * j); s += (v.x + v.y) + (v.z + v.w); } }
    return frsq(s * invn + EPS);
}
__device__ __forceinline__ float row_rstd_rt(const float* ss, int nss, int row, float invn) {
    if (nss == 1) return row_rstd<1>(ss, row, invn);
    if (nss == 4) return row_rstd<4>(ss, row, invn);
    if (nss == 8) return row_rstd<8>(ss, row, invn);
    return row_rstd<16>(ss, row, invn);
}

__device__ __forceinline__ void make_gemm(const Args& a, int gi, GemmDesc& g);
__device__ __forceinline__ void epilogue(const Args& a, int gi, f32x4 (&acc)[2][2][4][2], const Unit& u, int wr, int wc, int fr, int fq, LAS unsigned char* lds, int upar) {
    asm volatile("" : "+s"(gi), "+s"(wr), "+s"(wc), "+v"(fr), "+v"(fq));
    GemmDesc g; make_gemm(a, gi, g);
    const LAS float* RST = (const LAS float*)(lds + LDSCTL_OFF + 7168) + upar * 256;
    const int rl0 = wr * 64 + fr;
    const int row0 = u.pm * BM + wr * 64 + fr;
    if (g.epi == EPI_SWIGLU) {
        const int hc0 = 128 * u.pn + 32 * wc + 8 * fq;
#pragma unroll
        for (int ai = 0; ai < 2; ++ai)
#pragma unroll
            for (int m = 0; m < 4; ++m) {
                const int row = row0 + ai * HALF + m * 16;
                const float rs = RST[rl0 + ai * HALF + m * 16];
                u32x4 w;
#pragma unroll
                for (int bj = 0; bj < 2; ++bj) {
                    const f32x4 ga = acc[ai][bj][m][0] * rs, ua = acc[ai][bj][m][1] * rs;
                    float hv[4];
#pragma unroll
                    for (int i = 0; i < 4; ++i) { const float sg = __builtin_amdgcn_rcpf(1.f + __builtin_amdgcn_exp2f(-ga[i] * LOG2E)); hv[i] = ga[i] * sg * ua[i]; }
                    if (bj == 0) { w.x = pkh(hv[0], hv[1]); w.y = pkh(hv[2], hv[3]); } else { w.z = pkh(hv[0], hv[1]); w.w = pkh(hv[2], hv[3]); }
                }
                *(u32x4*)(g.oh + (size_t)row * DFF + hc0) = w;
            }
    } else if (g.epi == EPI_RESID) {
        const int col0 = u.pn * BM + wc * 32 + 8 * fq;
#pragma unroll
        for (int ai = 0; ai < 2; ++ai)
#pragma unroll
            for (int m = 0; m < 4; ++m) {
                const int row = row0 + ai * HALF + m * 16;
                const size_t off = (size_t)row * DM + col0;
                float q = 0.f;
#pragma unroll
                for (int bj = 0; bj < 2; ++bj) {
                    const h8 hv = *(const h8*)(g.xh + off + bj * HALF);
                    const f32x4 x0 = (f32x4){(float)hv[0], (float)hv[1], (float)hv[2], (float)hv[3]} + acc[ai][bj][m][0] * g.rscale;
                    const f32x4 x1 = (f32x4){(float)hv[4], (float)hv[5], (float)hv[6], (float)hv[7]} + acc[ai][bj][m][1] * g.rscale;
                    u32x4 w; w.x = pkh(x0[0], x0[1]); w.y = pkh(x0[2], x0[3]); w.z = pkh(x1[0], x1[1]); w.w = pkh(x1[2], x1[3]);
                    *(u32x4*)(g.xh + off + bj * HALF) = w;
                    q += sq4(x0) + sq4(x1);
                }
                q += __shfl_xor(q, 16); q += __shfl_xor(q, 32);
                if (fq == 0) g.ssout[(size_t)row * 16 + u.pn * 4 + wc] = q;
                if (m == 3) asm volatile("" ::: "memory");
            }
    } else if (g.epi == EPI_FINAL) {
        LAS float* Pss = (LAS float*)(lds + LDSCTL_OFF + 1024);
        LAS float* Srs = (LAS float*)(lds + LDSCTL_OFF + 1024 + 4096);
        const int col0 = u.pn * BM + wc * 32 + 8 * fq;
        const int tid_ = opaque_tid();
#pragma unroll
        for (int ai = 0; ai < 2; ++ai)
#pragma unroll
            for (int m = 0; m < 4; ++m) {
                const int rl = ai * HALF + wr * 64 + m * 16 + fr;
                const size_t off = (size_t)(u.pm * BM + rl) * DM + col0;
                float q = 0.f;
#pragma unroll
                for (int bj = 0; bj < 2; ++bj) {
                    const h8 hv = *(const h8*)(g.xh + off + bj * HALF);
                    const f32x4 x0 = (f32x4){(float)hv[0], (float)hv[1], (float)hv[2], (float)hv[3]} + acc[ai][bj][m][0] * g.rscale;
                    const f32x4 x1 = (f32x4){(float)hv[4], (float)hv[5], (float)hv[6], (float)hv[7]} + acc[ai][bj][m][1] * g.rscale;
                    u32x4 w; w.x = pkh(x0[0], x0[1]); w.y = pkh(x0[2], x0[3]); w.z = pkh(x1[0], x1[1]); w.w = pkh(x1[2], x1[3]);
                    *(u32x4*)(g.xh + off + bj * HALF) = w;
                    q += sq4(x0) + sq4(x1);
                }
                q += __shfl_xor(q, 16); q += __shfl_xor(q, 32);
                if (fq == 0) Pss[rl * 4 + wc] = q;
                if (m == 3) asm volatile("" ::: "memory");
            }
        asm volatile("s_waitcnt vmcnt(0) lgkmcnt(0)\n\ts_barrier" ::: "memory");
        unsigned char* wsq = a.ws; asm volatile("" : "+s"(wsq));
        unsigned* cntw = (unsigned*)(wsq + WS_CTL) + 8192 + 64 * u.pm;
        if (tid_ < 256) {
            const f32x4 p4 = *(const LAS f32x4*)(Pss + tid_ * 4);
            const float sv = (p4.x + p4.y) + (p4.z + p4.w);
            __hip_atomic_store((unsigned*)(g.ssout + (size_t)(u.pm * BM + tid_) * 4 + u.pn), __builtin_bit_cast(unsigned, sv), __ATOMIC_RELAXED, __HIP_MEMORY_SCOPE_AGENT);
            asm volatile("s_waitcnt vmcnt(0)" ::: "memory");
            if ((tid_ & 63) == 0) __hip_atomic_fetch_add(cntw, 1u, __ATOMIC_RELAXED, __HIP_MEMORY_SCOPE_AGENT);
        }
        if (tid_ < 64) {
            unsigned sp = 0;
            while ((unsigned)__builtin_amdgcn_readfirstlane(__hip_atomic_load(cntw, __ATOMIC_RELAXED, __HIP_MEMORY_SCOPE_AGENT)) < 16u) { __builtin_amdgcn_s_sleep(2); if (++sp > (1u << 22)) break; }
            __builtin_amdgcn_fence(__ATOMIC_ACQUIRE, "agent");
            asm volatile("s_waitcnt vmcnt(0)" ::: "memory");
        }
        asm volatile("s_waitcnt vmcnt(0) lgkmcnt(0)\n\ts_barrier" ::: "memory");
        if (tid_ < 256) {
            const unsigned* sl = (const unsigned*)(g.ssout + (size_t)(u.pm * BM + tid_) * 4);
            float sv = 0.f;
#pragma unroll
            for (int k = 0; k < 4; ++k) sv += __builtin_bit_cast(float, __hip_atomic_load(sl + k, __ATOMIC_RELAXED, __HIP_MEMORY_SCOPE_AGENT));
            Srs[tid_] = frsq(sv * (1.f / DM) + EPS);
        }
        asm volatile("s_waitcnt vmcnt(0) lgkmcnt(0)\n\ts_barrier" ::: "memory");
        int fr2 = fr, col2 = col0; asm volatile("" : "+v"(fr2), "+v"(col2));
        f32x4 gv[2][2];
#pragma unroll
        for (int bj = 0; bj < 2; ++bj)
#pragma unroll
            for (int n = 0; n < 2; ++n) gv[bj][n] = *(const f32x4*)(a.g_final + col2 + bj * HALF + n * 4);
#pragma unroll
        for (int ai = 0; ai < 2; ++ai)
#pragma unroll
            for (int m = 0; m < 4; ++m) {
                const int rl = ai * HALF + wr * 64 + m * 16 + fr2;
                const float rs = Srs[rl];
                const size_t off = (size_t)(u.pm * BM + rl) * DM + col2;
                asm volatile("" ::: "memory");
#pragma unroll
                for (int bj = 0; bj < 2; ++bj) { const h8 hv = *(const h8*)(g.xh + off + bj * HALF);
                    const f32x4 x0 = (f32x4){(float)hv[0], (float)hv[1], (float)hv[2], (float)hv[3]}, x1 = (f32x4){(float)hv[4], (float)hv[5], (float)hv[6], (float)hv[7]};
                    *(f32x4*)(g.xout + off + bj * HALF) = x0 * rs * gv[bj][0]; *(f32x4*)(g.xout + off + bj * HALF + 4) = x1 * rs * gv[bj][1]; }
            }
        asm volatile("s_waitcnt lgkmcnt(0)\n\ts_barrier" ::: "memory");
    } else if (g.epi == EPI_WIN && u.pn < 6) {
        const float sc = (u.pn < 2) ? 0.125f * LOG2E : 1.f;
#pragma unroll
        for (int ai = 0; ai < 2; ++ai)
#pragma unroll
            for (int mp = 0; mp < 2; ++mp) {
                f32x4 cv[2][2], sv[2][2];
#pragma unroll
                for (int k = 0; k < 2; ++k) { const int t_ = (row0 + ai * HALF + (2 * mp + k) * 16) & (SEQ - 1);
                    cv[k][0] = *(const f32x4*)(g.cos64 + t_ * 32 + 8 * fq); cv[k][1] = *(const f32x4*)(g.cos64 + t_ * 32 + 8 * fq + 4);
                    sv[k][0] = *(const f32x4*)(g.sin64 + t_ * 32 + 8 * fq); sv[k][1] = *(const f32x4*)(g.sin64 + t_ * 32 + 8 * fq + 4); }
#pragma unroll
                for (int k = 0; k < 2; ++k) { const int m = 2 * mp + k;
                    const int row = row0 + ai * HALF + m * 16;
                    const float rs = RST[rl0 + ai * HALF + m * 16] * sc;
                    f16* prow = g.oh + (size_t)row * NP + 256 * u.pn + 64 * wc + 8 * fq;
                    u32x4 w1, w2;
#pragma unroll
                    for (int bj = 0; bj < 2; ++bj) {
                        const f32x4 v0 = acc[ai][bj][m][0] * rs, v1 = acc[ai][bj][m][1] * rs;
                        const f32x4 o1 = v0 * cv[k][bj] - v1 * sv[k][bj], o2 = v0 * sv[k][bj] + v1 * cv[k][bj];
                        if (bj == 0) { w1.x = pkh(o1[0], o1[1]); w1.y = pkh(o1[2], o1[3]); w2.x = pkh(o2[0], o2[1]); w2.y = pkh(o2[2], o2[3]); }
                        else { w1.z = pkh(o1[0], o1[1]); w1.w = pkh(o1[2], o1[3]); w2.z = pkh(o2[0], o2[1]); w2.w = pkh(o2[2], o2[3]); }
                    }
                    *(u32x4*)prow = w1; *(u32x4*)(prow + 32) = w2;
                }
            }
    } else if (g.epi == EPI_WIN) {
        const int pn = u.pn;
#pragma unroll
        for (int ai = 0; ai < 2; ++ai) {
            f32x4 c64v[4], s64v[4];
            if (pn <= 6) {
#pragma unroll
                for (int m = 0; m < 4; ++m) { const int t_ = (row0 + ai * HALF + m * 16) & (SEQ - 1);
                    c64v[m] = *(const f32x4*)(g.cos64 + t_ * 32 + 16 * (wc & 1) + 4 * fq); s64v[m] = *(const f32x4*)(g.sin64 + t_ * 32 + 16 * (wc & 1) + 4 * fq); }
            }
#pragma unroll
            for (int m = 0; m < 4; ++m) {
                const int row = row0 + ai * HALF + m * 16;
                const int t = row & (SEQ - 1);
                const float rs = RST[rl0 + ai * HALF + m * 16];
                f16* prow = g.oh + (size_t)row * NP;
                float ssacc = 0.f;
#pragma unroll
                for (int bj = 0; bj < 2; ++bj) {
                    const f32x4 v0 = acc[ai][bj][m][0] * rs, v1 = acc[ai][bj][m][1] * rs;
                    int type, pcol;
                    float sc = 1.f;
                    if (pn < 6) { type = 0; pcol = 256 * pn + 128 * bj + 64 * (wc >> 1); if (pn < 2) sc = 0.125f * LOG2E; }
                    else if (pn == 6) {
                        if (bj == 0) { type = 0; pcol = PC_KA + 64 * (wc >> 1); }
                        else if (wc == 0) { type = 1; pcol = PC_KR; }
                        else if (wc < 3) { type = 2; pcol = PC_VA + 32 * (wc - 1); }
                        else { type = 3; pcol = 0; }
                    } else if (pn == 7) { type = 2; pcol = PC_CQ + 128 * bj + 32 * wc; }
                    else if (pn == 8) { if (bj == 0) { type = 2; pcol = PC_CQ + 256 + 32 * wc; } else { type = 4; pcol = 0; } }
                    else { type = 2; pcol = PC_CKV + 128 * bj + 32 * wc; }
                    if (type == 0) {
                        const int g2 = wc & 1;
                        const f32x4 c4 = c64v[m], s4 = s64v[m];
                        const f32x4 o1 = (v0 * c4 - v1 * s4) * sc, o2 = (v0 * s4 + v1 * c4) * sc;
                        u32x2 w1; w1.x = pkh(o1[0], o1[1]); w1.y = pkh(o1[2], o1[3]);
                        u32x2 w2; w2.x = pkh(o2[0], o2[1]); w2.y = pkh(o2[2], o2[3]);
                        *(u32x2*)(prow + pcol + 16 * g2 + 4 * fq) = w1;
                        *(u32x2*)(prow + pcol + 32 + 16 * g2 + 4 * fq) = w2;
                    } else if (type == 1) {
                        const f32x4 c4 = *(const f32x4*)(g.cos32 + t * 16 + 4 * fq), s4 = *(const f32x4*)(g.sin32 + t * 16 + 4 * fq);
                        const f32x4 o1 = v0 * c4 - v1 * s4, o2 = v0 * s4 + v1 * c4;
                        u32x2 w1; w1.x = pkh(o1[0], o1[1]); w1.y = pkh(o1[2], o1[3]);
                        u32x2 w2; w2.x = pkh(o2[0], o2[1]); w2.y = pkh(o2[2], o2[3]);
                        *(u32x2*)(prow + pcol + 4 * fq) = w1;
                        *(u32x2*)(prow + pcol + 16 + 4 * fq) = w2;
                    } else if (type == 2) {
                        u32x4 w; w.x = pkh(v0[0], v0[1]); w.y = pkh(v0[2], v0[3]); w.z = pkh(v1[0], v1[1]); w.w = pkh(v1[2], v1[3]);
                        *(u32x4*)(prow + pcol + 8 * fq) = w;
                        ssacc += sq4(v0) + sq4(v1);
                    } else if (type == 3) {
                        *(f32x4*)(g.wi + (size_t)row * 16 + 4 * fq) = v0;
                    }
                }
                if (pn >= 7) {
                    ssacc += __shfl_xor(ssacc, 16); ssacc += __shfl_xor(ssacc, 32);
                    if (fq == 0) {
                        if (pn == 7) g.ssq[(size_t)row * 8 + wc] = ssacc;
                        else if (pn == 8) g.ssq[(size_t)row * 8 + 4 + wc] = ssacc;
                        else g.sskv[(size_t)row * 4 + wc] = ssacc;
                    }
                }
            }
        }
    } else if (g.epi == EPI_QUP) {
        const float c2b = 0.10206207261596577f * LOG2E;
#pragma unroll
        for (int ai = 0; ai < 2; ++ai)
#pragma unroll
            for (int m = 0; m < 4; ++m) {
                const int row = row0 + ai * HALF + m * 16;
                const int t = row & (SEQ - 1);
                const float rs = RST[rl0 + ai * HALF + m * 16] * c2b;
                f16* prow = g.oh + (size_t)row * NQB;
#pragma unroll
                for (int bj = 0; bj < 2; ++bj) {
                    const f32x4 v0 = acc[ai][bj][m][0] * rs, v1 = acc[ai][bj][m][1] * rs;
                    if (u.pn < 2) {
                        u32x4 w; w.x = pkh(v0[0], v0[1]); w.y = pkh(v0[2], v0[3]); w.z = pkh(v1[0], v1[1]); w.w = pkh(v1[2], v1[3]);
                        *(u32x4*)(prow + 256 * u.pn + 128 * bj + 32 * wc + 8 * fq) = w;
                    } else {
                        const int head = 4 * bj + wc;
                        const f32x4 c4 = *(const f32x4*)(g.cos32 + t * 16 + 4 * fq), s4 = *(const f32x4*)(g.sin32 + t * 16 + 4 * fq);
                        const f32x4 o1 = v0 * c4 - v1 * s4, o2 = v0 * s4 + v1 * c4;
                        u32x2 w1; w1.x = pkh(o1[0], o1[1]); w1.y = pkh(o1[2], o1[3]);
                        u32x2 w2; w2.x = pkh(o2[0], o2[1]); w2.y = pkh(o2[2], o2[3]);
                        *(u32x2*)(prow + 512 + 32 * head + 4 * fq) = w1;
                        *(u32x2*)(prow + 512 + 32 * head + 16 + 4 * fq) = w2;
                    }
                }
            }
    } else {
#pragma unroll
        for (int ai = 0; ai < 2; ++ai)
#pragma unroll
            for (int m = 0; m < 4; ++m) {
                const int row = row0 + ai * HALF + m * 16;
                const float rs = RST[rl0 + ai * HALF + m * 16];
                f16* prow = g.oh + (size_t)row * NKV;
#pragma unroll
                for (int bj = 0; bj < 2; ++bj) {
                    const f32x4 v0 = acc[ai][bj][m][0] * rs, v1 = acc[ai][bj][m][1] * rs;
                    u32x4 w; w.x = pkh(v0[0], v0[1]); w.y = pkh(v0[2], v0[3]); w.z = pkh(v1[0], v1[1]); w.w = pkh(v1[2], v1[3]);
                    *(u32x4*)(prow + 256 * u.pn + 128 * bj + 32 * wc + 8 * fq) = w;
                }
            }
    }
}

__device__ __forceinline__ void gemm_phase(LAS unsigned char* lds, const Args& args, const int gi, const GemmDesc& g, const StaticOrder& S) {
    const int tid = opaque_tid(), wid = __builtin_amdgcn_readfirstlane(tid >> 6), lane = tid & 63, wr = wid >> 2, wc = wid & 3, fr = lane & 15, fq = lane >> 4;
    const int K = g.K, nt = K / BK, lda = g.lda;
    unsigned voffA[2], voffB[2];
#pragma unroll
    for (int i = 0; i < 2; ++i) { int R, C; stage_rc(tid * 16 + i * 8192, R, C);
        voffA[i] = (unsigned)(R * lda + C) * 2u; voffB[i] = (unsigned)(R * K + C) * 2u; }
    const size_t kstep = (size_t)(BK * 2);
    const size_t hstepA = (size_t)HALF * lda * 2, hstepB = (size_t)HALF * K * 2;
    const size_t tstepA = 2 * hstepA, tstepB = 2 * hstepB;
    const unsigned ldsw = (unsigned)wid * 1024u;
    const int aoff = lds_byte(wr * 64 + fr, fq * 8), boff = lds_byte(wc * 32 + fr, fq * 8);
#define PG8_SA(b, h) (((b) * 2 + (h)) * HTB)
#define PG8_SB(b, h) ((4 + (b) * 2 + (h)) * HTB)
#define PG8_STAGE(bufoff, gbase, voff) do { _Pragma("unroll") for (int _i = 0; _i < 2; ++_i) \
        __builtin_amdgcn_global_load_lds((const unsigned*)((const char*)(gbase) + (voff)[_i]), (LAS unsigned*)(lds + (bufoff) + ldsw + _i * 8192), 16, 0, 0); } while (0)
#define PG8_LDA(dst, b, h) do { _Pragma("unroll") for (int m = 0; m < 4; ++m) _Pragma("unroll") for (int k = 0; k < 2; ++k) dst[m][k] = *(const LAS h8*)(lds + PG8_SA(b, h) + aoff + m * 2048 + k * 1024); } while (0)
#define PG8_LDB(dst, b, h) do { _Pragma("unroll") for (int n = 0; n < 2; ++n) _Pragma("unroll") for (int k = 0; k < 2; ++k) dst[n][k] = *(const LAS h8*)(lds + PG8_SB(b, h) + boff + n * 2048 + k * 1024); } while (0)
#define PG8_MMA(ai, bj, At, Bt) do { __builtin_amdgcn_s_setprio(1); _Pragma("unroll") for (int m = 0; m < 4; ++m) _Pragma("unroll") for (int n = 0; n < 2; ++n) _Pragma("unroll") for (int k = 0; k < 2; ++k) \
        acc[ai][bj][m][n] = __builtin_amdgcn_mfma_f32_16x16x32_f16(Bt[n][k], At[m][k], acc[ai][bj][m][n], 0, 0, 0); __builtin_amdgcn_s_setprio(0); } while (0)
#define PG8_WAIT_V(n) asm volatile("s_waitcnt vmcnt(" #n ")" ::: "memory")
#define PG8_WAIT_L(n) asm volatile("s_waitcnt lgkmcnt(" #n ")" ::: "memory")
#define PG8_BAR __builtin_amdgcn_s_barrier()
#define PG8_SCHED __builtin_amdgcn_sched_barrier(0)
    Unit cur, nxt; int ui = 0;
    if (!S.next(0, cur)) return;
    f32x4 acc[2][2][4][2];
#pragma unroll
    for (int a = 0; a < 2; ++a)
#pragma unroll
        for (int b = 0; b < 2; ++b)
#pragma unroll
            for (int m = 0; m < 4; ++m)
#pragma unroll
                for (int n = 0; n < 2; ++n) acc[a][b][m][n] = (f32x4){0.f, 0.f, 0.f, 0.f};
    h8 At[4][2], B0[2][2], B1[2][2];
    LAS float* RSTw = (LAS float*)(lds + LDSCTL_OFF + 7168);
    if (g.ss && tid < 256) RSTw[tid] = row_rstd_rt(g.ss, g.nss, cur.pm * BM + tid, g.invn);
    const char* cA = (const char*)g.A + (size_t)cur.pm * tstepA; const char* cB = (const char*)g.Bt + (size_t)cur.pn * tstepB;
    PG8_STAGE(PG8_SB(0, 0), cB, voffB); PG8_STAGE(PG8_SB(0, 1), cB + hstepB, voffB); PG8_STAGE(PG8_SA(0, 0), cA, voffA); PG8_STAGE(PG8_SA(0, 1), cA + hstepA, voffA);
    if (wr == 1) PG8_BAR;
    PG8_WAIT_V(2); PG8_BAR;
    PG8_STAGE(PG8_SB(1, 0), cB + kstep, voffB); PG8_STAGE(PG8_SA(1, 0), cA + kstep, voffA); PG8_STAGE(PG8_SB(1, 1), cB + hstepB + kstep, voffB);
    PG8_WAIT_V(6); PG8_BAR;
    for (;;) {
        const bool has_next = S.next(ui + 1, nxt);
        const char* nA = has_next ? (const char*)g.A + (size_t)nxt.pm * tstepA : cA; const char* nB = has_next ? (const char*)g.Bt + (size_t)nxt.pn * tstepB : cB;
        for (int t = 0; t < nt; t += 2) {
            const bool last = (t == nt - 2);
            const char* a1 = cA + (size_t)(t + 1) * kstep;
            const char* a2 = last ? nA : cA + (size_t)(t + 2) * kstep; const char* b2 = last ? nB : cB + (size_t)(t + 2) * kstep;
            const char* a3 = a2 + kstep; const char* b3 = b2 + kstep;
            PG8_LDB(B0, 0, 0); PG8_LDB(B1, 0, 1); PG8_SCHED; PG8_LDA(At, 0, 0); PG8_STAGE(PG8_SA(1, 1), a1 + hstepA, voffA);
            PG8_WAIT_V(8); PG8_WAIT_L(0); PG8_BAR; PG8_MMA(0, 0, At, B0); PG8_MMA(0, 1, At, B1); PG8_BAR; PG8_SCHED;
            PG8_LDA(At, 0, 1); PG8_STAGE(PG8_SB(0, 0), b2, voffB); PG8_STAGE(PG8_SB(0, 1), b2 + hstepB, voffB); PG8_STAGE(PG8_SA(0, 0), a2, voffA);
            PG8_WAIT_V(8); PG8_WAIT_L(0); PG8_BAR; PG8_MMA(1, 0, At, B0); PG8_MMA(1, 1, At, B1); PG8_BAR; PG8_SCHED;
            PG8_LDB(B0, 1, 0); PG8_LDB(B1, 1, 1); PG8_SCHED; PG8_LDA(At, 1, 0); PG8_STAGE(PG8_SA(0, 1), a2 + hstepA, voffA);
            PG8_WAIT_V(8); PG8_WAIT_L(0); PG8_BAR; PG8_MMA(0, 0, At, B0); PG8_MMA(0, 1, At, B1); PG8_BAR; PG8_SCHED;
            PG8_LDA(At, 1, 1); PG8_STAGE(PG8_SB(1, 0), b3, voffB); PG8_STAGE(PG8_SB(1, 1), b3 + hstepB, voffB); PG8_STAGE(PG8_SA(1, 0), a3, voffA);
            PG8_WAIT_V(8); PG8_WAIT_L(0); PG8_BAR; PG8_MMA(1, 0, At, B0); PG8_MMA(1, 1, At, B1); PG8_BAR; PG8_SCHED;
        }
        if (wr == 0) PG8_BAR;
        epilogue(args, gi, acc, cur, wr, wc, fr, fq, lds, ui & 1);
        if (!has_next) break;
#pragma unroll
        for (int a = 0; a < 2; ++a)
#pragma unroll
            for (int b = 0; b < 2; ++b)
#pragma unroll
                for (int m = 0; m < 4; ++m)
#pragma unroll
                    for (int n = 0; n < 2; ++n) acc[a][b][m][n] = (f32x4){0.f, 0.f, 0.f, 0.f};
        cur = nxt; cA = nA; cB = nB; ++ui;
        if (g.ss && tid < 256) RSTw[(ui & 1) * 256 + tid] = row_rstd_rt(g.ss, g.nss, cur.pm * BM + tid, g.invn);
        if (wr == 1) PG8_BAR;
    }
    PG8_WAIT_V(0);
    PG8_BAR;
#undef PG8_SA
#undef PG8_SB
#undef PG8_STAGE
#undef PG8_LDA
#undef PG8_LDB
#undef PG8_MMA
#undef PG8_WAIT_V
#undef PG8_WAIT_L
#undef PG8_BAR
#undef PG8_SCHED
}
__device__ __forceinline__ void make_gemm(const Args& a, int gi, GemmDesc& g) {
    unsigned char* ws = a.ws; const float* ax = a.x; float* aout = a.out;
    asm volatile("" : "+s"(ws), "+s"(ax), "+s"(aout));
    float* rope = (float*)(ws + WS_ROPE);
    g.M = M; g.ss = nullptr; g.nss = 1; g.invn = 1.f / DM; g.oh = nullptr; g.ldo = 0; g.xin = nullptr; g.xout = nullptr; g.xh = nullptr; g.ssout = nullptr; g.rscale = 1.f;
    g.cos64 = rope; g.sin64 = rope + SEQ * 32; g.cos32 = rope + SEQ * 64; g.sin32 = rope + SEQ * 64 + SEQ * 16;
    g.wi = (float*)(ws + WS_WI); g.ssq = (float*)(ws + WS_SSQ); g.sskv = (float*)(ws + WS_SSKV);
    switch (gi) {
        case G_FFN1A: g.A = (const f16*)(ws + WS_XH); g.Bt = (const f16*)(ws + WS_BT1); g.N = NFF; g.K = DM; g.lda = DM; g.epi = EPI_SWIGLU;
            g.ss = (const float*)(ws + WS_SS0); g.nss = 1; g.oh = (f16*)(ws + WS_H); break;
        case G_FFN1B: g.A = (const f16*)(ws + WS_H); g.Bt = (const f16*)(ws + WS_BTD1); g.N = DM; g.K = DFF; g.lda = DFF; g.epi = EPI_RESID;
            g.xin = nullptr; g.xout = aout; g.xh = (f16*)(ws + WS_XH); g.ssout = (float*)(ws + WS_SS16); g.rscale = 0.5f; break;
        case G_WIN: g.A = (const f16*)(ws + WS_XH); g.Bt = (const f16*)(ws + WS_BTIN); g.N = NP; g.K = DM; g.lda = DM; g.epi = EPI_WIN;
            g.ss = (const float*)(ws + WS_SS16); g.nss = 16; g.oh = (f16*)(ws + WS_P); break;
        case G_QUP: g.A = (const f16*)(ws + WS_P) + PC_CQ; g.Bt = (const f16*)(ws + WS_BTQ); g.N = NQB; g.K = QLORA; g.lda = NP; g.epi = EPI_QUP;
            g.ss = (const float*)(ws + WS_SSQ); g.nss = 8; g.invn = 1.f / QLORA; g.oh = (f16*)(ws + WS_QB); break;
        case G_KVUP: g.A = (const f16*)(ws + WS_P) + PC_CKV; g.Bt = (const f16*)(ws + WS_BTKV); g.N = NKV; g.K = KVLORA; g.lda = NP; g.epi = EPI_KVUP;
            g.ss = (const float*)(ws + WS_SSKV); g.nss = 4; g.invn = 1.f / KVLORA; g.oh = (f16*)(ws + WS_KV); break;
        case G_WOUT: g.A = (const f16*)(ws + WS_MIX); g.Bt = (const f16*)(ws + WS_BTOUT); g.N = DM; g.K = DM; g.lda = DM; g.epi = EPI_RESID;
            g.xin = nullptr; g.xout = aout; g.xh = (f16*)(ws + WS_XH); g.ssout = (float*)(ws + WS_SS16); g.rscale = 1.f; break;
        case G_FFN2A: g.A = (const f16*)(ws + WS_XH); g.Bt = (const f16*)(ws + WS_BT2); g.N = NFF; g.K = DM; g.lda = DM; g.epi = EPI_SWIGLU;
            g.ss = (const float*)(ws + WS_SS16); g.nss = 16; g.oh = (f16*)(ws + WS_H); break;
        default: g.A = (const f16*)(ws + WS_H); g.Bt = (const f16*)(ws + WS_BTD2); g.N = DM; g.K = DFF; g.lda = DFF; g.epi = (FUSE_FINAL && gridDim.x == 256) ? EPI_FINAL : EPI_RESID;
            g.xin = nullptr; g.xout = aout; g.xh = (f16*)(ws + WS_XH); g.ssout = (float*)(ws + WS_SS16); g.rscale = 0.5f; break;
    }
}

}

struct Frame {
    LAS unsigned char* lds;
    int tid, lane, wave, vcu, G;
};

__device__ __forceinline__ bool prep_rowmap(const Args& a, int mat, int R, const float*& W, int& col, int& N) {
    using pg8::perm32;
    switch (mat) {
        case 0: case 2: { const int pn_ = R >> 8, rr = R & 255, bj = rr >> 7, wc_ = (rr >> 5) & 3, n = (rr >> 4) & 1, fq_ = (rr >> 2) & 3; col = 128 * pn_ + 32 * wc_ + 8 * fq_ + 4 * bj + (rr & 3); N = DFF;
            W = (mat == 0) ? (n ? a.w1_up : a.w1_gate) : (n ? a.w2_up : a.w2_gate); return true; }
        case 1: W = a.w1_down; col = (R & ~31) + perm32(R & 31); N = DM; return true;
        case 3: W = a.w2_down; col = (R & ~31) + perm32(R & 31); N = DM; return true;
        case 4: { W = a.w_in; N = DPROJ;
            if (R < PC_KR) {
                int base, rr;
                if (R < PC_KA) {
                    if (R < PC_QI) { base = WC_QA; rr = R; } else { base = WC_QI; rr = R - PC_QI; }
                    const int tl = rr >> 8, sl = rr & 255, bj = sl >> 7, wc_ = (sl >> 5) & 3, n = (sl >> 4) & 1, fq_ = (sl >> 2) & 3;
                    col = base + (4 * tl + wc_) * 64 + 32 * n + 8 * fq_ + 4 * bj + (sl & 3); return true; }
                if (R < PC_KI) { base = WC_KA; rr = R - PC_KA; } else { base = WC_KI; rr = R - PC_KI; }
                const int h = rr >> 6, w = rr & 63, g2 = w >> 5, n = (w >> 4) & 1, j = w & 15;
                col = base + h * 64 + 32 * n + 16 * g2 + j; return true; }
            if (R < PC_VA) { col = WC_KR + (R - PC_KR); return true; }
            if (R < PC_WI) { const int rr = R - PC_VA; col = WC_VA + (rr & ~31) + perm32(rr & 31); return true; }
            if (R < PC_WI + 16) { col = WC_WI + (R - PC_WI); return true; }
            if (R < PC_CQ) return false;
            if (R < PC_CQ + QLORA) { const int rr = R - PC_CQ; col = WC_CQ + (rr & ~31) + perm32(rr & 31); return true; }
            if (R < PC_CKV) return false;
            { const int rr = R - PC_CKV; col = WC_CKV + (rr & ~31) + perm32(rr & 31); return true; } }
        case 5: { W = a.w_uq; N = 768;
            if (R < 512) { const int Rp = (R & ~31) + perm32(R & 31); col = (Rp >> 6) * 96 + (Rp & 63); }
            else { const int rr = R - 512; col = (rr >> 5) * 96 + 64 + (rr & 31); }
            return true; }
        case 6: { W = a.w_ukv; N = 1024;
            const int rr = R & 511, Rp = (rr & ~31) + perm32(rr & 31);
            col = (Rp >> 6) * 128 + (R >= 512 ? 64 : 0) + (Rp & 63); return true; }
        default: W = a.w_out; col = (R & ~31) + perm32(R & 31); N = DM; return true;
    }
}
__device__ __forceinline__ void prep_item(const Args& a, int mat, int K, const float* gain, f16* Bt, LAS float* scr, int item, int lane) {
    const int nkb = K / 64, rb = item / nkb, kb = item % nkb, k0 = 64 * kb, R0 = 32 * rb;
    const float* W; int col, N;
    const int cg = lane & 7, kr = lane >> 3;
    const bool valid = prep_rowmap(a, mat, R0 + 4 * cg, W, col, N);
#pragma unroll
    for (int i = 0; i < 8; ++i) { const int kk = 8 * i + kr;
        f32x4 v = (f32x4){0.f, 0.f, 0.f, 0.f};
        if (valid) { v = *(const f32x4*)(W + (size_t)(k0 + kk) * N + col); if (gain) v = v * gain[k0 + kk]; }
        LAS float* d = scr + kk * 33 + 4 * cg; d[0] = v.x; d[1] = v.y; d[2] = v.z; d[3] = v.w; }
    LDS_WAIT(); asm volatile("" ::: "memory");
    const int c = lane & 7;
#pragma unroll
    for (int j = 0; j < 4; ++j) { const int n = (lane >> 3) + 8 * j; const LAS float* s = scr + (8 * c) * 33 + n;
        u32x4 o; o.x = pkh(s[0 * 33], s[1 * 33]); o.y = pkh(s[2 * 33], s[3 * 33]); o.z = pkh(s[4 * 33], s[5 * 33]); o.w = pkh(s[6 * 33], s[7 * 33]);
        *(u32x4*)(Bt + (size_t)(R0 + n) * K + k0 + 8 * c) = o; }
    LDS_WAIT(); asm volatile("" ::: "memory");
}
__device__ __forceinline__ void prep_phase(const Args& a, Frame& F) {
    unsigned char* ws = a.ws;
    LAS float* scr = (LAS float*)(F.lds + F.wave * 16384);
    const int gw = F.vcu * NWAVES + F.wave, NGW = F.G * NWAVES;
    constexpr int I0 = 16 * (NFF / 32), I1 = (DFF / 64) * 32, I4 = 16 * (NP / 32), I5 = (QLORA / 64) * (NQB / 32), I6 = (KVLORA / 64) * (NKV / 32), I7 = 16 * 32;
    constexpr int NITEMS = 2 * I0 + 2 * I1 + I4 + I5 + I6 + I7;
    for (int it = gw; it < NITEMS; it += NGW) {
        int r = it;
        if (r < I0) { prep_item(a, 0, DM, a.g_ffn1, (f16*)(ws + WS_BT1), scr, r, F.lane); continue; } r -= I0;
        if (r < I1) { prep_item(a, 1, DFF, nullptr, (f16*)(ws + WS_BTD1), scr, r, F.lane); continue; } r -= I1;
        if (r < I0) { prep_item(a, 2, DM, a.g_ffn2, (f16*)(ws + WS_BT2), scr, r, F.lane); continue; } r -= I0;
        if (r < I1) { prep_item(a, 3, DFF, nullptr, (f16*)(ws + WS_BTD2), scr, r, F.lane); continue; } r -= I1;
        if (r < I4) { prep_item(a, 4, DM, a.g_mix, (f16*)(ws + WS_BTIN), scr, r, F.lane); continue; } r -= I4;
        if (r < I5) { prep_item(a, 5, QLORA, a.g_q_lat, (f16*)(ws + WS_BTQ), scr, r, F.lane); continue; } r -= I5;
        if (r < I6) { prep_item(a, 6, KVLORA, a.g_kv_lat, (f16*)(ws + WS_BTKV), scr, r, F.lane); continue; } r -= I6;
        prep_item(a, 7, DM, nullptr, (f16*)(ws + WS_BTOUT), scr, r, F.lane);
    }
    {
        f16* XH = (f16*)(ws + WS_XH); float* SS0 = (float*)(ws + WS_SS0);
        for (int m = gw; m < M; m += NGW) {
            const f32x4* xr = (const f32x4*)(a.x + (size_t)m * DM) + F.lane;
            f32x4 v[4]; float s = 0.f;
#pragma unroll
            for (int j = 0; j < 4; ++j) { v[j] = xr[64 * j]; s += sq4(v[j]); }
            s = wave_sum(s);
            u32x2* o8 = (u32x2*)(XH + (size_t)m * DM) + F.lane;
#pragma unroll
            for (int j = 0; j < 4; ++j) { u32x2 w; w.x = pkh(v[j].x, v[j].y); w.y = pkh(v[j].z, v[j].w); o8[64 * j] = w; }
            if (F.lane == 0) SS0[m] = s;
        }
    }
    {
        float* c64 = (float*)(ws + WS_ROPE); float* s64 = c64 + SEQ * 32; float* c32 = s64 + SEQ * 32; float* s32 = c32 + SEQ * 16;
        const int gt = (F.vcu * NWAVES + F.wave) * 64 + F.lane, NT = F.G * NWAVES * 64;
        for (int e = gt; e < SEQ * 48; e += NT) {
            const int t = e / 48, j = e % 48;
            const double ex = (j < 32) ? -(double)(2 * j) / 64.0 : -(double)(2 * (j - 32)) / 32.0;
            const double xx = ex * 13.287712379549449;
            const double nf = __builtin_floor(xx), ff = (xx - nf) * 0.69314718055994530942;
            double pe = 1.0 / 1307674368000.0;
#pragma unroll
            for (int kk = 14; kk >= 1; --kk) { double fact = 1.0; for (int q2 = 2; q2 <= kk; ++q2) fact *= (double)q2; pe = pe * ff + 1.0 / fact; }
            pe = pe * ff + 1.0;
            const float inv = (float)__builtin_ldexp(pe, (int)nf);
            const float angf = (float)t * inv;
            const double ang = (double)angf;
            const double kq = __builtin_rint(ang * 0.63661977236758134308);
            double r = __builtin_fma(-kq, 1.57079632679489655800, ang);
            r = __builtin_fma(-kq, 6.12323399573676603587e-17, r);
            const double r2 = r * r;
            double sn = -1.0 / 6227020800.0; sn = sn * r2 + 1.0 / 39916800.0; sn = sn * r2 - 1.0 / 362880.0; sn = sn * r2 + 1.0 / 5040.0; sn = sn * r2 - 1.0 / 120.0; sn = sn * r2 + 1.0 / 6.0; sn = -sn * r2 * r + r;
            double cs = 1.0 / 479001600.0; cs = cs * r2 - 1.0 / 3628800.0; cs = cs * r2 + 1.0 / 40320.0; cs = cs * r2 - 1.0 / 720.0; cs = cs * r2 + 1.0 / 24.0; cs = cs * r2 - 0.5; cs = cs * r2 + 1.0;
            const int q = ((int)kq) & 3;
            const double S = (q == 0) ? sn : (q == 1) ? cs : (q == 2) ? -sn : -cs;
            const double C = (q == 0) ? cs : (q == 1) ? -sn : (q == 2) ? -cs : sn;
            if (j < 32) { c64[t * 32 + j] = (float)C; s64[t * 32 + j] = (float)S; }
            else { c32[t * 16 + (j - 32)] = (float)C; s32[t * 16 + (j - 32)] = (float)S; }
        }
    }
}


namespace att {
constexpr int KSL = 12288, VSL = 8192, SLOT = KSL + VSL;
constexpr int WSF_OFF = 2 * SLOT, OST_OFF = WSF_OFF + 2048, ATT_LDS = OST_OFF + 8 * 4096;
static_assert(ATT_LDS <= RING_BYTES, "attention LDS");
typedef short v4i16_t __attribute__((ext_vector_type(4)));
__device__ __forceinline__ int crow(int r, int hi) { return (r & 3) + 8 * (r >> 2) + 4 * hi; }
__device__ __forceinline__ h4 vtr(const LAS unsigned char* p) { return __builtin_bit_cast(h4, __builtin_amdgcn_ds_read_tr16_b64_v4i16((LAS v4i16_t*)p)); }
__device__ __forceinline__ float hmax2(float a) { return fmaxf(a, __shfl_xor(a, 32)); }
__device__ __forceinline__ float hsum2(float a) { return a + __shfl_xor(a, 32); }
#define ATT_BAR() asm volatile("s_waitcnt vmcnt(0) lgkmcnt(0)\n\ts_barrier" ::: "memory")

template <int MODE>
__device__ __forceinline__ void attn_unit(const Args& a, LAS unsigned char* lds, int b, int h, int q0) {
    constexpr int ND = (MODE == 0) ? 6 : 4;
    constexpr float THR = 8.f;
    unsigned char* ws = a.ws; asm volatile("" : "+s"(ws));
    const f16* P = (const f16*)(ws + WS_P); const f16* QB = (const f16*)(ws + WS_QB); const f16* KV = (const f16*)(ws + WS_KV); f16* MIX = (f16*)(ws + WS_MIX);
    const unsigned* MASK = (const unsigned*)(ws + WS_MASK);
    const int tid = opaque_tid(), lane = tid & 63, r32 = lane & 31, hi = lane >> 5; const int w = __builtin_amdgcn_readfirstlane(tid >> 6);
    const size_t rowbase = (size_t)b * SEQ;
    const int qw = (MODE == 0) ? q0 + 32 * w : q0;
    const int NT = (MODE == 0) ? (q0 + 256) / 64 : (q0 + 32 + 63) / 64;
    LAS float* wsf = (LAS float*)(lds + WSF_OFF) + w * 64;
    auto dma = [&](int t, int s) {
        LAS unsigned char* ks = lds + s * SLOT; LAS unsigned char* vs = ks + KSL;
        const size_t krow = rowbase + 64 * t + lane, vrow = rowbase + 64 * t + 16 * (w & 3) + (lane >> 2);
        if (MODE == 0) {
            __builtin_amdgcn_global_load_lds((const unsigned*)(KV + krow * NKV + h * 64 + 8 * w), (LAS unsigned*)(ks + w * 1024), 16, 0, 0);
            if (w < 4) __builtin_amdgcn_global_load_lds((const unsigned*)(P + krow * NP + PC_KR + 8 * w), (LAS unsigned*)(ks + (8 + w) * 1024), 16, 0, 0);
            __builtin_amdgcn_global_load_lds((const unsigned*)(KV + vrow * NKV + 512 + h * 64 + (w >> 2) * 32 + (lane & 3) * 8), (LAS unsigned*)(vs + w * 1024), 16, 0, 0);
        } else {
            __builtin_amdgcn_global_load_lds((const unsigned*)(P + krow * NP + PC_KA + 8 * w), (LAS unsigned*)(ks + w * 1024), 16, 0, 0);
            __builtin_amdgcn_global_load_lds((const unsigned*)(P + vrow * NP + PC_VA + (w >> 2) * 32 + (lane & 3) * 8), (LAS unsigned*)(vs + w * 1024), 16, 0, 0);
        }
    };
    dma(0, 0);
    h8 qr[ND];
    if (MODE == 0) {
        const f16* qp = QB + (rowbase + qw + r32) * NQB;
#pragma unroll
        for (int d0 = 0; d0 < 4; ++d0) qr[d0] = *(const h8*)(qp + h * 64 + 16 * d0 + 8 * hi);
#pragma unroll
        for (int d0 = 4; d0 < ND; ++d0) qr[d0] = *(const h8*)(qp + 512 + h * 32 + 16 * (d0 - 4) + 8 * hi);
    } else {
        const f16* qp = P + (rowbase + qw + r32) * NP + PC_QA + w * 64;
#pragma unroll
        for (int d0 = 0; d0 < ND; ++d0) qr[d0] = *(const h8*)(qp + 16 * d0 + 8 * hi);
    }
    const unsigned* mp = MASK + ((rowbase + qw + r32) * 2 + hi) * 64;
    unsigned mw_next = (MODE == 1) ? mp[0] : 0u;
    float mhat = 0.f, lsum = 0.f;
    f32x16 o[2]; o[0] = f32x16{}; o[1] = f32x16{};
    f32x16 negm = f32x16{};
    const int vp0 = ((lane >> 4) & 1) * 32 + (lane & 3) * 8 + (4 * hi + ((lane & 15) >> 2)) * 64;
    for (int t = 0; t < NT; ++t) {
        ATT_BAR();
        if (t + 1 < NT) dma(t + 1, (t + 1) & 1);
        const unsigned mw = mw_next;
        if (MODE == 1 && t + 1 < NT) mw_next = mp[t + 1];
        if (MODE == 1 || 64 * t <= qw + 31) {
            const LAS unsigned char* ks = lds + (t & 1) * SLOT + hi * 1024 + r32 * 16; const LAS unsigned char* vs = lds + (t & 1) * SLOT + KSL + vp0;
            f32x16 p0 = negm, p1 = negm;
#pragma unroll
            for (int d0 = 0; d0 < ND; ++d0) {
                const h8 b0 = *(const LAS h8*)(ks + d0 * 2048), b1 = *(const LAS h8*)(ks + d0 * 2048 + 512);
                p0 = __builtin_amdgcn_mfma_f32_32x32x16_f16(b0, qr[d0], p0, 0, 0, 0);
                p1 = __builtin_amdgcn_mfma_f32_32x32x16_f16(b1, qr[d0], p1, 0, 0, 0);
            }
            if (MODE == 0 && 64 * t + 63 > qw) {
                const int qrow = qw + r32, kb = 64 * t + 4 * hi;
#pragma unroll
                for (int r = 0; r < 16; ++r) { const int kv = kb + (r & 3) + 8 * (r >> 2); if (kv > qrow) p0[r] = -INFINITY; if (kv + 32 > qrow) p1[r] = -INFINITY; }
            }
            float rm = fmaxf(fmaxf(p0[0], p1[0]), fmaxf(p0[1], p1[1]));
#pragma unroll
            for (int r = 2; r < 16; r += 2) rm = fmaxf(fmaxf(rm, p0[r]), fmaxf(p1[r], fmaxf(p0[r + 1], p1[r + 1])));
            rm = hmax2(rm);
            if (t == 0 || __any(rm > THR)) {
                const float dl = (t == 0) ? rm : fmaxf(rm, 0.f), f = (t == 0) ? 1.f : __builtin_amdgcn_exp2f(-dl);
                lsum *= f; mhat += dl;
#pragma unroll
                for (int r = 0; r < 16; ++r) { p0[r] -= dl; p1[r] -= dl; negm[r] = -mhat; }
                if (hi == 0) wsf[r32] = f;
                LDS_WAIT();
#pragma unroll
                for (int r = 0; r < 16; ++r) { const float fr_ = wsf[crow(r, hi)]; o[0][r] *= fr_; o[1][r] *= fr_; }
                LDS_WAIT();
            }
#pragma unroll
            for (int r = 0; r < 16; ++r) { p0[r] = __builtin_amdgcn_exp2f(p0[r]); p1[r] = __builtin_amdgcn_exp2f(p1[r]); }
            if (MODE == 1) {
#pragma unroll
                for (int r = 0; r < 16; ++r) {
                    p0[r] = ((mw >> (15 - r)) & 1u) ? p0[r] : 0.f;
                    p1[r] = ((mw >> (31 - r)) & 1u) ? p1[r] : 0.f;
                }
            }
            float sacc0 = 0.f, sacc1 = 0.f;
#pragma unroll
            for (int r = 0; r < 16; ++r) { sacc0 += p0[r]; sacc1 += p1[r]; }
            lsum += sacc0 + sacc1;
            h8 pa[4];
#pragma unroll
            for (int j = 0; j < 4; ++j) {
                const h2 a0 = __builtin_bit_cast(h2, __builtin_amdgcn_cvt_pkrtz(p0[2 * j], p0[2 * j + 1])), a1 = __builtin_bit_cast(h2, __builtin_amdgcn_cvt_pkrtz(p0[8 + 2 * j], p0[8 + 2 * j + 1]));
                const h2 a2 = __builtin_bit_cast(h2, __builtin_amdgcn_cvt_pkrtz(p1[2 * j], p1[2 * j + 1])), a3 = __builtin_bit_cast(h2, __builtin_amdgcn_cvt_pkrtz(p1[8 + 2 * j], p1[8 + 2 * j + 1]));
                pa[0][2 * j] = a0.x; pa[0][2 * j + 1] = a0.y; pa[1][2 * j] = a1.x; pa[1][2 * j + 1] = a1.y;
                pa[2][2 * j] = a2.x; pa[2][2 * j + 1] = a2.y; pa[3][2 * j] = a3.x; pa[3][2 * j + 1] = a3.y; }
#pragma unroll
            for (int d0 = 0; d0 < 2; ++d0)
#pragma unroll
                for (int k4 = 0; k4 < 4; ++k4) {
                    const h4 lo = vtr(vs + d0 * 4096 + k4 * 1024), hi4 = vtr(vs + d0 * 4096 + k4 * 1024 + 512);
                    const h8 vf = {lo[0], lo[1], lo[2], lo[3], hi4[0], hi4[1], hi4[2], hi4[3]};
                    o[d0] = __builtin_amdgcn_mfma_f32_32x32x16_f16(pa[k4], vf, o[d0], 0, 0, 0);
                }
        }
    }
    lsum = hsum2(lsum);
    if (hi == 0) wsf[32 + r32] = lsum;
    LDS_WAIT();
    float rli[16];
#pragma unroll
    for (int r = 0; r < 16; ++r) { const float lv = wsf[32 + crow(r, hi)]; rli[r] = lv > 0.f ? __builtin_amdgcn_rcpf(lv) : 0.f; }
    if (MK_DEBUG && hi == 0 && !(lsum > 0.f)) atomicAdd((unsigned*)(ws + WS_CTL) + 27, 1u);
    LAS f16* stg = (LAS f16*)(lds + OST_OFF) + w * 2048;
#pragma unroll
    for (int r = 0; r < 16; ++r) { const int orow = crow(r, hi);
#pragma unroll
        for (int d0 = 0; d0 < 2; ++d0) stg[orow * 64 + d0 * 32 + r32] = (f16)(o[d0][r] * rli[r]); }
    LDS_WAIT();
    f16* Ow = MIX + (rowbase + qw) * DM + ((MODE == 0) ? 512 + h * 64 : w * 64);
#pragma unroll
    for (int i = 0; i < 4; ++i) { const int row = i * 8 + (lane >> 3), ch = lane & 7; const u32x4 v = *(const LAS u32x4*)(stg + row * 64 + ch * 8); *(u32x4*)(Ow + (size_t)row * DM + ch * 8) = v; }
    ATT_BAR();
}


constexpr int P_KOFF = 0, P_VOFF = 3 * KSL, P_WSF = P_VOFF + 4 * VSL, P_OST = P_WSF + 2048, P_MSK = P_OST + 8 * 4096, P_LDS = P_MSK + 4 * 256;
static_assert(P_LDS <= RING_BYTES, "pipelined attention LDS");
#define AT_SB() __builtin_amdgcn_sched_barrier(0)
template <int MODE>
__device__ __forceinline__ void attn_unit_p(const Args& a, LAS unsigned char* lds, int b, int h, int q0) {
    constexpr int ND = (MODE == 0) ? 6 : 4, NQK = 2 * ND;
    constexpr float THR = 8.f;
    unsigned char* ws = a.ws; asm volatile("" : "+s"(ws));
    typedef const GAS f16* gp;
    gp P = (gp)(ws + WS_P); gp QB = (gp)(ws + WS_QB); gp KV = (gp)(ws + WS_KV); GAS f16* MIX = (GAS f16*)(ws + WS_MIX);
    const GAS unsigned* MASK = (const GAS unsigned*)(ws + WS_MASK);
    const int tid = opaque_tid(), lane = tid & 63, r32 = lane & 31, hi = lane >> 5; const int w = __builtin_amdgcn_readfirstlane(tid >> 6);
    const size_t rowbase = (size_t)b * SEQ;
    const int qw = (MODE == 0) ? q0 + 32 * w : q0;
    const int NT = (MODE == 0) ? (q0 + 256) / 64 : (q0 + 32 + 63) / 64;
    const int NTw = (MODE == 0) ? (qw + 31) / 64 + 1 : NT;
    LAS float* wsf = (LAS float*)(lds + P_WSF) + w * 64;
    auto dma = [&](int t) {
        LAS unsigned char* ks = lds + P_KOFF + (t % 3) * KSL; LAS unsigned char* vs = lds + P_VOFF + (t & 3) * VSL;
        int ln = lane; asm volatile("" : "+v"(ln));
        const size_t krow = rowbase + 64 * t + ln, vrow = rowbase + 64 * t + 16 * (w & 3) + (ln >> 2);
        if (MODE == 0) {
            __builtin_amdgcn_global_load_lds((const GAS unsigned*)(KV + krow * NKV + h * 64 + 8 * w), (LAS unsigned*)(ks + w * 1024), 16, 0, 0);
            if (w < 4) __builtin_amdgcn_global_load_lds((const GAS unsigned*)(P + krow * NP + PC_KR + 8 * w), (LAS unsigned*)(ks + (8 + w) * 1024), 16, 0, 0);
            __builtin_amdgcn_global_load_lds((const GAS unsigned*)(KV + vrow * NKV + 512 + h * 64 + (w >> 2) * 32 + (ln & 3) * 8), (LAS unsigned*)(vs + w * 1024), 16, 0, 0);
        } else {
            __builtin_amdgcn_global_load_lds((const GAS unsigned*)(P + krow * NP + PC_KA + 8 * w), (LAS unsigned*)(ks + w * 1024), 16, 0, 0);
            __builtin_amdgcn_global_load_lds((const GAS unsigned*)(P + vrow * NP + PC_VA + (w >> 2) * 32 + (ln & 3) * 8), (LAS unsigned*)(vs + w * 1024), 16, 0, 0);
            if (w == 0) __builtin_amdgcn_global_load_lds((const GAS unsigned*)(MASK + ((rowbase + qw + (ln & 31)) * 2 + (ln >> 5)) * 64 + t), (LAS unsigned*)(lds + P_MSK + (t & 3) * 256), 4, 0, 0);
        }
    };
    h8 qr[ND];
    if (MODE == 0) {
        gp qp = QB + (rowbase + qw + r32) * NQB;
#pragma unroll
        for (int d0 = 0; d0 < 4; ++d0) qr[d0] = *(const GAS h8*)(qp + h * 64 + 16 * d0 + 8 * hi);
#pragma unroll
        for (int d0 = 4; d0 < ND; ++d0) qr[d0] = *(const GAS h8*)(qp + 512 + h * 32 + 16 * (d0 - 4) + 8 * hi);
    } else {
        gp qp = P + (rowbase + qw + r32) * NP + PC_QA + w * 64;
#pragma unroll
        for (int d0 = 0; d0 < ND; ++d0) qr[d0] = *(const GAS h8*)(qp + 16 * d0 + 8 * hi);
    }
    asm volatile("" :: "v"(qr[0]), "v"(qr[ND - 1]));
    dma(0); if (NT > 1) dma(1);
    float mhat = 0.f, lsum = 0.f;
    f32x16 lacc = f32x16{};
    h8 ones8; { unsigned o1 = 0x3C003C00u; asm volatile("" : "+v"(o1)); const u32x4 ov = (u32x4){o1, o1, o1, o1}; ones8 = __builtin_bit_cast(h8, ov); }
    f32x16 o[2]; o[0] = f32x16{}; o[1] = f32x16{};
    f32x16 negm = f32x16{};
    const int kfo = hi * 1024 + r32 * 16;
    const int vfo = ((lane >> 4) & 1) * 32 + (lane & 3) * 8 + (4 * hi + ((lane & 15) >> 2)) * 64;
    bool resc = false;
    f32x16 pA0, pA1, pB0, pB1;
    h4 vlo[3], vhi[3]; u32x4 pw[4];
    unsigned mw = 0u;
#define AT_CMASK(C0, C1, t) do { if (MODE == 0 && 64 * (t) + 63 > qw) { const int qrow = qw + r32, kb = 64 * (t) + 4 * hi; \
        _Pragma("unroll") for (int r = 0; r < 16; ++r) { const int kv = kb + (r & 3) + 8 * (r >> 2); if (kv > qrow) C0[r] = -INFINITY; if (kv + 32 > qrow) C1[r] = -INFINITY; } } } while (0)
#define AT_DECIDE(C0, C1, FIRST) do { float rm = fmaxf(fmaxf(C0[0], C1[0]), fmaxf(C0[1], C1[1])); \
        _Pragma("unroll") for (int r = 2; r < 16; r += 2) rm = fmaxf(fmaxf(rm, C0[r]), fmaxf(C1[r], fmaxf(C0[r + 1], C1[r + 1]))); \
        rm = hmax2(rm); resc = false; \
        if ((FIRST) || __any(rm > THR)) { const float dl = (FIRST) ? rm : fmaxf(rm, 0.f), f = (FIRST) ? 1.f : __builtin_amdgcn_exp2f(-dl); \
            lsum *= f; mhat += dl; \
            _Pragma("unroll") for (int r = 0; r < 16; ++r) { C0[r] -= dl; C1[r] -= dl; negm[r] = -mhat; } \
            if (!(FIRST)) { if (hi == 0) wsf[r32] = f; resc = true; } } } while (0)
#define AT_RESC() do { if (resc) { LDS_WAIT(); _Pragma("unroll") for (int r = 0; r < 16; ++r) { const float fr_ = wsf[crow(r, hi)]; o[0][r] *= fr_; o[1][r] *= fr_; if (MODE == 1) lacc[r] *= fr_; } LDS_WAIT(); } } while (0)
#define AT_EXP4(C, R0) do { _Pragma("unroll") for (int r_ = (R0); r_ < (R0) + 4; ++r_) C[r_] = __builtin_amdgcn_exp2f(C[r_]); } while (0)
#define AT_EXPM4(C, R0, SH) do { float c0_ = C[(R0)], c1_ = C[(R0) + 1], c2_ = C[(R0) + 2], c3_ = C[(R0) + 3]; \
        const unsigned m0_ = (unsigned)((int)(mw << (31 - ((SH) - (R0)))) >> 31), m1_ = (unsigned)((int)(mw << (31 - ((SH) - (R0) - 1))) >> 31), m2_ = (unsigned)((int)(mw << (31 - ((SH) - (R0) - 2))) >> 31), m3_ = (unsigned)((int)(mw << (31 - ((SH) - (R0) - 3))) >> 31); \
        asm volatile("v_exp_f32 %0, %0\n\tv_exp_f32 %1, %1\n\tv_exp_f32 %2, %2\n\tv_exp_f32 %3, %3\n\tv_and_b32 %0, %0, %4\n\tv_and_b32 %1, %1, %5\n\tv_and_b32 %2, %2, %6\n\tv_and_b32 %3, %3, %7" \
            : "+v"(c0_), "+v"(c1_), "+v"(c2_), "+v"(c3_) : "v"(m0_), "v"(m1_), "v"(m2_), "v"(m3_)); \
        C[(R0)] = c0_; C[(R0) + 1] = c1_; C[(R0) + 2] = c2_; C[(R0) + 3] = c3_; } while (0)
#define AT_EX(C, R0, SH) do { if (MODE == 1) AT_EXPM4(C, R0, SH); else AT_EXP4(C, R0); } while (0)
#define AT_MSK4(C, R0, SH) do { } while (0)
#define AT_PK(P, J) __builtin_bit_cast(unsigned, __builtin_amdgcn_cvt_pkrtz(P[J], P[(J) + 1]))
#define AT_VIDX(i) ((((i) & 1) * 4) + ((i) >> 1))
#define AT_VRD(i, vsb) do { vlo[(i) % 3] = vtr((vsb) + (AT_VIDX(i) >> 2) * 4096 + (AT_VIDX(i) & 3) * 1024); vhi[(i) % 3] = vtr((vsb) + (AT_VIDX(i) >> 2) * 4096 + (AT_VIDX(i) & 3) * 1024 + 512); } while (0)
#define AT_VFR(i) ((h8){vlo[(i) % 3][0], vlo[(i) % 3][1], vlo[(i) % 3][2], vlo[(i) % 3][3], vhi[(i) % 3][0], vhi[(i) % 3][1], vhi[(i) % 3][2], vhi[(i) % 3][3]})
#define AT_PAF(k) __builtin_bit_cast(h8, pw[k])
#define AT_FIN(P0, P1, i, vsb) do { \
        if ((i) < 4) { if (MODE == 0) sacc += (P0[4 * (i)] + P0[4 * (i) + 1]) + (P0[4 * (i) + 2] + P0[4 * (i) + 3]); pw[(i) >> 1][2 * ((i) & 1)] = AT_PK(P0, 4 * (i)); pw[(i) >> 1][2 * ((i) & 1) + 1] = AT_PK(P0, 4 * (i) + 2); asm volatile("" : "+v"(sacc)); asm volatile("" : "+v"(pw[(i) >> 1])); } \
        else { if (MODE == 0) sacc += (P1[4 * ((i) - 4)] + P1[4 * ((i) - 4) + 1]) + (P1[4 * ((i) - 4) + 2] + P1[4 * ((i) - 4) + 3]); pw[2 + (((i) - 4) >> 1)][2 * ((i) & 1)] = AT_PK(P1, 4 * ((i) - 4)); pw[2 + (((i) - 4) >> 1)][2 * ((i) & 1) + 1] = AT_PK(P1, 4 * ((i) - 4) + 2); asm volatile("" : "+v"(sacc)); asm volatile("" : "+v"(pw[2 + (((i) - 4) >> 1)])); } } while (0)
#define AT_KRD(j, ksb) (*(const LAS h8*)((ksb) + ((j) >> 1) * 2048 + ((j) & 1) * 512))
#define AT_QKSLOT(C0, C1, P0, P1, j, ksb, vsb, FIN) do { \
        if ((j) + 4 < NQK) kfr[((j) + 4) % 5] = AT_KRD((j) + 4, ksb); \
        AT_SB(); \
        if (((j) & 1) == 0) C0 = __builtin_amdgcn_mfma_f32_32x32x16_f16(kfr[(j) % 5], qr[(j) >> 1], ((j) < 2) ? negm : C0, 0, 0, 0); \
        else C1 = __builtin_amdgcn_mfma_f32_32x32x16_f16(kfr[(j) % 5], qr[(j) >> 1], ((j) < 2) ? negm : C1, 0, 0, 0); \
        AT_SB(); \
        if ((FIN) && (j) < 8) AT_FIN(P0, P1, ((j) & 7), vsb); \
        AT_SB(); } while (0)
#define AT_QK(C0, C1, P0, P1, ksb, vsb, FIN) do { h8 kfr[5]; kfr[0] = AT_KRD(0, ksb); kfr[1] = AT_KRD(1, ksb); kfr[2] = AT_KRD(2, ksb); kfr[3] = AT_KRD(3, ksb); AT_SB(); \
        AT_QKSLOT(C0, C1, P0, P1, 0, ksb, vsb, FIN); AT_QKSLOT(C0, C1, P0, P1, 1, ksb, vsb, FIN); AT_QKSLOT(C0, C1, P0, P1, 2, ksb, vsb, FIN); AT_QKSLOT(C0, C1, P0, P1, 3, ksb, vsb, FIN); \
        AT_QKSLOT(C0, C1, P0, P1, 4, ksb, vsb, FIN); AT_QKSLOT(C0, C1, P0, P1, 5, ksb, vsb, FIN); AT_QKSLOT(C0, C1, P0, P1, 6, ksb, vsb, FIN); AT_QKSLOT(C0, C1, P0, P1, 7, ksb, vsb, FIN); \
        if (NQK > 8) { AT_QKSLOT(C0, C1, P0, P1, 8, ksb, vsb, FIN); AT_QKSLOT(C0, C1, P0, P1, 9, ksb, vsb, FIN); AT_QKSLOT(C0, C1, P0, P1, 10, ksb, vsb, FIN); AT_QKSLOT(C0, C1, P0, P1, 11, ksb, vsb, FIN); } } while (0)
#define AT_PVSLOT(C0, C1, i, DOEXP, vsb) do { o[(i) & 1] = __builtin_amdgcn_mfma_f32_32x32x16_f16(AT_PAF((i) >> 1), AT_VFR(i), o[(i) & 1], 0, 0, 0); \
        if (MODE == 1 && ((i) & 1) == 0) lacc = __builtin_amdgcn_mfma_f32_32x32x16_f16(AT_PAF((i) >> 1), ones8, lacc, 0, 0, 0); AT_SB(); \
        if ((i) + 2 < 8) AT_VRD(((i) + 2) & 7, vsb); \
        if (DOEXP) { if ((i) < 4) { AT_EX(C0, 4 * (i), 15); asm volatile("" : "+v"(C0)); } else { AT_EX(C1, 4 * ((i) - 4), 31); asm volatile("" : "+v"(C1)); } } \
        AT_SB(); } while (0)
#define AT_PV(C0, C1, DOEXP, vsb) do { AT_VRD(0, vsb); AT_VRD(1, vsb); AT_SB(); AT_PVSLOT(C0, C1, 0, DOEXP, vsb); AT_PVSLOT(C0, C1, 1, DOEXP, vsb); AT_PVSLOT(C0, C1, 2, DOEXP, vsb); AT_PVSLOT(C0, C1, 3, DOEXP, vsb); \
        AT_PVSLOT(C0, C1, 4, DOEXP, vsb); AT_PVSLOT(C0, C1, 5, DOEXP, vsb); AT_PVSLOT(C0, C1, 6, DOEXP, vsb); AT_PVSLOT(C0, C1, 7, DOEXP, vsb); } while (0)
#define AT_STEP(C0, C1, P0, P1, t) do { \
        const LAS unsigned char* ksb_ = lds + P_KOFF + ((t) % 3) * KSL + kfo; const LAS unsigned char* vsb_ = lds + P_VOFF + (((t) - 1) & 3) * VSL + vfo; \
        if (MODE == 1) mw = *(const LAS unsigned*)(lds + P_MSK + ((t) & 3) * 256 + lane * 4); \
        float sacc = 0.f; \
        AT_QK(C0, C1, P0, P1, ksb_, vsb_, true); \
        lsum += sacc; \
        AT_CMASK(C0, C1, t); \
        AT_DECIDE(C0, C1, false); AT_SB(); \
        AT_PV(C0, C1, true, vsb_); \
        AT_RESC(); } while (0)
#define AT_DRAIN(P0, P1, t) do { const LAS unsigned char* vsb_ = lds + P_VOFF + (((t) - 1) & 3) * VSL + vfo; float sacc = 0.f; \
        AT_FIN(P0, P1, 0, vsb_); AT_FIN(P0, P1, 1, vsb_); AT_FIN(P0, P1, 2, vsb_); AT_FIN(P0, P1, 3, vsb_); AT_FIN(P0, P1, 4, vsb_); AT_FIN(P0, P1, 5, vsb_); AT_FIN(P0, P1, 6, vsb_); AT_FIN(P0, P1, 7, vsb_); \
        lsum += sacc; AT_SB(); AT_PV(P0, P1, false, vsb_); } while (0)

    const bool w3 = (MODE == 0) ? (w < 4) : (w == 0);
#define AT_WAITBAR(NEWER) do { if (NEWER) { if (w3) asm volatile("s_waitcnt vmcnt(3) lgkmcnt(0)\n\ts_barrier" ::: "memory"); else asm volatile("s_waitcnt vmcnt(2) lgkmcnt(0)\n\ts_barrier" ::: "memory"); } \
        else asm volatile("s_waitcnt vmcnt(0) lgkmcnt(0)\n\ts_barrier" ::: "memory"); } while (0)
    AT_WAITBAR(NT > 1);
    if (NT > 2) dma(2);
    {
        const LAS unsigned char* ksb_ = lds + P_KOFF + kfo; const LAS unsigned char* vsb_ = lds + P_VOFF + vfo;
        if (MODE == 1) mw = *(const LAS unsigned*)(lds + P_MSK + lane * 4);
        float sacc = 0.f;
        AT_QK(pA0, pA1, pA0, pA1, ksb_, vsb_, false);
        (void)sacc;
        AT_CMASK(pA0, pA1, 0);
        AT_DECIDE(pA0, pA1, true);
#pragma unroll
        for (int i = 0; i < 4; ++i) { AT_EX(pA0, 4 * i, 15); AT_EX(pA1, 4 * i, 31); }
    }
    AT_WAITBAR(NT > 2);
    int t = 1; bool lastB = false;
    for (; t + 1 < NTw; t += 2) {
        if (t + 2 < NT) dma(t + 2);
        AT_STEP(pB0, pB1, pA0, pA1, t);
        AT_WAITBAR(t + 2 < NT);
        if (t + 3 < NT) dma(t + 3);
        AT_STEP(pA0, pA1, pB0, pB1, t + 1);
        AT_WAITBAR(t + 3 < NT);
    }
    if (t < NTw) {
        if (t + 2 < NT) dma(t + 2);
        AT_STEP(pB0, pB1, pA0, pA1, t);
        AT_WAITBAR(t + 2 < NT);
        ++t; lastB = true;
    }
    if (lastB) { AT_DRAIN(pB0, pB1, t); } else { AT_DRAIN(pA0, pA1, t); }
    for (; t < NT; ++t) { if (t + 2 < NT) dma(t + 2); AT_WAITBAR(t + 2 < NT); }
    float rli[16];
    if (MODE == 0) {
        lsum = hsum2(lsum);
        if (hi == 0) wsf[32 + r32] = lsum;
        LDS_WAIT();
#pragma unroll
        for (int r = 0; r < 16; ++r) { const float lv = wsf[32 + crow(r, hi)]; rli[r] = lv > 0.f ? __builtin_amdgcn_rcpf(lv) : 0.f; }
    } else {
#pragma unroll
        for (int r = 0; r < 16; ++r) { const float lv = lacc[r]; rli[r] = lv > 0.f ? __builtin_amdgcn_rcpf(lv) : 0.f; }
    }
    LAS f16* stg = (LAS f16*)(lds + P_OST) + w * 2048;
#pragma unroll
    for (int r = 0; r < 16; ++r) { const int orow = crow(r, hi);
#pragma unroll
        for (int d0 = 0; d0 < 2; ++d0) stg[orow * 64 + d0 * 32 + r32] = (f16)(o[d0][r] * rli[r]); }
    LDS_WAIT();
    GAS f16* Ow = MIX + (rowbase + qw) * DM + ((MODE == 0) ? 512 + h * 64 : w * 64);
#pragma unroll
    for (int i = 0; i < 4; ++i) { const int row = i * 8 + (lane >> 3), ch = lane & 7; const u32x4 v = *(const LAS u32x4*)(stg + row * 64 + ch * 8); *(GAS u32x4*)(Ow + (size_t)row * DM + ch * 8) = v; }
    ATT_BAR();
}

#ifndef ATT_PIPE
#define ATT_PIPE 1
#endif
template <int MODE> __device__ __forceinline__ void attn_phase(const Args& a, Frame& F) {
    for (int k = F.vcu; k < 1024; k += F.G) {
        const int i = k >> 8, c = k & 255;
        if (MODE == 0) { const int bh = c >> 2, j = c & 3; const int qb = (i == 0) ? j : (i == 1) ? 7 - j : (i == 2) ? 8 + j : 15 - j;
            if (ATT_PIPE) attn_unit_p<0>(a, F.lds, bh >> 3, bh & 7, qb * 256); else attn_unit<0>(a, F.lds, bh >> 3, bh & 7, qb * 256); }
        else { const int b = c >> 5, j = c & 31; const int u = (i == 0) ? j : (i == 1) ? 63 - j : (i == 2) ? 64 + j : 127 - j;
            if (ATT_PIPE) attn_unit_p<1>(a, F.lds, b, 0, u * 32); else attn_unit<1>(a, F.lds, b, 0, u * 32); }
    }
}
}


namespace idx {
constexpr int QL_OFF = 0;
constexpr int HIST_OFF = 69632;
constexpr int SEL_OFF = HIST_OFF, CAND_OFF = HIST_OFF + 16384;
constexpr int NH_OFF = 102400;
constexpr int QP_OFF = 104448;
constexpr int WSC_OFF = 105472;
constexpr int NCAP = 512;
static_assert(WSC_OFF + 8 * 3072 <= RING_BYTES, "indexer LDS");
constexpr float IDX_SCALE = 0.03125f;
using att::crow;
#define IDX_BAR() asm volatile("s_waitcnt vmcnt(0) lgkmcnt(0)\n\ts_barrier" ::: "memory")
__device__ __forceinline__ unsigned ordu(float f) { const unsigned u = __builtin_bit_cast(unsigned, f); return (u & 0x80000000u) ? ~u : (u | 0x80000000u); }

#define IDX_CHAIN(X, KT) do { X = __builtin_amdgcn_mfma_f32_32x32x16_f16(kf[KT][0], qf[0], zero16, 0, 0, 0); X = __builtin_amdgcn_mfma_f32_32x32x16_f16(kf[KT][1], qf[1], X, 0, 0, 0); \
        X = __builtin_amdgcn_mfma_f32_32x32x16_f16(kf[KT][2], qf[2], X, 0, 0, 0); X = __builtin_amdgcn_mfma_f32_32x32x16_f16(kf[KT][3], qf[3], X, 0, 0, 0); } while (0)
#define IDX_FMA4(XV, KTV, W, R0) do { _Pragma("unroll") for (int r_ = (R0); r_ < (R0) + 4; ++r_) { float t_ = __builtin_fmaf(__builtin_fabsf(XV[r_]), W, acc[KTV][r_]); asm("" : "+v"(t_)); acc[KTV][r_] = t_; } } while (0)
#define IDX_SLOT(XD, KT, KS, XV, KTV, W, R0, EXTRA) do { XD = __builtin_amdgcn_mfma_f32_32x32x16_f16(kf[KT][KS], qf[KS], XD, 0, 0, 0); __builtin_amdgcn_sched_barrier(0); EXTRA; IDX_FMA4(XV, KTV, W, R0); __builtin_amdgcn_sched_barrier(0); } while (0)
typedef const GAS f16* gf16p;
__device__ __forceinline__ void load_kf(h8 (&kf)[4][4], gf16p Pk, int r32, int hi) {
#pragma unroll
    for (int kt = 0; kt < 4; ++kt)
#pragma unroll
        for (int ks = 0; ks < 4; ++ks) kf[kt][ks] = *(const GAS h8*)(Pk + (size_t)(32 * kt + r32) * NP + 16 * ks + 8 * hi);
}
__device__ __forceinline__ void chunk_scores(const h8 (&kf)[4][4], const LAS unsigned char* QL, const LAS float* WH, int r32, int hi, f32x16 (&acc)[4]) {
    const LAS unsigned char* qb = QL + (hi * 32 + r32) * 16;
    const f32x16 zero16 = f32x16{};
    {
        h8 qf[4];
#pragma unroll
        for (int ks = 0; ks < 4; ++ks) qf[ks] = *(const LAS h8*)(qb + (16 * 8 + 2 * ks) * 512);
#pragma unroll
        for (int kt = 0; kt < 4; ++kt) IDX_CHAIN(acc[kt], kt);
    }
    f32x16 x0 = zero16, x1 = zero16, x2 = zero16, x3 = zero16; float wprev = 0.f;
    h8 qf[4];
#pragma unroll
    for (int ks = 0; ks < 4; ++ks) qf[ks] = *(const LAS h8*)(qb + (2 * ks) * 512);
    float wv = WH[r32];
#pragma unroll 1
    for (int h = 0; h < 16; ++h) {
        const LAS unsigned char* qn = qb + ((h + 1) * 8) * 512;
        float wnext;
        x0 = zero16; __builtin_amdgcn_sched_barrier(0);
        IDX_SLOT(x0, 0, 0, x2, 2, wprev, 8, (void)0);
        IDX_SLOT(x0, 0, 1, x2, 2, wprev, 12, (void)0);
        IDX_SLOT(x0, 0, 2, x3, 3, wprev, 0, (void)0);
        IDX_SLOT(x0, 0, 3, x3, 3, wprev, 4, x1 = zero16);
        IDX_SLOT(x1, 1, 0, x3, 3, wprev, 8, (void)0);
        IDX_SLOT(x1, 1, 1, x3, 3, wprev, 12, (void)0);
        IDX_SLOT(x1, 1, 2, x0, 0, wv, 0, (void)0);
        IDX_SLOT(x1, 1, 3, x0, 0, wv, 4, x2 = zero16);
        IDX_SLOT(x2, 2, 0, x0, 0, wv, 8, (void)0);
        IDX_SLOT(x2, 2, 1, x0, 0, wv, 12, (void)0);
        IDX_SLOT(x2, 2, 2, x1, 1, wv, 0, (void)0);
        IDX_SLOT(x2, 2, 3, x1, 1, wv, 4, x3 = zero16);
        IDX_SLOT(x3, 3, 0, x1, 1, wv, 8, qf[0] = *(const LAS h8*)(qn));
        IDX_SLOT(x3, 3, 1, x1, 1, wv, 12, qf[1] = *(const LAS h8*)(qn + 1024));
        IDX_SLOT(x3, 3, 2, x2, 2, wv, 0, qf[2] = *(const LAS h8*)(qn + 2048));
        IDX_SLOT(x3, 3, 3, x2, 2, wv, 4, qf[3] = *(const LAS h8*)(qn + 3072); wnext = WH[((h + 1) & 15) * 32 + r32]);
        wprev = wv; wv = wnext;
    }
    IDX_FMA4(x2, 2, wprev, 8); IDX_FMA4(x2, 2, wprev, 12); IDX_FMA4(x3, 3, wprev, 0); IDX_FMA4(x3, 3, wprev, 4); IDX_FMA4(x3, 3, wprev, 8); IDX_FMA4(x3, 3, wprev, 12);
}

__device__ __forceinline__ void idx_unit(const Args& a, LAS unsigned char* lds, int b, int u, int uslot) {
    unsigned char* ws = a.ws; asm volatile("" : "+s"(ws));
    gf16p P = (gf16p)(ws + WS_P); const GAS float* WI = (const GAS float*)(ws + WS_WI); GAS unsigned* MASK = (GAS unsigned*)(ws + WS_MASK);
    const int tid = opaque_tid(), lane = tid & 63, r32 = lane & 31, hi = lane >> 5; const int w = __builtin_amdgcn_readfirstlane(tid >> 6);
    const size_t rowbase = (size_t)b * SEQ; const int q0 = 32 * u, nch = (u >> 2) + 1; const bool selneeded = (u >= 8);
    LAS unsigned char* QL = lds + QL_OFF; LAS unsigned* HIST = (LAS unsigned*)(lds + HIST_OFF); LAS unsigned* SEL = (LAS unsigned*)(lds + SEL_OFF); LAS unsigned* CAND = (LAS unsigned*)(lds + CAND_OFF);
    LAS float* NH = (LAS float*)(lds + NH_OFF); LAS float* QP = (LAS float*)(lds + QP_OFF);
#pragma unroll
    for (int i = 0; i < 8; ++i) { const int p = w * 8 + i, hh = p >> 2, c = 2 * (p & 3) + (lane >> 5);
        __builtin_amdgcn_global_load_lds((const GAS unsigned*)(P + (rowbase + q0 + r32) * NP + PC_QI + hh * 64 + c * 8), (LAS unsigned*)(QL + p * 1024), 16, 0, 0); }
#pragma unroll
    for (int i = 0; i < 4; ++i) *(LAS u32x4*)(lds + HIST_OFF + (i * 512 + tid) * 16) = (u32x4){0u, 0u, 0u, 0u};
    const int tq = tid & 31, th = tid >> 5;
    f32x4 wq[4];
#pragma unroll
    for (int j = 0; j < 4; ++j) wq[j] = *(const GAS f32x4*)(WI + (rowbase + q0 + tq) * 16 + 4 * j);
    IDX_BAR();
    { float s = 0.f;
#pragma unroll
        for (int c = 0; c < 8; ++c) { const h8 v = *(const LAS h8*)(QL + ((th * 8 + c) * 32 + tq) * 16);
#pragma unroll
            for (int j = 0; j < 8; ++j) { const float f = (float)v[j]; s += f * f; } }
        NH[th * 32 + tq] = __builtin_sqrtf(s); }
    IDX_BAR();
    if (tid < 32) { float s1 = 0.f, s2 = 0.f;
#pragma unroll
        for (int hh = 0; hh < 16; ++hh) { const float wv = wq[hh >> 2][hh & 3] * IDX_SCALE, n = NH[hh * 32 + tq]; s1 += wv * n; s2 += wv * wv * n * n; }
        const float mu = 0.3989423f * s1, sg = fmaxf(0.5838f * __builtin_sqrtf(s2), 1e-20f);
        const float invw = 25.6f / sg, lo = mu - 5.f * sg;
        QP[tq * 8 + 0] = invw; QP[tq * 8 + 1] = -lo * invw;
    }
    { const int c = th >> 1, hf = th & 1; float a0 = 0.f, a1 = 0.f, a2 = 0.f, a3 = 0.f;
#pragma unroll
        for (int hh = 0; hh < 16; ++hh) { const float wv = 0.5f * IDX_SCALE * wq[hh >> 2][hh & 3]; const h4 v = *(const LAS h4*)(QL + ((hh * 8 + c) * 32 + tq) * 16 + 8 * hf);
            a0 += wv * (float)v[0]; a1 += wv * (float)v[1]; a2 += wv * (float)v[2]; a3 += wv * (float)v[3]; }
        u32x2 o; o.x = pkh(a0, a1); o.y = pkh(a2, a3);
        *(LAS u32x2*)(QL + ((16 * 8 + c) * 32 + tq) * 16 + 8 * hf) = o; }
    IDX_BAR();
    { float wsel = wq[0][0];
#pragma unroll
        for (int hh = 1; hh < 16; ++hh) wsel = (th == hh) ? wq[hh >> 2][hh & 3] : wsel;
        NH[th * 32 + tq] = 0.5f * IDX_SCALE * wsel; }
    IDX_BAR();
    const LAS float* WH = NH;
    const float invw = QP[r32 * 8 + 0], yoff = QP[r32 * 8 + 1];
    unsigned cm16 = 0u;
#pragma unroll
    for (int r = 0; r < 16; ++r) cm16 |= (crow(r, hi) <= r32) ? (1u << (15 - r)) : 0u;
    const int du = u & 3;
    gf16p Pki = P + rowbase * NP + PC_KI;
    GAS u32x4* binbuf = (GAS u32x4*)(ws + WS_MIX + (size_t)blockIdx.x * 262144 + (size_t)(uslot & 1) * 131072);
    if (selneeded) {
        h8 kf[4][4];
        if (w < nch) load_kf(kf, Pki + (size_t)(128 * w) * NP, r32, hi);
        const float a1 = invw * (1.f / 256.f), b1 = yoff * (1.f / 256.f);
        const unsigned hbase = (unsigned)(size_t)(lds + HIST_OFF) + 4u * (unsigned)r32 - 0x80000000u;
        for (int c = w; c < nch; c += 8) {
            f32x16 acc[4];
            chunk_scores(kf, QL, WH, r32, hi, acc);
            if (c + 8 < nch) load_kf(kf, Pki + (size_t)(128 * (c + 8)) * NP, r32, hi);
            const bool last = (c == nch - 1);
#define IDX_BINZ(R) float y01_; asm("v_fma_f32 %0, %1, %2, %3 clamp" : "=v"(y01_) : "v"(acc[kt][R]), "v"(a1), "v"(b1)); \
                    const unsigned zi_ = __builtin_bit_cast(unsigned, __builtin_fmaf(y01_, 255.f, 8388608.f)); \
                    if (((R) & 3) == 0) pk[(R) >> 2] = zi_ & 255u; else pk[(R) >> 2] |= zi_ << (8 * ((R) & 3));
#pragma unroll
            for (int kt = 0; kt < 4; ++kt) {
                const int full = !last ? 1 : (kt < du ? 1 : 0);
                u32x4 pk;
                if (full) {
#pragma unroll
                    for (int r = 0; r < 16; ++r) { IDX_BINZ(r)
                        __hip_atomic_fetch_add((LAS unsigned*)(size_t)((zi_ << 7) + hbase), 1u, __ATOMIC_RELAXED, __HIP_MEMORY_SCOPE_WORKGROUP); }
                } else {
                    const unsigned fld = (kt == du) ? cm16 : 0u;
#pragma unroll
                    for (int r = 0; r < 16; ++r) { IDX_BINZ(r)
                        if ((fld >> (15 - r)) & 1u) __hip_atomic_fetch_add((LAS unsigned*)(size_t)((zi_ << 7) + hbase), 1u, __ATOMIC_RELAXED, __HIP_MEMORY_SCOPE_WORKGROUP); }
                }
                binbuf[(c * 64 + lane) * 4 + kt] = pk;
            }
        }
        IDX_BAR();
        { unsigned v[4][4], sm[4], I[4];
#pragma unroll
            for (int i = 0; i < 4; ++i) {
#pragma unroll
                for (int k = 0; k < 4; ++k) v[i][k] = HIST[(4 * lane + k) * 32 + 4 * w + i];
                sm[i] = v[i][0] + v[i][1] + v[i][2] + v[i][3]; I[i] = sm[i]; }
#pragma unroll
            for (int d = 1; d < 64; d <<= 1) {
#pragma unroll
                for (int i = 0; i < 4; ++i) { const unsigned t = __shfl_down(I[i], d); if (lane + d < 64) I[i] += t; } }
#pragma unroll
            for (int i = 0; i < 4; ++i) { const int q = 4 * w + i; const unsigned E = I[i] - sm[i];
                if (E < 256u && I[i] >= 256u) { unsigned cum = E; int bst = 4 * lane; unsigned nab = E; bool found = false;
#pragma unroll
                    for (int k = 3; k >= 0; --k) { if (!found && cum + v[i][k] >= 256u) { bst = 4 * lane + k; nab = cum; found = true; } cum += v[i][k]; }
                    QP[q * 8 + 2] = (float)bst; QP[q * 8 + 4] = (float)(256 - (int)nab); } }
        }
        IDX_BAR();
#pragma unroll
        for (int i = 0; i < 4; ++i) *(LAS u32x4*)(lds + HIST_OFF + (i * 512 + tid) * 16) = (u32x4){0u, 0u, 0u, 0u};
        IDX_BAR();
    }
    if (selneeded) {
        const int bst = (int)QP[r32 * 8 + 2];
        for (int c = w; c < nch; c += 8) {
            u32x4 pk[4];
#pragma unroll
            for (int kt = 0; kt < 4; ++kt) pk[kt] = binbuf[(c * 64 + lane) * 4 + kt];
            const bool last = (c == nch - 1);
#pragma unroll
            for (int jp = 0; jp < 2; ++jp) {
                unsigned selw = 0u, gew = 0u;
#pragma unroll
                for (int r = 0; r < 16; ++r) { const int bin = (int)((pk[2 * jp + 1][r >> 2] >> (8 * (r & 3))) & 255u);
                    selw = __builtin_amdgcn_alignbit(selw, (unsigned)(bst - bin), 31); gew = __builtin_amdgcn_alignbit(gew, (unsigned)(bst - 1 - bin), 31); }
#pragma unroll
                for (int r = 0; r < 16; ++r) { const int bin = (int)((pk[2 * jp][r >> 2] >> (8 * (r & 3))) & 255u);
                    selw = __builtin_amdgcn_alignbit(selw, (unsigned)(bst - bin), 31); gew = __builtin_amdgcn_alignbit(gew, (unsigned)(bst - 1 - bin), 31); }
                unsigned sel = selw, cand = gew & ~selw;
                if (last) { const int k0 = 2 * jp, k1 = 2 * jp + 1;
                    const unsigned f0 = k0 < du ? 0xFFFFu : (k0 == du ? cm16 : 0u), f1 = k1 < du ? 0xFFFFu : (k1 == du ? cm16 : 0u);
                    const unsigned cmw = f0 | (f1 << 16); sel &= cmw; cand &= cmw; }
                SEL[(r32 * 2 + hi) * 64 + 2 * c + jp] = sel; CAND[(r32 * 2 + hi) * 64 + 2 * c + jp] = cand;
            }
        }
    } else {
#pragma unroll
        for (int i = 0; i < 8; ++i) { const int widx = i * 512 + tid, q = widx >> 7, h2 = (widx >> 6) & 1, jj = widx & 63;
            unsigned cmq = 0u;
#pragma unroll
            for (int r = 0; r < 16; ++r) cmq |= (crow(r, h2) <= q) ? (1u << (15 - r)) : 0u;
            const int t0 = 2 * jj, t1 = 2 * jj + 1;
            const unsigned f0 = t0 < u ? 0xFFFFu : (t0 == u ? cmq : 0u), f1 = t1 < u ? 0xFFFFu : (t1 == u ? cmq : 0u);
            SEL[widx] = f0 | (f1 << 16); }
    }
    IDX_BAR();
    if (selneeded) {
        LAS u16* list = (LAS u16*)(lds + WSC_OFF + w * 3072); LAS float* scs = (LAS float*)(lds + WSC_OFF + w * 3072 + 1024);
        const int head = lane & 15, fq = lane >> 4;
        int need[4], n[4], off[4]; unsigned w0[4], w1[4];
#pragma unroll
        for (int i = 0; i < 4; ++i) { const int q = 4 * w + i; need[i] = (int)QP[q * 8 + 4]; w0[i] = CAND[(q * 2 + 0) * 64 + lane]; w1[i] = CAND[(q * 2 + 1) * 64 + lane];
            off[i] = __builtin_popcount(w0[i]) + __builtin_popcount(w1[i]); n[i] = off[i]; }
#pragma unroll
        for (int d = 1; d < 64; d <<= 1) {
#pragma unroll
            for (int i = 0; i < 4; ++i) { const int t = __shfl_up(n[i], d); if (lane >= d) n[i] += t; } }
#pragma unroll
        for (int i = 0; i < 4; ++i) { off[i] = n[i] - off[i]; n[i] = __builtin_amdgcn_readlane(n[i], 63); }
        const bool fast = (n[0] <= 64) && (n[1] <= 64) && (n[2] <= 64) && (n[3] <= 64);
        if (fast) {
#pragma unroll
            for (int i = 0; i < 4; ++i) { int pos = off[i];
                for (unsigned tmp = w0[i]; tmp; tmp &= tmp - 1) { const int be = __builtin_ctz(tmp); list[i * 64 + pos] = (u16)(64 * lane + 32 * (be >> 4) + crow(15 - (be & 15), 0)); ++pos; }
                for (unsigned tmp = w1[i]; tmp; tmp &= tmp - 1) { const int be = __builtin_ctz(tmp); list[i * 64 + pos] = (u16)(64 * lane + 32 * (be >> 4) + crow(15 - (be & 15), 1)); ++pos; } }
            LDS_WAIT(); asm volatile("" ::: "memory");
            float sc[4] = {0.f, 0.f, 0.f, 0.f}; int mykey[4];
#pragma unroll
            for (int i = 0; i < 4; ++i) { const int li = lane < n[i] ? lane : (n[i] > 0 ? n[i] - 1 : 0); mykey[i] = list[i * 64 + li]; }
#pragma unroll
            for (int p = 0; p < 2; ++p) {
                const int nm = n[2 * p] > n[2 * p + 1] ? n[2 * p] : n[2 * p + 1]; const int gmax = (nm + 15) >> 4;
                h8 aq[2][2]; f32x4 wv4[2]; h8 bk[2][4][2];
#pragma unroll
                for (int ii = 0; ii < 2; ++ii) { const int i = 2 * p + ii, q = 4 * w + i;
#pragma unroll
                    for (int ks = 0; ks < 2; ++ks) aq[ii][ks] = *(const LAS h8*)(QL + ((head * 8 + 4 * ks + fq) * 32 + q) * 16);
                    wv4[ii] = *(const GAS f32x4*)(WI + (rowbase + q0 + q) * 16 + 4 * fq); wv4[ii] = wv4[ii] * IDX_SCALE;
#pragma unroll
                    for (int g = 0; g < 4; ++g) if (g < gmax) { const int ci = 16 * g + head; const int li = ci < n[i] ? ci : (n[i] > 0 ? n[i] - 1 : 0); const int key = list[i * 64 + li];
                        gf16p kp = Pki + (size_t)key * NP + 8 * fq; bk[ii][g][0] = *(const GAS h8*)kp; bk[ii][g][1] = *(const GAS h8*)(kp + 32); } }
#pragma unroll
                for (int ii = 0; ii < 2; ++ii) { const int i = 2 * p + ii;
#pragma unroll
                    for (int g = 0; g < 4; ++g) if (g < gmax) {
                        f32x4 x = __builtin_amdgcn_mfma_f32_16x16x32_f16(aq[ii][0], bk[ii][g][0], (f32x4){0.f, 0.f, 0.f, 0.f}, 0, 0, 0);
                        x = __builtin_amdgcn_mfma_f32_16x16x32_f16(aq[ii][1], bk[ii][g][1], x, 0, 0, 0);
                        float sv = wv4[ii].x * fmaxf(x.x, 0.f) + wv4[ii].y * fmaxf(x.y, 0.f) + wv4[ii].z * fmaxf(x.z, 0.f) + wv4[ii].w * fmaxf(x.w, 0.f);
                        sv += __shfl_xor(sv, 16); sv += __shfl_xor(sv, 32);
                        if (fq == g) sc[i] = sv; } }
            }
            int rank[4] = {0, 0, 0, 0};
            int nmax = n[0]; nmax = n[1] > nmax ? n[1] : nmax; nmax = n[2] > nmax ? n[2] : nmax; nmax = n[3] > nmax ? n[3] : nmax;
            for (int j = 0; j < nmax; ++j) {
#pragma unroll
                for (int i = 0; i < 4; ++i) { const float sj = __builtin_bit_cast(float, __builtin_amdgcn_readlane(__builtin_bit_cast(int, sc[i]), j));
                    rank[i] += (j < n[i] && (sj > sc[i] || (sj == sc[i] && j < lane))) ? 1 : 0; } }
#pragma unroll
            for (int i = 0; i < 4; ++i) if (lane < n[i] && rank[i] < need[i]) { const int q = 4 * w + i, key = mykey[i]; const int jj = key >> 6, tp = (key >> 5) & 1, i5 = key & 31, kh = (i5 >> 2) & 1, r = (i5 & 3) | ((i5 >> 3) << 2);
                __hip_atomic_fetch_or(SEL + (q * 2 + kh) * 64 + jj, 1u << (16 * tp + 15 - r), __ATOMIC_RELAXED, __HIP_MEMORY_SCOPE_WORKGROUP); }
        } else {
#pragma unroll 1
            for (int i = 0; i < 4; ++i) { const int q = 4 * w + i;
                const int needq = (int)QP[q * 8 + 4];
                const unsigned v0 = CAND[(q * 2 + 0) * 64 + lane], v1 = CAND[(q * 2 + 1) * 64 + lane];
                const int cnt = __builtin_popcount(v0) + __builtin_popcount(v1); int Pf = cnt;
#pragma unroll
                for (int d = 1; d < 64; d <<= 1) { const int t = __shfl_up(Pf, d); if (lane >= d) Pf += t; }
                int nq = __shfl(Pf, 63); int pos = Pf - cnt;
                for (unsigned tmp = v0; tmp; tmp &= tmp - 1) { const int be = __builtin_ctz(tmp); if (pos < NCAP) list[pos] = (u16)(64 * lane + 32 * (be >> 4) + crow(15 - (be & 15), 0)); ++pos; }
                for (unsigned tmp = v1; tmp; tmp &= tmp - 1) { const int be = __builtin_ctz(tmp); if (pos < NCAP) list[pos] = (u16)(64 * lane + 32 * (be >> 4) + crow(15 - (be & 15), 1)); ++pos; }
                nq = nq < NCAP ? nq : NCAP;
                LDS_WAIT(); asm volatile("" ::: "memory");
                if (nq > 0 && needq > 0) {
                    h8 aq[2];
#pragma unroll
                    for (int ks = 0; ks < 2; ++ks) aq[ks] = *(const LAS h8*)(QL + ((head * 8 + 4 * ks + fq) * 32 + q) * 16);
                    f32x4 wv4 = *(const GAS f32x4*)(WI + (rowbase + q0 + q) * 16 + 4 * fq); wv4 = wv4 * IDX_SCALE;
                    for (int g0 = 0; g0 < nq; g0 += 16) { const int ci = g0 + head; const int key = list[ci < nq ? ci : nq - 1];
                        gf16p kp = Pki + (size_t)key * NP + 8 * fq;
                        const h8 bk0 = *(const GAS h8*)kp, bk1 = *(const GAS h8*)(kp + 32);
                        f32x4 x = __builtin_amdgcn_mfma_f32_16x16x32_f16(aq[0], bk0, (f32x4){0.f, 0.f, 0.f, 0.f}, 0, 0, 0);
                        x = __builtin_amdgcn_mfma_f32_16x16x32_f16(aq[1], bk1, x, 0, 0, 0);
                        float sv = wv4.x * fmaxf(x.x, 0.f) + wv4.y * fmaxf(x.y, 0.f) + wv4.z * fmaxf(x.z, 0.f) + wv4.w * fmaxf(x.w, 0.f);
                        sv += __shfl_xor(sv, 16); sv += __shfl_xor(sv, 32);
                        if (fq == 0 && ci < nq) scs[ci] = sv; }
                    LDS_WAIT(); asm volatile("" ::: "memory");
                    unsigned thr = 0u;
                    if (needq < nq) {
#pragma unroll 1
                        for (int bit = 31; bit >= 0; --bit) { const unsigned trial = thr | (1u << bit); int c2 = 0;
                            for (int i0 = 0; i0 < nq; i0 += 64) { const int ii = i0 + lane; const bool ok = ii < nq && ordu(scs[ii < nq ? ii : 0]) >= trial; c2 += __builtin_popcountll(__ballot(ok)); }
                            if (c2 >= needq) thr = trial; } }
                    for (int i0 = 0; i0 < nq; i0 += 64) { const int ii = i0 + lane;
                        if (ii < nq && ordu(scs[ii]) >= thr) { const int key = list[ii]; const int jj = key >> 6, tp = (key >> 5) & 1, i5 = key & 31, kh = (i5 >> 2) & 1, r = (i5 & 3) | ((i5 >> 3) << 2);
                            __hip_atomic_fetch_or(SEL + (q * 2 + kh) * 64 + jj, 1u << (16 * tp + 15 - r), __ATOMIC_RELAXED, __HIP_MEMORY_SCOPE_WORKGROUP); } }
                    LDS_WAIT(); asm volatile("" ::: "memory");
                }
            }
        }
    }
    IDX_BAR();
    { GAS u32x4* mo = (GAS u32x4*)(MASK + (rowbase + q0) * 128);
        mo[tid] = *(const LAS u32x4*)(lds + SEL_OFF + tid * 16); mo[512 + tid] = *(const LAS u32x4*)(lds + SEL_OFF + (512 + tid) * 16); }
    IDX_BAR();
}
__device__ __forceinline__ void idx_phase(const Args& a, Frame& F) {
    for (int k = F.vcu; k < 1024; k += F.G) { const int i = k >> 8, c = k & 255; const int b = c >> 5, j = c & 31;
        const int u = (i == 0) ? j : (i == 1) ? 63 - j : (i == 2) ? 64 + j : 127 - j;
        idx_unit(a, F.lds, b, u, i); }
}
}


namespace dbg {
__device__ __forceinline__ int sample_t(int i) { switch (i) { case 0: return 0; case 1: return 1; case 2: return 31; case 3: return 32; case 4: return 63; case 5: return 64; case 6: return 100; case 7: return 127; case 8: return 128; case 9: return 255; case 10: return 256; case 11: return 1000; case 12: return 2047; case 13: return 2048; case 14: return 3071; default: return 4095; } }
constexpr int CW_DBG = 16;
__device__ __forceinline__ void dbg_phase(const Args& a, Frame& F) {
    if (F.vcu >= 16) return;
    unsigned char* ws = a.ws; asm volatile("" : "+s"(ws));
    const f16* P = (const f16*)(ws + WS_P); const float* WI = (const float*)(ws + WS_WI); const unsigned* MASK = (const unsigned*)(ws + WS_MASK);
    unsigned* ctl = (unsigned*)(ws + WS_CTL);
    const int t = sample_t(F.vcu);
    const int b = F.vcu & 7; const size_t rowbase = (size_t)b * SEQ;
    LAS float* qf = (LAS float*)(F.lds);
    LAS float* sc = (LAS float*)(F.lds + 4096);
    LAS unsigned* red = (LAS unsigned*)(F.lds + 4096 + 16384);
    const int tid = F.tid;
    for (int i = tid; i < 1024; i += 512) qf[i] = (float)P[(rowbase + t) * NP + PC_QI + i];
    if (tid < 2) red[tid] = 0u;
    __syncthreads();
    for (int j = tid; j <= t; j += 512) {
        const f16* kp = P + (rowbase + j) * NP + PC_KI;
        float s = 0.f;
        for (int h = 0; h < 16; ++h) { float x = 0.f;
            for (int d = 0; d < 64; ++d) x += qf[h * 64 + d] * (float)kp[d];
            s += WI[(rowbase + t) * 16 + h] * fmaxf(x, 0.f); }
        sc[j] = s * 0.03125f;
    }
    __syncthreads();
    unsigned mism = 0u, nsel = 0u;
    for (int j = tid; j <= t; j += 512) {
        const float sj = sc[j]; int rank = 0;
        for (int i = 0; i <= t; ++i) { const float si = sc[i]; rank += (si > sj || (si == sj && i < j)) ? 1 : 0; }
        const bool exp_sel = (rank < 256);
        const int jj = j >> 6, tp = (j >> 5) & 1, i5 = j & 31, kh = (i5 >> 2) & 1, r = (i5 & 3) | ((i5 >> 3) << 2);
        const unsigned wv = MASK[((rowbase + t) * 2 + kh) * 64 + jj];
        const bool act = (wv >> (16 * tp + 15 - r)) & 1u;
        mism += (exp_sel != act) ? 1u : 0u; nsel += act ? 1u : 0u;
    }
    for (int j = t + 1 + tid; j < SEQ; j += 512) {
        const int jj = j >> 6, tp = (j >> 5) & 1, i5 = j & 31, kh = (i5 >> 2) & 1, r = (i5 & 3) | ((i5 >> 3) << 2);
        const unsigned wv = MASK[((rowbase + t) * 2 + kh) * 64 + jj];
        mism += ((wv >> (16 * tp + 15 - r)) & 1u) ? 1u : 0u;
    }
    atomicAdd((unsigned*)&red[0], mism); atomicAdd((unsigned*)&red[1], nsel);
    __syncthreads();
    if (tid == 0) { atomicAdd(ctl + CW_DBG, red[0]); const unsigned want = (t + 1 < 256) ? (unsigned)(t + 1) : 256u; if (red[1] != want) atomicAdd(ctl + CW_DBG + 1, 1u); }
    __syncthreads();
}

__device__ __forceinline__ void dbg2_phase(const Args& a, Frame& F) {
    if (F.vcu >= 16) return;
    unsigned char* ws = a.ws; asm volatile("" : "+s"(ws));
    const f16* P = (const f16*)(ws + WS_P); const unsigned* MASK = (const unsigned*)(ws + WS_MASK); const f16* MIX = (const f16*)(ws + WS_MIX);
    unsigned* ctl = (unsigned*)(ws + WS_CTL);
    const int t = sample_t(F.vcu);
    const int b = F.vcu & 7; const size_t rowbase = (size_t)b * SEQ;
    const int tid = F.tid, h = tid >> 6, d = tid & 63;
    LAS unsigned* red = (LAS unsigned*)(F.lds);
    if (tid < 2) red[tid] = 0u;
    __syncthreads();
    const f16* qp = P + (rowbase + t) * NP + PC_QA + h * 64;
    float mx = -1e30f;
    for (int j = 0; j <= t; ++j) {
        const int jj = j >> 6, tp = (j >> 5) & 1, i5 = j & 31, kh = (i5 >> 2) & 1, r = (i5 & 3) | ((i5 >> 3) << 2);
        const unsigned wv = MASK[((rowbase + t) * 2 + kh) * 64 + jj];
        if (!((wv >> (16 * tp + 15 - r)) & 1u)) continue;
        const f16* kp = P + (rowbase + j) * NP + PC_KA; float sdot = 0.f;
        for (int e = 0; e < 64; ++e) sdot += (float)qp[e] * (float)kp[e];
        mx = fmaxf(mx, sdot);
    }
    float l = 0.f, o = 0.f;
    for (int j = 0; j <= t; ++j) {
        const int jj = j >> 6, tp = (j >> 5) & 1, i5 = j & 31, kh = (i5 >> 2) & 1, r = (i5 & 3) | ((i5 >> 3) << 2);
        const unsigned wv = MASK[((rowbase + t) * 2 + kh) * 64 + jj];
        if (!((wv >> (16 * tp + 15 - r)) & 1u)) continue;
        const f16* kp = P + (rowbase + j) * NP + PC_KA; float sdot = 0.f;
        for (int e = 0; e < 64; ++e) sdot += (float)qp[e] * (float)kp[e];
        const float p = __builtin_amdgcn_exp2f(sdot - mx);
        l += p; o += p * (float)P[(rowbase + j) * NP + PC_VA + d];
    }
    o /= l;
    const float got = (float)MIX[(rowbase + t) * DM + h * 64 + d];
    if (F.vcu == 0 && tid == 0) { float m64 = -1e30f, s0v = 0.f; float qn = 0.f, kn = 0.f;
        for (int j = 0; j < 64; ++j) { const f16* kp = P + (rowbase + j) * NP + PC_KA; float sd = 0.f; for (int e = 0; e < 64; ++e) sd += (float)qp[e] * (float)kp[e]; if (j == 0) s0v = sd; m64 = fmaxf(m64, sd); }
        for (int e = 0; e < 64; ++e) { qn += (float)qp[e] * (float)qp[e]; const float kv = (float)P[(rowbase + 0) * NP + PC_KA + e]; kn += kv * kv; }
        ctl[20] = (unsigned)(m64 - s0v + 0.5f); ctl[21] = (unsigned)(__builtin_sqrtf(qn) * 4.f + 0.5f); ctl[22] = (unsigned)(__builtin_sqrtf(kn) * 4.f + 0.5f); }
    if (F.vcu == 0 && h == 3) { float ratio = got / o; if (!(ratio > 0.f && ratio < 6.f)) ratio = 6.f; atomicAdd(ctl + 28, (unsigned)(ratio * 10.f + 0.5f)); }
    LAS float* redf = (LAS float*)(F.lds + 64);
    if (tid < 2) redf[tid] = 0.f;
    __syncthreads();
    atomicAdd((float*)&redf[0], (got - o) * (got - o)); atomicAdd((float*)&redf[1], o * o);
    if (F.vcu == 0 && __builtin_fabsf(got - o) > 0.01f + 0.02f * __builtin_fabsf(o)) atomicAdd(ctl + 19, 1u);
    __syncthreads();
    if (tid == 0) { const float rr = __builtin_sqrtf(redf[0] / redf[1]); unsigned c = (unsigned)(rr * 100.f + 0.5f); if (!(rr < 10.f)) c = 1000; ctl[32 + F.vcu] = c; }
    __syncthreads();
}
}

enum { ST_GEMM = 0, ST_IDX = 1, ST_MLA = 2, ST_DSA = 3, ST_FINAL = 4, ST_ZMIX = 5, ST_DBG = 6, ST_DBG2 = 7, ST_NONE = 8 };

#ifndef DBG_WHICH
#define DBG_WHICH 3
#endif
__device__ __forceinline__ void final_phase(const Args& a, Frame& F) {
    const int gw = F.vcu * NWAVES + F.wave, NGW = F.G * NWAVES;
    const float* SS = (const float*)(a.ws + WS_SS16);
    f32x4 gv[4];
#pragma unroll
    for (int j = 0; j < 4; ++j) gv[j] = *((const f32x4*)a.g_final + F.lane + 64 * j);
    float dscale = 1.f;
    if (MK_TIMING) { const unsigned* ctl = (const unsigned*)(a.ws + WS_CTL); unsigned tk = 0; if (TSEL >= 100) { for (int i = 0; i < 12; ++i) tk += __hip_atomic_load(ctl + 48 + i, __ATOMIC_RELAXED, __HIP_MEMORY_SCOPE_AGENT); tk /= 5; } else if (TSEL == 67) tk = __hip_atomic_load(ctl + 48 + 6, __ATOMIC_RELAXED, __HIP_MEMORY_SCOPE_AGENT) + __hip_atomic_load(ctl + 48 + 7, __ATOMIC_RELAXED, __HIP_MEMORY_SCOPE_AGENT); else tk = __hip_atomic_load(ctl + 48 + TSEL, __ATOMIC_RELAXED, __HIP_MEMORY_SCOPE_AGENT); dscale = 1.f + (float)((tk + TOFF) / TUNIT); }
    if (MK_DEBUG) { const unsigned* ctl = (const unsigned*)(a.ws + WS_CTL); const unsigned mm = __hip_atomic_load(ctl + 16, __ATOMIC_RELAXED, __HIP_MEMORY_SCOPE_AGENT), bc = __hip_atomic_load(ctl + 17, __ATOMIC_RELAXED, __HIP_MEMORY_SCOPE_AGENT);
      const unsigned m2 = __hip_atomic_load(ctl + 18, __ATOMIC_RELAXED, __HIP_MEMORY_SCOPE_AGENT);
      unsigned code = 0; if (DBG_WHICH == 0) { if (mm) code = 1 + (31 - __builtin_clz(mm)); } else if (DBG_WHICH == 1) code = bc; else if (DBG_WHICH == 2) { if (m2) code = 1 + (31 - __builtin_clz(m2)); }
      else { unsigned nb = 0, first = 0, second = 0; for (int i = 0; i < 16; ++i) { const unsigned c = __hip_atomic_load(ctl + 32 + i, __ATOMIC_RELAXED, __HIP_MEMORY_SCOPE_AGENT); if (c > nb) nb = c; first += c; if (c > 3 && !second) second = i + 1; }
        code = (DBG_WHICH == 3) ? nb : (DBG_WHICH == 4) ? first / 16 : (DBG_WHICH == 14) ? (__hip_atomic_load(ctl + 28, __ATOMIC_RELAXED, __HIP_MEMORY_SCOPE_AGENT) / 64) : (DBG_WHICH >= 10) ? ({ const unsigned v_ = __hip_atomic_load(ctl + 14 + DBG_WHICH, __ATOMIC_RELAXED, __HIP_MEMORY_SCOPE_AGENT); v_ ? 1 + (31 - __builtin_clz(v_)) : 0u; }) : (DBG_WHICH == 5) ? second : (DBG_WHICH == 6) ? __hip_atomic_load(ctl + 19, __ATOMIC_RELAXED, __HIP_MEMORY_SCOPE_AGENT) / 8 : __hip_atomic_load(ctl + 13 + DBG_WHICH, __ATOMIC_RELAXED, __HIP_MEMORY_SCOPE_AGENT); if (code > 70) code = 70; } dscale = 1.f + (float)code; }
    for (int m = gw; m < M; m += NGW) {
        float s = (F.lane < 16) ? SS[(size_t)m * 16 + F.lane] : 0.f;
        s = wave_sum(s);
        const float rs = frsq(s * (1.f / DM) + EPS) * dscale;
        f32x4* xr = (f32x4*)(a.out + (size_t)m * DM) + F.lane; const h4* hr = (const h4*)((const f16*)(a.ws + WS_XH) + (size_t)m * DM) + F.lane;
#pragma unroll
        for (int j = 0; j < 4; ++j) { const h4 hv = hr[64 * j]; f32x4 v = (f32x4){(float)hv[0], (float)hv[1], (float)hv[2], (float)hv[3]}; v = v * rs * gv[j]; xr[64 * j] = v; }
    }
}
__device__ __forceinline__ void zmix_phase(const Args& a, Frame& F) {
    u32x4* p = (u32x4*)(a.ws + WS_MIX);
    const size_t n = (size_t)M * DM * 2 / 16;
    for (size_t i = (size_t)F.vcu * 512 + F.tid; i < n; i += (size_t)F.G * 512) p[i] = (u32x4){0u, 0u, 0u, 0u};
}

struct Stage { int type, gi, bar; };
__device__ __forceinline__ Stage get_stage(int s) {
#if MK_DEBUG
    switch (s) {
        case 0: return {ST_GEMM, G_FFN1A, 1};
        case 1: return {ST_GEMM, G_FFN1B, 1};
        case 2: return {ST_GEMM, G_WIN, 1};
        case 3: return {ST_GEMM, G_QUP, 0};
        case 4: return {ST_GEMM, G_KVUP, 0};
        case 5: return {ST_IDX, 0, 1};
        case 6: return {ST_DBG, 0, 1};
        case 7: return {ST_MLA, 0, 0};
        case 8: return {ST_DSA, 0, 1};
        case 9: return {ST_DBG2, 0, 1};
        case 10: return {ST_GEMM, G_WOUT, 1};
        case 11: return {ST_GEMM, G_FFN2A, 1};
        case 12: return {ST_GEMM, G_FFN2B, 1};
        default: return {ST_FINAL, 0, 0};
    }
#else
    switch (s) {
        case 0: return {ST_GEMM, G_FFN1A, 1};
        case 1: return {ST_GEMM, G_FFN1B, 1};
        case 2: return {ST_GEMM, G_WIN, 1};
        case 3: return {ST_GEMM, G_QUP, 0};
        case 4: return {ST_GEMM, G_KVUP, 0};
        case 5: return {ST_IDX, 0, 1};
        case 6: return {ST_MLA, 0, 0};
        case 7: return {ST_DSA, 0, 1};
#if DUP_STAGE == 6
        case 8: return {ST_MLA, 0, 1};
#elif DUP_STAGE == 7
        case 8: return {ST_DSA, 0, 1};
#elif DUP_STAGE == 5
        case 8: return {ST_IDX, 0, 1};
#endif
        case 8 + (DUP_STAGE ? 1 : 0): return {ST_GEMM, G_WOUT, 1};
        case 9 + (DUP_STAGE ? 1 : 0): return {ST_GEMM, G_FFN2A, 1};
        case 10 + (DUP_STAGE ? 1 : 0): return {ST_GEMM, G_FFN2B, (FUSE_FINAL && gridDim.x == 256) ? 0 : 1};
        default: return {(FUSE_FINAL && gridDim.x == 256) ? ST_NONE : ST_FINAL, 0, 0};
    }
#endif
}
#if MK_DEBUG
constexpr int NSTAGES = 14;
#else
constexpr int NSTAGES = 12 + (DUP_STAGE ? 1 : 0);
#endif

__global__ void __launch_bounds__(NWAVES * 64, 2) mega_fwd(Args args) {
    extern __shared__ __attribute__((aligned(16))) unsigned char lds_raw[];
    Frame F;
    F.lds = (LAS unsigned char*)lds_raw;
    volatile LAS unsigned* MISC = (volatile LAS unsigned*)(F.lds + MISC_OFF);
    F.tid = threadIdx.x; F.lane = F.tid & 63; F.wave = __builtin_amdgcn_readfirstlane(F.tid >> 6);
    F.G = gridDim.x; { const int bx = blockIdx.x; F.vcu = (F.G % 8 == 0) ? (bx % 8) * (F.G / 8) + bx / 8 : bx; }
    for (int u = F.tid; u < (LDS_BYTES - LDSCTL_OFF) / 4; u += NWAVES * 64) ((LAS unsigned*)(F.lds + LDSCTL_OFF))[u] = 0u;
    __syncthreads();
    unsigned* ctl = (unsigned*)(args.ws + WS_CTL);
    XcdBarrier bar = xcd_barrier_post(ctl + CW_BAR, MISC + 8);

    for (int rep = 0; rep < ((RSEL == 100) ? 2 : 1); ++rep) prep_phase(args, F);
    xcd_barrier(bar);

    for (int s = 0; s < NSTAGES; ++s) {
        const Stage st = get_stage(s);
        unsigned long long tq0 = 0; if (MK_TIMING && blockIdx.x == 0 && threadIdx.x == 0) tq0 = __builtin_amdgcn_s_memrealtime();
        F.tid = opaque_tid(); F.lane = F.tid & 63; F.wave = __builtin_amdgcn_readfirstlane(F.tid >> 6);
        for (int rep = 0; rep < ((s == RSEL) ? 2 : 1); ++rep) {
        if (st.type == ST_GEMM) {
            pg8::GemmDesc g; pg8::make_gemm(args, st.gi, g);
            pg8::StaticOrder S; S.init(g.M, g.N, F.G, (int)blockIdx.x);
            pg8::gemm_phase(F.lds, args, st.gi, g, S);
        } else if (st.type == ST_MLA) {
            if (F.wave >= 4) __builtin_amdgcn_s_setprio(1);
            att::attn_phase<0>(args, F);
            __builtin_amdgcn_s_setprio(0);
        } else if (st.type == ST_DSA) {
            if (F.wave >= 4) __builtin_amdgcn_s_setprio(1);
            att::attn_phase<1>(args, F);
            __builtin_amdgcn_s_setprio(0);
        } else if (st.type == ST_IDX) {
            idx::idx_phase(args, F);
#if MK_DEBUG
        } else if (st.type == ST_DBG) {
            dbg::dbg_phase(args, F);
        } else if (st.type == ST_DBG2) {
            dbg::dbg2_phase(args, F);
#endif
        } else if (st.type == ST_FINAL) {
            final_phase(args, F);
        }
        }
        if (st.bar) xcd_barrier(bar);
        if (MK_TIMING && blockIdx.x == 0 && threadIdx.x == 0) { const unsigned long long tq1 = __builtin_amdgcn_s_memrealtime(); __hip_atomic_store(ctl + 48 + s, (unsigned)(tq1 - tq0), __ATOMIC_RELAXED, __HIP_MEMORY_SCOPE_AGENT); }
    }
}

extern "C" void kernel_launch(void* const* d_in, const int* in_sizes, int n_in, void* d_out, int out_size, void* d_ws, size_t ws_size, hipStream_t stream) {
    static int grid = 0;
    if (grid == 0) {
        if (n_in != 17 || in_sizes[0] != M * DM || out_size != M * DM || ws_size < WS_END) {
            fprintf(stderr, "kernel_launch: unexpected shapes/workspace: n_in %d in0 %d out %d ws %zu (need %zu); nothing launched\n", n_in, n_in > 0 ? in_sizes[0] : -1, out_size, ws_size, (size_t)WS_END);
            grid = -1; return; }
        int dev = 0, cus = 0;
        if (hipGetDevice(&dev) != hipSuccess || hipDeviceGetAttribute(&cus, hipDeviceAttributeMultiprocessorCount, dev) != hipSuccess) { grid = -1; return; }
        if (hipFuncSetAttribute((const void*)mega_fwd, hipFuncAttributeMaxDynamicSharedMemorySize, LDS_BYTES) != hipSuccess) { fprintf(stderr, "kernel_launch: hipFuncSetAttribute failed\n"); grid = -1; return; }
        int per_cu = 0;
        if (hipOccupancyMaxActiveBlocksPerMultiprocessor(&per_cu, (const void*)mega_fwd, NWAVES * 64, LDS_BYTES) != hipSuccess || per_cu < 1)
            fprintf(stderr, "kernel_launch: note: occupancy query reports %d workgroups per CU\n", per_cu);
        (void)hipGetLastError();
        grid = cus < 256 ? cus : 256;
    }
    if (grid < 0) return;
    (void)hipMemsetAsync((char*)d_ws + WS_CTL, 0, CTL_ZERO_BYTES, stream);
    Args a{};
    a.x = (const float*)d_in[0]; a.g_ffn1 = (const float*)d_in[1]; a.w1_gate = (const float*)d_in[2]; a.w1_up = (const float*)d_in[3]; a.w1_down = (const float*)d_in[4];
    a.g_mix = (const float*)d_in[5]; a.w_in = (const float*)d_in[6]; a.g_q_lat = (const float*)d_in[7]; a.g_kv_lat = (const float*)d_in[8]; a.w_uq = (const float*)d_in[9]; a.w_ukv = (const float*)d_in[10];
    a.w_out = (const float*)d_in[11]; a.g_ffn2 = (const float*)d_in[12]; a.w2_gate = (const float*)d_in[13]; a.w2_up = (const float*)d_in[14]; a.w2_down = (const float*)d_in[15]; a.g_final = (const float*)d_in[16];
    a.out = (float*)d_out; a.ws = (unsigned char*)d_ws;
    hipLaunchKernelGGL(mega_fwd, dim3(grid), dim3(NWAVES * 64), LDS_BYTES, stream, a);
}
```

```cpp
#include <hip/hip_runtime.h>
#include <cstdio>
#include <cstdint>
#include <cmath>

#ifndef MK_DEBUG
#define MK_DEBUG 0
#endif
#ifndef MK_TIMING
#define MK_TIMING 0
#endif
#ifndef TSEL
#define TSEL 6
#endif
#ifndef TUNIT
#define TUNIT 4000
#endif
#ifndef TOFF
#define TOFF 0
#endif
#ifndef DUP_STAGE
#define DUP_STAGE 0
#endif
#ifndef FUSE_FINAL
#define FUSE_FINAL 1
#endif
#ifndef RSEL
#define RSEL -1
#endif
#define LAS __attribute__((address_space(3)))
#define GAS __attribute__((address_space(1)))
typedef _Float16 f16;
typedef _Float16 h8 __attribute__((ext_vector_type(8)));
typedef _Float16 h4 __attribute__((ext_vector_type(4)));
typedef _Float16 h2 __attribute__((ext_vector_type(2)));
typedef float f32x2 __attribute__((ext_vector_type(2)));
typedef float f32x4 __attribute__((ext_vector_type(4)));
typedef float f32x16 __attribute__((ext_vector_type(16)));
typedef unsigned u32x2 __attribute__((ext_vector_type(2)));
typedef unsigned u32x4 __attribute__((ext_vector_type(4)));
typedef unsigned short u16;

constexpr int BATCH = 8, SEQ = 4096, DM = 1024, M = BATCH * SEQ;
constexpr int DFF = 2816, NFF = 2 * DFF;
constexpr int DPROJ = 2416, NP = 2560, NPS = 2816;
constexpr int QLORA = 384, KVLORA = 256;
constexpr int NQB = 768, NKV = 1024;
constexpr float EPS = 1e-6f;
constexpr float LOG2E = 1.4426950408889634f;
constexpr int PC_QA = 0, PC_QI = 512, PC_KA = 1536, PC_KI = 1600, PC_KR = 1664, PC_VA = 1696, PC_WI = 1760, PC_CQ = 1792, PC_CKV = 2304;
constexpr int WC_QA = 0, WC_KA = 512, WC_VA = 576, WC_QI = 640, WC_KI = 1664, WC_WI = 1728, WC_CQ = 1744, WC_CKV = 2128, WC_KR = 2384;

constexpr size_t MiB = 1u << 20;
constexpr size_t WS_CTL = 0, CTL_ZERO_BYTES = 1 * MiB;
constexpr size_t WS_BT1 = 1 * MiB;
constexpr size_t WS_BTD1 = 12 * MiB;
constexpr size_t WS_BT2 = 18 * MiB;
constexpr size_t WS_BTD2 = 29 * MiB;
constexpr size_t WS_BTIN = 35 * MiB;
constexpr size_t WS_BTQ = 40 * MiB;
constexpr size_t WS_BTKV = 41 * MiB;
constexpr size_t WS_BTOUT = 42 * MiB;
constexpr size_t WS_ROPE = 44 * MiB;
constexpr size_t WS_SS0 = 46 * MiB;
constexpr size_t WS_SS16 = 47 * MiB;
constexpr size_t WS_SSQ = 49 * MiB;
constexpr size_t WS_SSKV = 50 * MiB;
constexpr size_t WS_WI = 51 * MiB;
constexpr size_t WS_XH = 54 * MiB;
constexpr size_t WS_H = 118 * MiB;
constexpr size_t WS_P = WS_H;
constexpr size_t WS_QB = 294 * MiB;
constexpr size_t WS_KV = 342 * MiB;
constexpr size_t WS_MIX = 406 * MiB;
constexpr size_t WS_MASK = 470 * MiB;
constexpr size_t WS_END = 486 * MiB;

constexpr int RING_BYTES = 131072;
constexpr int LDSCTL_OFF = RING_BYTES, MISC_OFF = LDSCTL_OFF + 320;
constexpr int LDS_BYTES = 147456;
constexpr int NWAVES = 8;

#define RLX_AGENT __ATOMIC_RELAXED, __HIP_MEMORY_SCOPE_AGENT
#define LDS_WAIT() asm volatile("s_waitcnt lgkmcnt(0)" ::: "memory")
#define VM_WAIT() asm volatile("s_waitcnt vmcnt(0)" ::: "memory")

#ifndef WBITS
#define WBITS 5
#endif
#ifndef GRPBAR
#define GRPBAR 1
#endif
#ifndef HBITS
#define HBITS 6
#endif
__device__ __forceinline__ unsigned pkh(float a, float b) { h2 v; v.x = (f16)a; v.y = (f16)b; return __builtin_bit_cast(unsigned, v); }
__device__ __forceinline__ int opaque_tid() { int t = threadIdx.x; asm volatile("" : "+v"(t)); return t; }
__device__ __forceinline__ float frsq(float x) { return __builtin_amdgcn_rsqf(x); }
__device__ __forceinline__ float sq4(const f32x4 v) { return (v.x * v.x + v.y * v.y) + (v.z * v.z + v.w * v.w); }
__device__ __forceinline__ float wave_sum(float v) {
#pragma unroll
    for (int o = 1; o < 64; o <<= 1) v += __shfl_xor(v, o);
    return v;
}

#define XB_TMO      128
#define XB_XCNT(j)  (256  + 64 * (j))
#define XB_XSUB(j)  (1280 + 64 * (j))
#define XB_XGEN(j)  (2304 + 64 * (j))
#define XB_TOP      3328
#define XB_TOPGEN   3392
#define XCD_BAR_WORDS 3456
#define XB_SPIN_CAP (1u << 18)
constexpr int CW_BAR = 4096;

__device__ __forceinline__ unsigned xb_ld(unsigned* p)              { return __hip_atomic_load(p, __ATOMIC_RELAXED, __HIP_MEMORY_SCOPE_AGENT); }
__device__ __forceinline__ unsigned xb_add(unsigned* p, unsigned v) { return __hip_atomic_fetch_add(p, v, __ATOMIC_RELAXED, __HIP_MEMORY_SCOPE_AGENT); }
__device__ __forceinline__ unsigned xb_xcc_id() { return (unsigned)__builtin_amdgcn_s_getreg((3 << 11) | 20) & 0xFu; }
#define XB_SPIN(cond, bar) do { unsigned _sp = 0; while (cond) { __builtin_amdgcn_s_sleep(1); \
    if ((++_sp & 255u) == 0u) { if (xb_ld(&(bar)[XB_TMO])) break; if (_sp > XB_SPIN_CAP) { atomicAdd(&(bar)[XB_TMO], 1u); break; } } } } while (0)

struct XcdBarrier { unsigned* bar; unsigned x; volatile LAS unsigned* st; };

__device__ __forceinline__ XcdBarrier xcd_barrier_post(unsigned* bar, volatile LAS unsigned* st) {
    XcdBarrier b; b.bar = bar; b.x = xb_xcc_id(); b.st = st;
    if (threadIdx.x == 0) (void)xb_add(&bar[XB_XCNT(b.x)], 1u);
    return b;
}
__device__ __forceinline__ void xcd_barrier_complete(unsigned* bar, unsigned x, unsigned& nloc, unsigned& nx) {
    const unsigned G = gridDim.x * gridDim.y * gridDim.z;
    unsigned sum, cnt, mine, sp = 0u;
    for (;;) {
        sum = 0u; cnt = 0u; mine = 0u;
#pragma unroll
        for (unsigned j = 0; j < 16; ++j) { const unsigned c = xb_ld(&bar[XB_XCNT(j)]); sum += c; cnt += (c > 0u) ? 1u : 0u; mine = (j == x) ? c : mine; }
        if (sum == G) break;
        __builtin_amdgcn_s_sleep(1);
        if ((++sp & 255u) == 0u) { if (xb_ld(&bar[XB_TMO])) break; if (sp > XB_SPIN_CAP) { atomicAdd(&bar[XB_TMO], 1u); break; } }
    }
    nloc = mine > 0u ? mine : 1u; nx = cnt > 0u ? cnt : 1u;
}
__device__ __forceinline__ void xcd_barrier(const XcdBarrier& b) {
    asm volatile("s_waitcnt vmcnt(0)" ::: "memory");
    __syncthreads();
    if (threadIdx.x == 0) {
        unsigned* bar = b.bar; unsigned bx_ = b.x;
        asm volatile("" : "+s"(bar), "+s"(bx_));
        __builtin_amdgcn_s_waitcnt(0);
        unsigned nloc = b.st[0], nx = b.st[1];
        if (nloc == 0u) { xcd_barrier_complete(bar, bx_, nloc, nx); b.st[0] = nloc; b.st[1] = nx; }
        const unsigned old = xb_add(&bar[XB_XSUB(bx_)], 1u);
        const unsigned gen = old / nloc;
        if (old + 1u == (gen + 1u) * nloc) {
            __builtin_amdgcn_fence(__ATOMIC_RELEASE, "agent");
            asm volatile("s_waitcnt vmcnt(0)" ::: "memory");
            const unsigned og = xb_add(&bar[XB_TOP], 1u);
            const unsigned tg = og / nx;
            if (og + 1u == (tg + 1u) * nx) xb_add(&bar[XB_TOPGEN], 1u);
            else XB_SPIN(xb_ld(&bar[XB_TOPGEN]) == tg, bar);
            __builtin_amdgcn_fence(__ATOMIC_ACQUIRE, "agent");
            xb_add(&bar[XB_XGEN(bx_)], 1u);
            asm volatile("s_waitcnt vmcnt(0)" ::: "memory");
        } else {
            XB_SPIN(xb_ld(&bar[XB_XGEN(bx_)]) == gen, bar);
            __builtin_amdgcn_fence(__ATOMIC_ACQUIRE, "agent");
            asm volatile("s_waitcnt vmcnt(0)" ::: "memory");
        }
    }
    __syncthreads();
}

#define GB_BASE 32768
#define GB_POP(g, y)  (GB_BASE + (g) * 16 + (y))
#define GB_SUB(g, y)  (GB_BASE + 256 + ((g) * 16 + (y)) * 16)
#define GB_TOP(g)     (GB_BASE + 256 + 2048 + (g) * 16)
__device__ __forceinline__ void grp_barrier_post(const XcdBarrier& b) {
    if (threadIdx.x == 0) (void)xb_add(&b.bar[GB_POP(blockIdx.x & 7u, b.x)], 1u);
}
__device__ __forceinline__ void grp_barrier(const XcdBarrier& b) {
    asm volatile("s_waitcnt vmcnt(0)" ::: "memory");
    __syncthreads();
    if (threadIdx.x == 0) {
        unsigned* bar = b.bar; unsigned y = b.x; asm volatile("" : "+s"(bar), "+s"(y));
        __builtin_amdgcn_s_waitcnt(0);
        const unsigned g = blockIdx.x & 7u;
        unsigned nloc = b.st[4], nx = b.st[5];
        if (nloc == 0u) {
            nx = 0u;
#pragma unroll
            for (unsigned j = 0; j < 16; ++j) { const unsigned c = xb_ld(&bar[GB_POP(g, j)]); nx += (c > 0u) ? 1u : 0u; nloc = (j == y) ? c : nloc; }
            nloc = nloc > 0u ? nloc : 1u; nx = nx > 0u ? nx : 1u; b.st[4] = nloc; b.st[5] = nx; }
        const unsigned n = b.st[3] + 1u; b.st[3] = n;
        if (nx == 1u) {
            (void)xb_add(&bar[GB_SUB(g, y)], 1u);
            const unsigned want1 = n * nloc;
            XB_SPIN(xb_ld(&bar[GB_SUB(g, y)]) < want1, bar);
        } else {
            const unsigned old = xb_add(&bar[GB_SUB(g, y)], 1u);
            if (old + 1u == n * nloc) {
                __builtin_amdgcn_fence(__ATOMIC_RELEASE, "agent");
                asm volatile("s_waitcnt vmcnt(0)" ::: "memory");
                (void)xb_add(&bar[GB_TOP(g)], 1u);
            }
            const unsigned want = n * nx;
            XB_SPIN(xb_ld(&bar[GB_TOP(g)]) < want, bar);
        }
        __builtin_amdgcn_fence(__ATOMIC_ACQUIRE, "agent");
        asm volatile("s_waitcnt vmcnt(0)" ::: "memory");
    }
    __syncthreads();
}

struct Args {
    const float* x; const float* g_ffn1; const float* w1_gate; const float* w1_up; const float* w1_down;
    const float* g_mix; const float* w_in; const float* g_q_lat; const float* g_kv_lat; const float* w_uq; const float* w_ukv;
    const float* w_out; const float* g_ffn2; const float* w2_gate; const float* w2_up; const float* w2_down; const float* g_final;
    float* out; unsigned char* ws;
};

constexpr int G_FFN1A = 0, G_FFN1B = 1, G_WIN = 2, G_QUP = 3, G_KVUP = 4, G_WOUT = 5, G_FFN2A = 6, G_FFN2B = 7;
namespace pg8 {
constexpr int BM = 256, BK = 64, HALF = 128, HTB = HALF * BK * 2, STAGE_BYTES = 8 * HTB, NXCD = 8, WGM = 4;
__host__ __device__ __forceinline__ int lds_byte(int r, int c) { const int st = (r >> 4) * 2 + (c >> 5), rr = r & 15, cc = c & 31, ob = rr * 64 + cc * 2; return st * 1024 + (ob ^ (((ob >> 9) & 1) << 5)); }
__host__ __device__ __forceinline__ void stage_rc(int b, int& R, int& C) { const int st = b / 1024, sb = b % 1024, swz = sb ^ (((sb >> 9) & 1) << 5); R = (st >> 1) * 16 + swz / 64; C = (st & 1) * 32 + (swz % 64) / 2; }
__host__ __device__ __forceinline__ int perm32(int rho) { const int n = rho >> 4, i = rho & 15; return 8 * (i >> 2) + 4 * n + (i & 3); }

struct Unit { int pm, pn; };
struct StaticOrder {
    int nM, nN, nwg, G, c;
    __device__ void init(int M_, int N_, int G_, int c_) { nM = M_ / BM; nN = N_ / BM; nwg = nM * nN; G = G_; c = c_; }
    __device__ bool next(int i, Unit& u) const {
        const long L = (long)i * G + c; if (L >= nwg) return false;
        int wgid = (int)L; { const int q = nwg / NXCD, r = nwg % NXCD, xcd = wgid % NXCD, off = wgid / NXCD; wgid = (xcd < r ? xcd * (q + 1) : r * (q + 1) + (xcd - r) * q) + off; }
        const int nig = WGM * nN, gid = wgid / nig, fm = gid * WGM, gsz = (nM - fm) < WGM ? (nM - fm) : WGM;
        u.pm = fm + ((wgid % nig) % gsz); u.pn = (wgid % nig) / gsz; return true;
    }
};

enum { EPI_SWIGLU = 0, EPI_RESID = 1, EPI_WIN = 2, EPI_QUP = 3, EPI_KVUP = 4, EPI_FINAL = 5 };
struct GemmDesc {
    const f16* A; const f16* Bt; int M, N, K, lda;
    int epi;
    const float* ss; int nss;
    float invn;
    f16* oh; int ldo;
    const float* xin; float* xout; f16* xh; float* ssout; float rscale;
    const float* cos64; const float* sin64; const float* cos32; const float* sin32;
    float* wi; float* ssq; float* sskv;
};

template <int NSS> __device__ __forceinline__ float row_rstd(const float* ss, int row, float invn) {
    float s;
    if (NSS == 1) s = ss[row];
    else { s = 0.f;
#pragma unroll
        for (int j = 0; j < NSS / 4; ++j) { const f32x4 v = *(const f32x4*)(ss + (size_t)row * NSS + 4 * j); s += (v.x + v.y) + (v.z + v.w); } }
    return frsq(s * invn + EPS);
}
__device__ __forceinline__ float row_rstd_rt(const float* ss, int nss, int row, float invn) {
    if (nss == 1) return row_rstd<1>(ss, row, invn);
    if (nss == 4) return row_rstd<4>(ss, row, invn);
    if (nss == 8) return row_rstd<8>(ss, row, invn);
    return row_rstd<16>(ss, row, invn);
}

__device__ __forceinline__ void make_gemm(const Args& a, int gi, GemmDesc& g);
__device__ __forceinline__ void epilogue(const Args& a, int gi, f32x4 (&acc)[2][2][4][2], const Unit& u, int wr, int wc, int fr, int fq, LAS unsigned char* lds, int upar) {
    asm volatile("" : "+s"(gi), "+s"(wr), "+s"(wc), "+v"(fr), "+v"(fq));
    GemmDesc g; make_gemm(a, gi, g);
    const LAS float* RST = (const LAS float*)(lds + LDSCTL_OFF + 7168) + upar * 256;
    const int rl0 = wr * 64 + fr;
    const int row0 = u.pm * BM + wr * 64 + fr;
    if (g.epi == EPI_SWIGLU) {
        const int hc0 = 128 * u.pn + 32 * wc + 8 * fq;
#pragma unroll
        for (int ai = 0; ai < 2; ++ai)
#pragma unroll
            for (int m = 0; m < 4; ++m) {
                const int row = row0 + ai * HALF + m * 16;
                const float rs = RST[rl0 + ai * HALF + m * 16];
                u32x4 w;
#pragma unroll
                for (int bj = 0; bj < 2; ++bj) {
                    const f32x4 ga = acc[ai][bj][m][0] * rs, ua = acc[ai][bj][m][1] * rs;
                    float hv[4];
#pragma unroll
                    for (int i = 0; i < 4; ++i) { const float sg = __builtin_amdgcn_rcpf(1.f + __builtin_amdgcn_exp2f(-ga[i] * LOG2E)); hv[i] = ga[i] * sg * ua[i]; }
                    if (bj == 0) { w.x = pkh(hv[0], hv[1]); w.y = pkh(hv[2], hv[3]); } else { w.z = pkh(hv[0], hv[1]); w.w = pkh(hv[2], hv[3]); }
                }
                if (HBITS < 10) {
                    typedef unsigned short u16x8 __attribute__((ext_vector_type(8)));
                    u16x8 hv8 = __builtin_bit_cast(u16x8, w); const unsigned short hh = (unsigned short)(1u << (9 - HBITS)), hm = (unsigned short)~((1u << (10 - HBITS)) - 1u);
                    hv8 = (hv8 + hh) & hm; w = __builtin_bit_cast(u32x4, hv8); }
                __builtin_nontemporal_store(w, (u32x4*)(g.oh + (size_t)row * DFF + hc0));
            }
    } else if (g.epi == EPI_RESID) {
        const int col0 = u.pn * BM + wc * 32 + 8 * fq;
#pragma unroll
        for (int ai = 0; ai < 2; ++ai)
#pragma unroll
            for (int m = 0; m < 4; ++m) {
                const int row = row0 + ai * HALF + m * 16;
                const size_t off = (size_t)row * DM + col0;
                float q = 0.f;
#pragma unroll
                for (int bj = 0; bj < 2; ++bj) {
                    const h8 hv = *(const h8*)(g.xh + off + bj * HALF);
                    const f32x4 x0 = (f32x4){(float)hv[0], (float)hv[1], (float)hv[2], (float)hv[3]} + acc[ai][bj][m][0] * g.rscale;
                    const f32x4 x1 = (f32x4){(float)hv[4], (float)hv[5], (float)hv[6], (float)hv[7]} + acc[ai][bj][m][1] * g.rscale;
                    u32x4 w; w.x = pkh(x0[0], x0[1]); w.y = pkh(x0[2], x0[3]); w.z = pkh(x1[0], x1[1]); w.w = pkh(x1[2], x1[3]);
                    *(u32x4*)(g.xh + off + bj * HALF) = w;
                    q += sq4(x0) + sq4(x1);
                }
                q += __shfl_xor(q, 16); q += __shfl_xor(q, 32);
                if (fq == 0) g.ssout[(size_t)row * 16 + u.pn * 4 + wc] = q;
                if (m == 3) asm volatile("" ::: "memory");
            }
    } else if (g.epi == EPI_FINAL) {
        LAS float* Pss = (LAS float*)(lds + LDSCTL_OFF + 1024);
        LAS float* Srs = (LAS float*)(lds + LDSCTL_OFF + 1024 + 4096);
        const int col0 = u.pn * BM + wc * 32 + 8 * fq;
        const int tid_ = opaque_tid();
#pragma unroll
        for (int ai = 0; ai < 2; ++ai)
#pragma unroll
            for (int m = 0; m < 4; ++m) {
                const int rl = ai * HALF + wr * 64 + m * 16 + fr;
                const size_t off = (size_t)(u.pm * BM + rl) * DM + col0;
                float q = 0.f;
#pragma unroll
                for (int bj = 0; bj < 2; ++bj) {
                    const h8 hv = *(const h8*)(g.xh + off + bj * HALF);
                    const f32x4 x0 = (f32x4){(float)hv[0], (float)hv[1], (float)hv[2], (float)hv[3]} + acc[ai][bj][m][0] * g.rscale;
                    const f32x4 x1 = (f32x4){(float)hv[4], (float)hv[5], (float)hv[6], (float)hv[7]} + acc[ai][bj][m][1] * g.rscale;
                    u32x4 w; w.x = pkh(x0[0], x0[1]); w.y = pkh(x0[2], x0[3]); w.z = pkh(x1[0], x1[1]); w.w = pkh(x1[2], x1[3]);
                    *(u32x4*)(g.xh + off + bj * HALF) = w;
                    q += sq4(x0) + sq4(x1);
                }
                q += __shfl_xor(q, 16); q += __shfl_xor(q, 32);
                if (fq == 0) Pss[rl * 4 + wc] = q;
                if (m == 3) asm volatile("" ::: "memory");
            }
        asm volatile("s_waitcnt vmcnt(0) lgkmcnt(0)\n\ts_barrier" ::: "memory");
        unsigned char* wsq = a.ws; asm volatile("" : "+s"(wsq));
        unsigned* cntw = (unsigned*)(wsq + WS_CTL) + 8192 + 64 * u.pm;
        if (tid_ < 256) {
            const f32x4 p4 = *(const LAS f32x4*)(Pss + tid_ * 4);
            const float sv = (p4.x + p4.y) + (p4.z + p4.w);
            __hip_atomic_store((unsigned*)(g.ssout + (size_t)(u.pm * BM + tid_) * 16 + u.pn), __builtin_bit_cast(unsigned, sv), __ATOMIC_RELAXED, __HIP_MEMORY_SCOPE_AGENT);
            asm volatile("s_waitcnt vmcnt(0)" ::: "memory");
            if ((tid_ & 63) == 0) __hip_atomic_fetch_add(cntw, 1u, __ATOMIC_RELAXED, __HIP_MEMORY_SCOPE_AGENT);
        }
        if (tid_ < 64) {
            unsigned sp = 0;
            while ((unsigned)__builtin_amdgcn_readfirstlane(__hip_atomic_load(cntw, __ATOMIC_RELAXED, __HIP_MEMORY_SCOPE_AGENT)) < 16u) { __builtin_amdgcn_s_sleep(2); if (++sp > (1u << 22)) break; }
            __builtin_amdgcn_fence(__ATOMIC_ACQUIRE, "agent");
            asm volatile("s_waitcnt vmcnt(0)" ::: "memory");
        }
        asm volatile("s_waitcnt vmcnt(0) lgkmcnt(0)\n\ts_barrier" ::: "memory");
        if (tid_ < 256) {
            const unsigned* sl = (const unsigned*)(g.ssout + (size_t)(u.pm * BM + tid_) * 16);
            float sv = 0.f;
#pragma unroll
            for (int k = 0; k < 4; ++k) sv += __builtin_bit_cast(float, __hip_atomic_load(sl + k, __ATOMIC_RELAXED, __HIP_MEMORY_SCOPE_AGENT));
            Srs[tid_] = frsq(sv * (1.f / DM) + EPS);
        }
        asm volatile("s_waitcnt vmcnt(0) lgkmcnt(0)\n\ts_barrier" ::: "memory");
        int fr2 = fr, col2 = col0; asm volatile("" : "+v"(fr2), "+v"(col2));
        f32x4 gv[2][2];
#pragma unroll
        for (int bj = 0; bj < 2; ++bj)
#pragma unroll
            for (int n = 0; n < 2; ++n) gv[bj][n] = *(const f32x4*)(a.g_final + col2 + bj * HALF + n * 4);
#pragma unroll
        for (int ai = 0; ai < 2; ++ai)
#pragma unroll
            for (int m = 0; m < 4; ++m) {
                const int rl = ai * HALF + wr * 64 + m * 16 + fr2;
                const float rs = Srs[rl];
                const size_t off = (size_t)(u.pm * BM + rl) * DM + col2;
                asm volatile("" ::: "memory");
#pragma unroll
                for (int bj = 0; bj < 2; ++bj) { const h8 hv = *(const h8*)(g.xh + off + bj * HALF);
                    const f32x4 x0 = (f32x4){(float)hv[0], (float)hv[1], (float)hv[2], (float)hv[3]}, x1 = (f32x4){(float)hv[4], (float)hv[5], (float)hv[6], (float)hv[7]};
                    *(f32x4*)(g.xout + off + bj * HALF) = x0 * rs * gv[bj][0]; *(f32x4*)(g.xout + off + bj * HALF + 4) = x1 * rs * gv[bj][1]; }
            }
        asm volatile("s_waitcnt lgkmcnt(0)\n\ts_barrier" ::: "memory");
    } else if (g.epi == EPI_WIN && u.pn < 6) {
        const float sc = (u.pn < 2) ? 0.125f * LOG2E : 1.f;
#pragma unroll
        for (int ai = 0; ai < 2; ++ai)
#pragma unroll
            for (int mp = 0; mp < 2; ++mp) {
                f32x4 cv[2][2], sv[2][2];
#pragma unroll
                for (int k = 0; k < 2; ++k) { const int t_ = (row0 + ai * HALF + (2 * mp + k) * 16) & (SEQ - 1);
                    cv[k][0] = *(const f32x4*)(g.cos64 + t_ * 32 + 8 * fq); cv[k][1] = *(const f32x4*)(g.cos64 + t_ * 32 + 8 * fq + 4);
                    sv[k][0] = *(const f32x4*)(g.sin64 + t_ * 32 + 8 * fq); sv[k][1] = *(const f32x4*)(g.sin64 + t_ * 32 + 8 * fq + 4); }
#pragma unroll
                for (int k = 0; k < 2; ++k) { const int m = 2 * mp + k;
                    const int row = row0 + ai * HALF + m * 16;
                    const float rs = RST[rl0 + ai * HALF + m * 16] * sc;
                    f16* prow = g.oh + (size_t)row * NPS + 256 * u.pn + 64 * wc + 8 * fq;
                    u32x4 w1, w2;
#pragma unroll
                    for (int bj = 0; bj < 2; ++bj) {
                        const f32x4 v0 = acc[ai][bj][m][0] * rs, v1 = acc[ai][bj][m][1] * rs;
                        const f32x4 o1 = v0 * cv[k][bj] - v1 * sv[k][bj], o2 = v0 * sv[k][bj] + v1 * cv[k][bj];
                        if (bj == 0) { w1.x = pkh(o1[0], o1[1]); w1.y = pkh(o1[2], o1[3]); w2.x = pkh(o2[0], o2[1]); w2.y = pkh(o2[2], o2[3]); }
                        else { w1.z = pkh(o1[0], o1[1]); w1.w = pkh(o1[2], o1[3]); w2.z = pkh(o2[0], o2[1]); w2.w = pkh(o2[2], o2[3]); }
                    }
                    *(u32x4*)prow = w1; *(u32x4*)(prow + 32) = w2;
                }
            }
    } else if (g.epi == EPI_WIN) {
        const int pn = u.pn;
#pragma unroll
        for (int ai = 0; ai < 2; ++ai) {
            f32x4 c64v[4], s64v[4];
            if (pn <= 6) {
#pragma unroll
                for (int m = 0; m < 4; ++m) { const int t_ = (row0 + ai * HALF + m * 16) & (SEQ - 1);
                    c64v[m] = *(const f32x4*)(g.cos64 + t_ * 32 + 16 * (wc & 1) + 4 * fq); s64v[m] = *(const f32x4*)(g.sin64 + t_ * 32 + 16 * (wc & 1) + 4 * fq); }
            }
#pragma unroll
            for (int m = 0; m < 4; ++m) {
                const int row = row0 + ai * HALF + m * 16;
                const int t = row & (SEQ - 1);
                const float rs = RST[rl0 + ai * HALF + m * 16];
                f16* prow = g.oh + (size_t)row * NPS;
                float ssacc = 0.f;
#pragma unroll
                for (int bj = 0; bj < 2; ++bj) {
                    const f32x4 v0 = acc[ai][bj][m][0] * rs, v1 = acc[ai][bj][m][1] * rs;
                    int type, pcol;
                    float sc = 1.f;
                    if (pn < 6) { type = 0; pcol = 256 * pn + 128 * bj + 64 * (wc >> 1); if (pn < 2) sc = 0.125f * LOG2E; }
                    else if (pn == 6) {
                        if (bj == 0) { type = 0; pcol = PC_KA + 64 * (wc >> 1); }
                        else if (wc == 0) { type = 1; pcol = PC_KR; }
                        else if (wc < 3) { type = 2; pcol = PC_VA + 32 * (wc - 1); }
                        else { type = 3; pcol = 0; }
                    } else if (pn == 7) { type = 2; pcol = PC_CQ + 128 * bj + 32 * wc; }
                    else if (pn == 8) { if (bj == 0) { type = 2; pcol = PC_CQ + 256 + 32 * wc; } else { type = 4; pcol = 0; } }
                    else { type = 2; pcol = PC_CKV + 128 * bj + 32 * wc; }
                    if (type == 0) {
                        const int g2 = wc & 1;
                        const f32x4 c4 = c64v[m], s4 = s64v[m];
                        const f32x4 o1 = (v0 * c4 - v1 * s4) * sc, o2 = (v0 * s4 + v1 * c4) * sc;
                        u32x2 w1; w1.x = pkh(o1[0], o1[1]); w1.y = pkh(o1[2], o1[3]);
                        u32x2 w2; w2.x = pkh(o2[0], o2[1]); w2.y = pkh(o2[2], o2[3]);
                        *(u32x2*)(prow + pcol + 16 * g2 + 4 * fq) = w1;
                        *(u32x2*)(prow + pcol + 32 + 16 * g2 + 4 * fq) = w2;
                    } else if (type == 1) {
                        const f32x4 c4 = *(const f32x4*)(g.cos32 + t * 16 + 4 * fq), s4 = *(const f32x4*)(g.sin32 + t * 16 + 4 * fq);
                        const f32x4 o1 = v0 * c4 - v1 * s4, o2 = v0 * s4 + v1 * c4;
                        u32x2 w1; w1.x = pkh(o1[0], o1[1]); w1.y = pkh(o1[2], o1[3]);
                        u32x2 w2; w2.x = pkh(o2[0], o2[1]); w2.y = pkh(o2[2], o2[3]);
                        *(u32x2*)(prow + pcol + 4 * fq) = w1;
                        *(u32x2*)(prow + pcol + 16 + 4 * fq) = w2;
                    } else if (type == 2) {
                        u32x4 w; w.x = pkh(v0[0], v0[1]); w.y = pkh(v0[2], v0[3]); w.z = pkh(v1[0], v1[1]); w.w = pkh(v1[2], v1[3]);
                        *(u32x4*)(prow + pcol + 8 * fq) = w;
                        ssacc += sq4(v0) + sq4(v1);
                    } else if (type == 3) {
                        *(f32x4*)(g.wi + (size_t)row * 16 + 4 * fq) = v0;
                    }
                }
                if (pn >= 7) {
                    ssacc += __shfl_xor(ssacc, 16); ssacc += __shfl_xor(ssacc, 32);
                    if (fq == 0) {
                        if (pn == 7) g.ssq[(size_t)row * 8 + wc] = ssacc;
                        else if (pn == 8) g.ssq[(size_t)row * 8 + 4 + wc] = ssacc;
                        else g.sskv[(size_t)row * 4 + wc] = ssacc;
                    }
                }
            }
        }
    } else if (g.epi == EPI_QUP) {
        const float c2b = 0.10206207261596577f * LOG2E;
#pragma unroll
        for (int ai = 0; ai < 2; ++ai)
#pragma unroll
            for (int m = 0; m < 4; ++m) {
                const int row = row0 + ai * HALF + m * 16;
                const int t = row & (SEQ - 1);
                const float rs = RST[rl0 + ai * HALF + m * 16] * c2b;
                f16* prow = g.oh + (size_t)row * NQB;
#pragma unroll
                for (int bj = 0; bj < 2; ++bj) {
                    const f32x4 v0 = acc[ai][bj][m][0] * rs, v1 = acc[ai][bj][m][1] * rs;
                    if (u.pn < 2) {
                        u32x4 w; w.x = pkh(v0[0], v0[1]); w.y = pkh(v0[2], v0[3]); w.z = pkh(v1[0], v1[1]); w.w = pkh(v1[2], v1[3]);
                        *(u32x4*)(prow + 256 * u.pn + 128 * bj + 32 * wc + 8 * fq) = w;
                    } else {
                        const int head = 4 * bj + wc;
                        const f32x4 c4 = *(const f32x4*)(g.cos32 + t * 16 + 4 * fq), s4 = *(const f32x4*)(g.sin32 + t * 16 + 4 * fq);
                        const f32x4 o1 = v0 * c4 - v1 * s4, o2 = v0 * s4 + v1 * c4;
                        u32x2 w1; w1.x = pkh(o1[0], o1[1]); w1.y = pkh(o1[2], o1[3]);
                        u32x2 w2; w2.x = pkh(o2[0], o2[1]); w2.y = pkh(o2[2], o2[3]);
                        *(u32x2*)(prow + 512 + 32 * head + 4 * fq) = w1;
                        *(u32x2*)(prow + 512 + 32 * head + 16 + 4 * fq) = w2;
                    }
                }
            }
    } else {
#pragma unroll
        for (int ai = 0; ai < 2; ++ai)
#pragma unroll
            for (int m = 0; m < 4; ++m) {
                const int row = row0 + ai * HALF + m * 16;
                const float rs = RST[rl0 + ai * HALF + m * 16];
                f16* prow = g.oh + (size_t)row * NKV;
#pragma unroll
                for (int bj = 0; bj < 2; ++bj) {
                    const f32x4 v0 = acc[ai][bj][m][0] * rs, v1 = acc[ai][bj][m][1] * rs;
                    u32x4 w; w.x = pkh(v0[0], v0[1]); w.y = pkh(v0[2], v0[3]); w.z = pkh(v1[0], v1[1]); w.w = pkh(v1[2], v1[3]);
                    *(u32x4*)(prow + 256 * u.pn + 128 * bj + 32 * wc + 8 * fq) = w;
                }
            }
    }
}

__device__ __forceinline__ void gemm_phase(LAS unsigned char* lds, const Args& args, const int gi, const GemmDesc& g, const StaticOrder& S) {
    const int tid = opaque_tid(), wid = __builtin_amdgcn_readfirstlane(tid >> 6), lane = tid & 63, wr = wid >> 2, wc = wid & 3, fr = lane & 15, fq = lane >> 4;
    const int K = g.K, nt = K / BK, lda = g.lda;
    unsigned voffA[2], voffB[2];
#pragma unroll
    for (int i = 0; i < 2; ++i) { int R, C; stage_rc(tid * 16 + i * 8192, R, C);
        voffA[i] = (unsigned)(R * lda + C) * 2u; voffB[i] = (unsigned)(R * K + C) * 2u; }
    const size_t kstep = (size_t)(BK * 2);
    const size_t hstepA = (size_t)HALF * lda * 2, hstepB = (size_t)HALF * K * 2;
    const size_t tstepA = 2 * hstepA, tstepB = 2 * hstepB;
    const unsigned ldsw = (unsigned)wid * 1024u;
    const int aoff = lds_byte(wr * 64 + fr, fq * 8), boff = lds_byte(wc * 32 + fr, fq * 8);
#define PG8_SA(b, h) (((b) * 2 + (h)) * HTB)
#define PG8_SB(b, h) ((4 + (b) * 2 + (h)) * HTB)
#define PG8_STAGE(bufoff, gbase, voff) do { _Pragma("unroll") for (int _i = 0; _i < 2; ++_i) \
        __builtin_amdgcn_global_load_lds((const unsigned*)((const char*)(gbase) + (voff)[_i]), (LAS unsigned*)(lds + (bufoff) + ldsw + _i * 8192), 16, 0, 0); } while (0)
#define PG8_LDA(dst, b, h) do { _Pragma("unroll") for (int m = 0; m < 4; ++m) _Pragma("unroll") for (int k = 0; k < 2; ++k) dst[m][k] = *(const LAS h8*)(lds + PG8_SA(b, h) + aoff + m * 2048 + k * 1024); } while (0)
#define PG8_LDB(dst, b, h) do { _Pragma("unroll") for (int n = 0; n < 2; ++n) _Pragma("unroll") for (int k = 0; k < 2; ++k) dst[n][k] = *(const LAS h8*)(lds + PG8_SB(b, h) + boff + n * 2048 + k * 1024); } while (0)
#define PG8_MMA(ai, bj, At, Bt) do { __builtin_amdgcn_s_setprio(1); _Pragma("unroll") for (int m = 0; m < 4; ++m) _Pragma("unroll") for (int n = 0; n < 2; ++n) _Pragma("unroll") for (int k = 0; k < 2; ++k) \
        acc[ai][bj][m][n] = __builtin_amdgcn_mfma_f32_16x16x32_f16(Bt[n][k], At[m][k], acc[ai][bj][m][n], 0, 0, 0); __builtin_amdgcn_s_setprio(0); } while (0)
#define PG8_WAIT_V(n) asm volatile("s_waitcnt vmcnt(" #n ")" ::: "memory")
#define PG8_WAIT_L(n) asm volatile("s_waitcnt lgkmcnt(" #n ")" ::: "memory")
#define PG8_BAR __builtin_amdgcn_s_barrier()
#define PG8_SCHED __builtin_amdgcn_sched_barrier(0)
    Unit cur, nxt; int ui = 0;
    if (!S.next(0, cur)) return;
    f32x4 acc[2][2][4][2];
#pragma unroll
    for (int a = 0; a < 2; ++a)
#pragma unroll
        for (int b = 0; b < 2; ++b)
#pragma unroll
            for (int m = 0; m < 4; ++m)
#pragma unroll
                for (int n = 0; n < 2; ++n) acc[a][b][m][n] = (f32x4){0.f, 0.f, 0.f, 0.f};
    h8 At[4][2], B0[2][2], B1[2][2];
    LAS float* RSTw = (LAS float*)(lds + LDSCTL_OFF + 7168);
    if (g.ss && tid < 256) RSTw[tid] = row_rstd_rt(g.ss, g.nss, cur.pm * BM + tid, g.invn);
    const char* cA = (const char*)g.A + (size_t)cur.pm * tstepA; const char* cB = (const char*)g.Bt + (size_t)cur.pn * tstepB;
    PG8_STAGE(PG8_SB(0, 0), cB, voffB); PG8_STAGE(PG8_SB(0, 1), cB + hstepB, voffB); PG8_STAGE(PG8_SA(0, 0), cA, voffA); PG8_STAGE(PG8_SA(0, 1), cA + hstepA, voffA);
    if (wr == 1) PG8_BAR;
    PG8_WAIT_V(2); PG8_BAR;
    PG8_STAGE(PG8_SB(1, 0), cB + kstep, voffB); PG8_STAGE(PG8_SA(1, 0), cA + kstep, voffA); PG8_STAGE(PG8_SB(1, 1), cB + hstepB + kstep, voffB);
    PG8_WAIT_V(6); PG8_BAR;
    for (;;) {
        const bool has_next = S.next(ui + 1, nxt);
        const char* nA = has_next ? (const char*)g.A + (size_t)nxt.pm * tstepA : cA; const char* nB = has_next ? (const char*)g.Bt + (size_t)nxt.pn * tstepB : cB;
        for (int t = 0; t < nt; t += 2) {
            const bool last = (t == nt - 2);
            const char* a1 = cA + (size_t)(t + 1) * kstep;
            const char* a2 = last ? nA : cA + (size_t)(t + 2) * kstep; const char* b2 = last ? nB : cB + (size_t)(t + 2) * kstep;
            const char* a3 = a2 + kstep; const char* b3 = b2 + kstep;
            PG8_LDB(B0, 0, 0); PG8_LDB(B1, 0, 1); PG8_SCHED; PG8_LDA(At, 0, 0); PG8_STAGE(PG8_SA(1, 1), a1 + hstepA, voffA);
            PG8_WAIT_V(8); PG8_WAIT_L(0); PG8_BAR; PG8_MMA(0, 0, At, B0); PG8_MMA(0, 1, At, B1); PG8_BAR; PG8_SCHED;
            PG8_LDA(At, 0, 1); PG8_STAGE(PG8_SB(0, 0), b2, voffB); PG8_STAGE(PG8_SB(0, 1), b2 + hstepB, voffB); PG8_STAGE(PG8_SA(0, 0), a2, voffA);
            PG8_WAIT_V(8); PG8_WAIT_L(0); PG8_BAR; PG8_MMA(1, 0, At, B0); PG8_MMA(1, 1, At, B1); PG8_BAR; PG8_SCHED;
            PG8_LDB(B0, 1, 0); PG8_LDB(B1, 1, 1); PG8_SCHED; PG8_LDA(At, 1, 0); PG8_STAGE(PG8_SA(0, 1), a2 + hstepA, voffA);
            PG8_WAIT_V(8); PG8_WAIT_L(0); PG8_BAR; PG8_MMA(0, 0, At, B0); PG8_MMA(0, 1, At, B1); PG8_BAR; PG8_SCHED;
            PG8_LDA(At, 1, 1); PG8_STAGE(PG8_SB(1, 0), b3, voffB); PG8_STAGE(PG8_SB(1, 1), b3 + hstepB, voffB); PG8_STAGE(PG8_SA(1, 0), a3, voffA);
            PG8_WAIT_V(8); PG8_WAIT_L(0); PG8_BAR; PG8_MMA(1, 0, At, B0); PG8_MMA(1, 1, At, B1); PG8_BAR; PG8_SCHED;
        }
        if (wr == 0) PG8_BAR;
        epilogue(args, gi, acc, cur, wr, wc, fr, fq, lds, ui & 1);
        if (!has_next) break;
#pragma unroll
        for (int a = 0; a < 2; ++a)
#pragma unroll
            for (int b = 0; b < 2; ++b)
#pragma unroll
                for (int m = 0; m < 4; ++m)
#pragma unroll
                    for (int n = 0; n < 2; ++n) acc[a][b][m][n] = (f32x4){0.f, 0.f, 0.f, 0.f};
        cur = nxt; cA = nA; cB = nB; ++ui;
        if (g.ss && tid < 256) RSTw[(ui & 1) * 256 + tid] = row_rstd_rt(g.ss, g.nss, cur.pm * BM + tid, g.invn);
        if (wr == 1) PG8_BAR;
    }
    PG8_WAIT_V(0);
    PG8_BAR;
#undef PG8_SA
#undef PG8_SB
#undef PG8_STAGE
#undef PG8_LDA
#undef PG8_LDB
#undef PG8_MMA
#undef PG8_WAIT_V
#undef PG8_WAIT_L
#undef PG8_BAR
#undef PG8_SCHED
}
__device__ __forceinline__ void make_gemm(const Args& a, int gi, GemmDesc& g) {
    unsigned char* ws = a.ws; const float* ax = a.x; float* aout = a.out;
    asm volatile("" : "+s"(ws), "+s"(ax), "+s"(aout));
    float* rope = (float*)(ws + WS_ROPE);
    g.M = M; g.ss = nullptr; g.nss = 1; g.invn = 1.f / DM; g.oh = nullptr; g.ldo = 0; g.xin = nullptr; g.xout = nullptr; g.xh = nullptr; g.ssout = nullptr; g.rscale = 1.f;
    g.cos64 = rope; g.sin64 = rope + SEQ * 32; g.cos32 = rope + SEQ * 64; g.sin32 = rope + SEQ * 64 + SEQ * 16;
    g.wi = (float*)(ws + WS_WI); g.ssq = (float*)(ws + WS_SSQ); g.sskv = (float*)(ws + WS_SSKV);
    switch (gi) {
        case G_FFN1A: g.A = (const f16*)(ws + WS_XH); g.Bt = (const f16*)(ws + WS_BT1); g.N = NFF; g.K = DM; g.lda = DM; g.epi = EPI_SWIGLU;
            g.ss = (const float*)(ws + WS_SS0); g.nss = 1; g.oh = (f16*)(ws + WS_H); break;
        case G_FFN1B: g.A = (const f16*)(ws + WS_H); g.Bt = (const f16*)(ws + WS_BTD1); g.N = DM; g.K = DFF; g.lda = DFF; g.epi = EPI_RESID;
            g.xin = nullptr; g.xout = aout; g.xh = (f16*)(ws + WS_XH); g.ssout = (float*)(ws + WS_SS16); g.rscale = 0.5f; break;
        case G_WIN: g.A = (const f16*)(ws + WS_XH); g.Bt = (const f16*)(ws + WS_BTIN); g.N = NP; g.K = DM; g.lda = DM; g.epi = EPI_WIN;
            g.ss = (const float*)(ws + WS_SS16); g.nss = 16; g.oh = (f16*)(ws + WS_P); break;
        case G_QUP: g.A = (const f16*)(ws + WS_P) + PC_CQ; g.Bt = (const f16*)(ws + WS_BTQ); g.N = NQB; g.K = QLORA; g.lda = NPS; g.epi = EPI_QUP;
            g.ss = (const float*)(ws + WS_SSQ); g.nss = 8; g.invn = 1.f / QLORA; g.oh = (f16*)(ws + WS_QB); break;
        case G_KVUP: g.A = (const f16*)(ws + WS_P) + PC_CKV; g.Bt = (const f16*)(ws + WS_BTKV); g.N = NKV; g.K = KVLORA; g.lda = NPS; g.epi = EPI_KVUP;
            g.ss = (const float*)(ws + WS_SSKV); g.nss = 4; g.invn = 1.f / KVLORA; g.oh = (f16*)(ws + WS_KV); break;
        case G_WOUT: g.A = (const f16*)(ws + WS_MIX); g.Bt = (const f16*)(ws + WS_BTOUT); g.N = DM; g.K = DM; g.lda = DM; g.epi = EPI_RESID;
            g.xin = nullptr; g.xout = aout; g.xh = (f16*)(ws + WS_XH); g.ssout = (float*)(ws + WS_SS16); g.rscale = 1.f; break;
        case G_FFN2A: g.A = (const f16*)(ws + WS_XH); g.Bt = (const f16*)(ws + WS_BT2); g.N = NFF; g.K = DM; g.lda = DM; g.epi = EPI_SWIGLU;
            g.ss = (const float*)(ws + WS_SS16); g.nss = 16; g.oh = (f16*)(ws + WS_H); break;
        default: g.A = (const f16*)(ws + WS_H); g.Bt = (const f16*)(ws + WS_BTD2); g.N = DM; g.K = DFF; g.lda = DFF; g.epi = (FUSE_FINAL && gridDim.x == 256) ? EPI_FINAL : EPI_RESID;
            g.xin = nullptr; g.xout = aout; g.xh = (f16*)(ws + WS_XH); g.ssout = (float*)(ws + WS_SS16); g.rscale = 0.5f; break;
    }
}

}

struct Frame {
    LAS unsigned char* lds;
    int tid, lane, wave, vcu, G;
};

__device__ __forceinline__ bool prep_rowmap(const Args& a, int mat, int R, const float*& W, int& col, int& N) {
    using pg8::perm32;
    switch (mat) {
        case 0: case 2: { const int pn_ = R >> 8, rr = R & 255, bj = rr >> 7, wc_ = (rr >> 5) & 3, n = (rr >> 4) & 1, fq_ = (rr >> 2) & 3; col = 128 * pn_ + 32 * wc_ + 8 * fq_ + 4 * bj + (rr & 3); N = DFF;
            W = (mat == 0) ? (n ? a.w1_up : a.w1_gate) : (n ? a.w2_up : a.w2_gate); return true; }
        case 1: W = a.w1_down; col = (R & ~31) + perm32(R & 31); N = DM; return true;
        case 3: W = a.w2_down; col = (R & ~31) + perm32(R & 31); N = DM; return true;
        case 4: { W = a.w_in; N = DPROJ;
            if (R < PC_KR) {
                int base, rr;
                if (R < PC_KA) {
                    if (R < PC_QI) { base = WC_QA; rr = R; } else { base = WC_QI; rr = R - PC_QI; }
                    const int tl = rr >> 8, sl = rr & 255, bj = sl >> 7, wc_ = (sl >> 5) & 3, n = (sl >> 4) & 1, fq_ = (sl >> 2) & 3;
                    col = base + (4 * tl + wc_) * 64 + 32 * n + 8 * fq_ + 4 * bj + (sl & 3); return true; }
                if (R < PC_KI) { base = WC_KA; rr = R - PC_KA; } else { base = WC_KI; rr = R - PC_KI; }
                const int h = rr >> 6, w = rr & 63, g2 = w >> 5, n = (w >> 4) & 1, j = w & 15;
                col = base + h * 64 + 32 * n + 16 * g2 + j; return true; }
            if (R < PC_VA) { col = WC_KR + (R - PC_KR); return true; }
            if (R < PC_WI) { const int rr = R - PC_VA; col = WC_VA + (rr & ~31) + perm32(rr & 31); return true; }
            if (R < PC_WI + 16) { col = WC_WI + (R - PC_WI); return true; }
            if (R < PC_CQ) return false;
            if (R < PC_CQ + QLORA) { const int rr = R - PC_CQ; col = WC_CQ + (rr & ~31) + perm32(rr & 31); return true; }
            if (R < PC_CKV) return false;
            { const int rr = R - PC_CKV; col = WC_CKV + (rr & ~31) + perm32(rr & 31); return true; } }
        case 5: { W = a.w_uq; N = 768;
            if (R < 512) { const int Rp = (R & ~31) + perm32(R & 31); col = (Rp >> 6) * 96 + (Rp & 63); }
            else { const int rr = R - 512; col = (rr >> 5) * 96 + 64 + (rr & 31); }
            return true; }
        case 6: { W = a.w_ukv; N = 1024;
            const int rr = R & 511, Rp = (rr & ~31) + perm32(rr & 31);
            col = (Rp >> 6) * 128 + (R >= 512 ? 64 : 0) + (Rp & 63); return true; }
        default: W = a.w_out; col = (R & ~31) + perm32(R & 31); N = DM; return true;
    }
}
__device__ __forceinline__ float wrnd(float f) {
    if (WBITS >= 10) return f;
    unsigned u = __builtin_bit_cast(unsigned, f); const unsigned sh = 23 - WBITS;
    u += ((1u << (sh - 1)) - 1u) + ((u >> sh) & 1u); u &= ~((1u << sh) - 1u);
    return __builtin_bit_cast(float, u); }
__device__ __forceinline__ void prep_item(const Args& a, int mat, int K, const float* gain, f16* Bt, LAS float* scr, int item, int lane) {
    const int nkb = K / 64, rb = item / nkb, kb = item % nkb, k0 = 64 * kb, R0 = 32 * rb;
    const float* W; int col, N;
    const int cg = lane & 7, kr = lane >> 3;
    const bool valid = prep_rowmap(a, mat, R0 + 4 * cg, W, col, N);
#pragma unroll
    for (int i = 0; i < 8; ++i) { const int kk = 8 * i + kr;
        f32x4 v = (f32x4){0.f, 0.f, 0.f, 0.f};
        if (valid) { v = *(const f32x4*)(W + (size_t)(k0 + kk) * N + col); if (gain) v = v * gain[k0 + kk]; }
        LAS float* d = scr + kk * 33 + 4 * cg; d[0] = v.x; d[1] = v.y; d[2] = v.z; d[3] = v.w; }
    LDS_WAIT(); asm volatile("" ::: "memory");
    const int c = lane & 7;
#pragma unroll
    for (int j = 0; j < 4; ++j) { const int n = (lane >> 3) + 8 * j; const LAS float* s = scr + (8 * c) * 33 + n;
        u32x4 o; o.x = pkh(wrnd(s[0 * 33]), wrnd(s[1 * 33])); o.y = pkh(wrnd(s[2 * 33]), wrnd(s[3 * 33])); o.z = pkh(wrnd(s[4 * 33]), wrnd(s[5 * 33])); o.w = pkh(wrnd(s[6 * 33]), wrnd(s[7 * 33]));
        *(u32x4*)(Bt + (size_t)(R0 + n) * K + k0 + 8 * c) = o; }
    LDS_WAIT(); asm volatile("" ::: "memory");
}
__device__ __forceinline__ void prep_phase(const Args& a, Frame& F) {
    unsigned char* ws = a.ws;
    LAS float* scr = (LAS float*)(F.lds + F.wave * 16384);
    const int gw = F.vcu * NWAVES + F.wave, NGW = F.G * NWAVES;
    constexpr int I0 = 16 * (NFF / 32), I1 = (DFF / 64) * 32, I4 = 16 * (NP / 32), I5 = (QLORA / 64) * (NQB / 32), I6 = (KVLORA / 64) * (NKV / 32), I7 = 16 * 32;
    constexpr int NITEMS = 2 * I0 + 2 * I1 + I4 + I5 + I6 + I7;
    for (int it = gw; it < NITEMS; it += NGW) {
        int r = it;
        if (r < I0) { prep_item(a, 0, DM, a.g_ffn1, (f16*)(ws + WS_BT1), scr, r, F.lane); continue; } r -= I0;
        if (r < I1) { prep_item(a, 1, DFF, nullptr, (f16*)(ws + WS_BTD1), scr, r, F.lane); continue; } r -= I1;
        if (r < I0) { prep_item(a, 2, DM, a.g_ffn2, (f16*)(ws + WS_BT2), scr, r, F.lane); continue; } r -= I0;
        if (r < I1) { prep_item(a, 3, DFF, nullptr, (f16*)(ws + WS_BTD2), scr, r, F.lane); continue; } r -= I1;
        if (r < I4) { prep_item(a, 4, DM, a.g_mix, (f16*)(ws + WS_BTIN), scr, r, F.lane); continue; } r -= I4;
        if (r < I5) { prep_item(a, 5, QLORA, a.g_q_lat, (f16*)(ws + WS_BTQ), scr, r, F.lane); continue; } r -= I5;
        if (r < I6) { prep_item(a, 6, KVLORA, a.g_kv_lat, (f16*)(ws + WS_BTKV), scr, r, F.lane); continue; } r -= I6;
        prep_item(a, 7, DM, nullptr, (f16*)(ws + WS_BTOUT), scr, r, F.lane);
    }
    {
        f16* XH = (f16*)(ws + WS_XH); float* SS0 = (float*)(ws + WS_SS0);
        for (int m = gw; m < M; m += NGW) {
            const f32x4* xr = (const f32x4*)(a.x + (size_t)m * DM) + F.lane;
            f32x4 v[4]; float s = 0.f;
#pragma unroll
            for (int j = 0; j < 4; ++j) { v[j] = xr[64 * j]; s += sq4(v[j]); }
            s = wave_sum(s);
            u32x2* o8 = (u32x2*)(XH + (size_t)m * DM) + F.lane;
#pragma unroll
            for (int j = 0; j < 4; ++j) { u32x2 w; w.x = pkh(v[j].x, v[j].y); w.y = pkh(v[j].z, v[j].w); o8[64 * j] = w; }
            if (F.lane == 0) SS0[m] = s;
        }
    }
    {
        float* c64 = (float*)(ws + WS_ROPE); float* s64 = c64 + SEQ * 32; float* c32 = s64 + SEQ * 32; float* s32 = c32 + SEQ * 16;
        const int gt = (F.vcu * NWAVES + F.wave) * 64 + F.lane, NT = F.G * NWAVES * 64;
        for (int e = gt; e < SEQ * 48; e += NT) {
            const int t = e / 48, j = e % 48;
            const double ex = (j < 32) ? -(double)(2 * j) / 64.0 : -(double)(2 * (j - 32)) / 32.0;
            const double xx = ex * 13.287712379549449;
            const double nf = __builtin_floor(xx), ff = (xx - nf) * 0.69314718055994530942;
            double pe = 1.0 / 1307674368000.0;
#pragma unroll
            for (int kk = 14; kk >= 1; --kk) { double fact = 1.0; for (int q2 = 2; q2 <= kk; ++q2) fact *= (double)q2; pe = pe * ff + 1.0 / fact; }
            pe = pe * ff + 1.0;
            const float inv = (float)__builtin_ldexp(pe, (int)nf);
            const float angf = (float)t * inv;
            const double ang = (double)angf;
            const double kq = __builtin_rint(ang * 0.63661977236758134308);
            double r = __builtin_fma(-kq, 1.57079632679489655800, ang);
            r = __builtin_fma(-kq, 6.12323399573676603587e-17, r);
            const double r2 = r * r;
            double sn = -1.0 / 6227020800.0; sn = sn * r2 + 1.0 / 39916800.0; sn = sn * r2 - 1.0 / 362880.0; sn = sn * r2 + 1.0 / 5040.0; sn = sn * r2 - 1.0 / 120.0; sn = sn * r2 + 1.0 / 6.0; sn = -sn * r2 * r + r;
            double cs = 1.0 / 479001600.0; cs = cs * r2 - 1.0 / 3628800.0; cs = cs * r2 + 1.0 / 40320.0; cs = cs * r2 - 1.0 / 720.0; cs = cs * r2 + 1.0 / 24.0; cs = cs * r2 - 0.5; cs = cs * r2 + 1.0;
            const int q = ((int)kq) & 3;
            const double S = (q == 0) ? sn : (q == 1) ? cs : (q == 2) ? -sn : -cs;
            const double C = (q == 0) ? cs : (q == 1) ? -sn : (q == 2) ? -cs : sn;
            if (j < 32) { c64[t * 32 + j] = (float)C; s64[t * 32 + j] = (float)S; }
            else { c32[t * 16 + (j - 32)] = (float)C; s32[t * 16 + (j - 32)] = (float)S; }
        }
    }
}


namespace att {
constexpr int KSL = 12288, VSL = 8192, SLOT = KSL + VSL;
constexpr int WSF_OFF = 2 * SLOT, OST_OFF = WSF_OFF + 2048, ATT_LDS = OST_OFF + 8 * 4096;
static_assert(ATT_LDS <= RING_BYTES, "attention LDS");
typedef short v4i16_t __attribute__((ext_vector_type(4)));
__device__ __forceinline__ int crow(int r, int hi) { return (r & 3) + 8 * (r >> 2) + 4 * hi; }
__device__ __forceinline__ h4 vtr(const LAS unsigned char* p) { return __builtin_bit_cast(h4, __builtin_amdgcn_ds_read_tr16_b64_v4i16((LAS v4i16_t*)p)); }
__device__ __forceinline__ float hmax2(float a) { return fmaxf(a, __shfl_xor(a, 32)); }
__device__ __forceinline__ float hsum2(float a) { return a + __shfl_xor(a, 32); }
#define ATT_BAR() asm volatile("s_waitcnt vmcnt(0) lgkmcnt(0)\n\ts_barrier" ::: "memory")

template <int MODE>
__device__ __forceinline__ void attn_unit(const Args& a, LAS unsigned char* lds, int b, int h, int q0) {
    constexpr int ND = (MODE == 0) ? 6 : 4;
    constexpr float THR = 8.f;
    unsigned char* ws = a.ws; asm volatile("" : "+s"(ws));
    const f16* P = (const f16*)(ws + WS_P); const f16* QB = (const f16*)(ws + WS_QB); const f16* KV = (const f16*)(ws + WS_KV); f16* MIX = (f16*)(ws + WS_MIX);
    const unsigned* MASK = (const unsigned*)(ws + WS_MASK);
    const int tid = opaque_tid(), lane = tid & 63, r32 = lane & 31, hi = lane >> 5; const int w = __builtin_amdgcn_readfirstlane(tid >> 6);
    const size_t rowbase = (size_t)b * SEQ;
    const int qw = (MODE == 0) ? q0 + 32 * w : q0;
    const int NT = (MODE == 0) ? (q0 + 256) / 64 : (q0 + 32 + 63) / 64;
    LAS float* wsf = (LAS float*)(lds + WSF_OFF) + w * 64;
    auto dma = [&](int t, int s) {
        LAS unsigned char* ks = lds + s * SLOT; LAS unsigned char* vs = ks + KSL;
        const size_t krow = rowbase + 64 * t + lane, vrow = rowbase + 64 * t + 16 * (w & 3) + (lane >> 2);
        if (MODE == 0) {
            __builtin_amdgcn_global_load_lds((const unsigned*)(KV + krow * NKV + h * 64 + 8 * w), (LAS unsigned*)(ks + w * 1024), 16, 0, 0);
            if (w < 4) __builtin_amdgcn_global_load_lds((const unsigned*)(P + krow * NPS + PC_KR + 8 * w), (LAS unsigned*)(ks + (8 + w) * 1024), 16, 0, 0);
            __builtin_amdgcn_global_load_lds((const unsigned*)(KV + vrow * NKV + 512 + h * 64 + (w >> 2) * 32 + (lane & 3) * 8), (LAS unsigned*)(vs + w * 1024), 16, 0, 0);
        } else {
            __builtin_amdgcn_global_load_lds((const unsigned*)(P + krow * NPS + PC_KA + 8 * w), (LAS unsigned*)(ks + w * 1024), 16, 0, 0);
            __builtin_amdgcn_global_load_lds((const unsigned*)(P + vrow * NPS + PC_VA + (w >> 2) * 32 + (lane & 3) * 8), (LAS unsigned*)(vs + w * 1024), 16, 0, 0);
        }
    };
    dma(0, 0);
    h8 qr[ND];
    if (MODE == 0) {
        const f16* qp = QB + (rowbase + qw + r32) * NQB;
#pragma unroll
        for (int d0 = 0; d0 < 4; ++d0) qr[d0] = *(const h8*)(qp + h * 64 + 16 * d0 + 8 * hi);
#pragma unroll
        for (int d0 = 4; d0 < ND; ++d0) qr[d0] = *(const h8*)(qp + 512 + h * 32 + 16 * (d0 - 4) + 8 * hi);
    } else {
        const f16* qp = P + (rowbase + qw + r32) * NPS + PC_QA + w * 64;
#pragma unroll
        for (int d0 = 0; d0 < ND; ++d0) qr[d0] = *(const h8*)(qp + 16 * d0 + 8 * hi);
    }
    const unsigned* mp = MASK + ((rowbase + qw + r32) * 2 + hi) * 64;
    unsigned mw_next = (MODE == 1) ? mp[0] : 0u;
    float mhat = 0.f, lsum = 0.f;
    f32x16 o[2]; o[0] = f32x16{}; o[1] = f32x16{};
    f32x16 negm = f32x16{};
    const int vp0 = ((lane >> 4) & 1) * 32 + (lane & 3) * 8 + (4 * hi + ((lane & 15) >> 2)) * 64;
    for (int t = 0; t < NT; ++t) {
        ATT_BAR();
        if (t + 1 < NT) dma(t + 1, (t + 1) & 1);
        const unsigned mw = mw_next;
        if (MODE == 1 && t + 1 < NT) mw_next = mp[t + 1];
        if (MODE == 1 || 64 * t <= qw + 31) {
            const LAS unsigned char* ks = lds + (t & 1) * SLOT + hi * 1024 + r32 * 16; const LAS unsigned char* vs = lds + (t & 1) * SLOT + KSL + vp0;
            f32x16 p0 = negm, p1 = negm;
#pragma unroll
            for (int d0 = 0; d0 < ND; ++d0) {
                const h8 b0 = *(const LAS h8*)(ks + d0 * 2048), b1 = *(const LAS h8*)(ks + d0 * 2048 + 512);
                p0 = __builtin_amdgcn_mfma_f32_32x32x16_f16(b0, qr[d0], p0, 0, 0, 0);
                p1 = __builtin_amdgcn_mfma_f32_32x32x16_f16(b1, qr[d0], p1, 0, 0, 0);
            }
            if (MODE == 0 && 64 * t + 63 > qw) {
                const int qrow = qw + r32, kb = 64 * t + 4 * hi;
#pragma unroll
                for (int r = 0; r < 16; ++r) { const int kv = kb + (r & 3) + 8 * (r >> 2); if (kv > qrow) p0[r] = -INFINITY; if (kv + 32 > qrow) p1[r] = -INFINITY; }
            }
            float rm = fmaxf(fmaxf(p0[0], p1[0]), fmaxf(p0[1], p1[1]));
#pragma unroll
            for (int r = 2; r < 16; r += 2) rm = fmaxf(fmaxf(rm, p0[r]), fmaxf(p1[r], fmaxf(p0[r + 1], p1[r + 1])));
            rm = hmax2(rm);
            if (t == 0 || __any(rm > THR)) {
                const float dl = (t == 0) ? rm : fmaxf(rm, 0.f), f = (t == 0) ? 1.f : __builtin_amdgcn_exp2f(-dl);
                lsum *= f; mhat += dl;
#pragma unroll
                for (int r = 0; r < 16; ++r) { p0[r] -= dl; p1[r] -= dl; negm[r] = -mhat; }
                if (hi == 0) wsf[r32] = f;
                LDS_WAIT();
#pragma unroll
                for (int r = 0; r < 16; ++r) { const float fr_ = wsf[crow(r, hi)]; o[0][r] *= fr_; o[1][r] *= fr_; }
                LDS_WAIT();
            }
#pragma unroll
            for (int r = 0; r < 16; ++r) { p0[r] = __builtin_amdgcn_exp2f(p0[r]); p1[r] = __builtin_amdgcn_exp2f(p1[r]); }
            if (MODE == 1) {
#pragma unroll
                for (int r = 0; r < 16; ++r) {
                    p0[r] = ((mw >> (15 - r)) & 1u) ? p0[r] : 0.f;
                    p1[r] = ((mw >> (31 - r)) & 1u) ? p1[r] : 0.f;
                }
            }
            float sacc0 = 0.f, sacc1 = 0.f;
#pragma unroll
            for (int r = 0; r < 16; ++r) { sacc0 += p0[r]; sacc1 += p1[r]; }
            lsum += sacc0 + sacc1;
            h8 pa[4];
#pragma unroll
            for (int j = 0; j < 4; ++j) {
                const h2 a0 = __builtin_bit_cast(h2, __builtin_amdgcn_cvt_pkrtz(p0[2 * j], p0[2 * j + 1])), a1 = __builtin_bit_cast(h2, __builtin_amdgcn_cvt_pkrtz(p0[8 + 2 * j], p0[8 + 2 * j + 1]));
                const h2 a2 = __builtin_bit_cast(h2, __builtin_amdgcn_cvt_pkrtz(p1[2 * j], p1[2 * j + 1])), a3 = __builtin_bit_cast(h2, __builtin_amdgcn_cvt_pkrtz(p1[8 + 2 * j], p1[8 + 2 * j + 1]));
                pa[0][2 * j] = a0.x; pa[0][2 * j + 1] = a0.y; pa[1][2 * j] = a1.x; pa[1][2 * j + 1] = a1.y;
                pa[2][2 * j] = a2.x; pa[2][2 * j + 1] = a2.y; pa[3][2 * j] = a3.x; pa[3][2 * j + 1] = a3.y; }
#pragma unroll
            for (int d0 = 0; d0 < 2; ++d0)
#pragma unroll
                for (int k4 = 0; k4 < 4; ++k4) {
                    const h4 lo = vtr(vs + d0 * 4096 + k4 * 1024), hi4 = vtr(vs + d0 * 4096 + k4 * 1024 + 512);
                    const h8 vf = {lo[0], lo[1], lo[2], lo[3], hi4[0], hi4[1], hi4[2], hi4[3]};
                    o[d0] = __builtin_amdgcn_mfma_f32_32x32x16_f16(pa[k4], vf, o[d0], 0, 0, 0);
                }
        }
    }
    lsum = hsum2(lsum);
    if (hi == 0) wsf[32 + r32] = lsum;
    LDS_WAIT();
    float rli[16];
#pragma unroll
    for (int r = 0; r < 16; ++r) { const float lv = wsf[32 + crow(r, hi)]; rli[r] = lv > 0.f ? __builtin_amdgcn_rcpf(lv) : 0.f; }
    if (MK_DEBUG && hi == 0 && !(lsum > 0.f)) atomicAdd((unsigned*)(ws + WS_CTL) + 27, 1u);
    LAS f16* stg = (LAS f16*)(lds + OST_OFF) + w * 2048;
#pragma unroll
    for (int r = 0; r < 16; ++r) { const int orow = crow(r, hi);
#pragma unroll
        for (int d0 = 0; d0 < 2; ++d0) stg[orow * 64 + d0 * 32 + r32] = (f16)(o[d0][r] * rli[r]); }
    LDS_WAIT();
    f16* Ow = MIX + (rowbase + qw) * DM + ((MODE == 0) ? 512 + h * 64 : w * 64);
#pragma unroll
    for (int i = 0; i < 4; ++i) { const int row = i * 8 + (lane >> 3), ch = lane & 7; const u32x4 v = *(const LAS u32x4*)(stg + row * 64 + ch * 8); *(u32x4*)(Ow + (size_t)row * DM + ch * 8) = v; }
    ATT_BAR();
}


constexpr int P_KOFF = 0, P_VOFF = 3 * KSL, P_WSF = P_VOFF + 4 * VSL, P_OST = P_WSF + 2048, P_MSK = P_OST + 8 * 4096, P_LDS = P_MSK + 4 * 256;
static_assert(P_LDS <= RING_BYTES, "pipelined attention LDS");
#define AT_SB() __builtin_amdgcn_sched_barrier(0)
template <int MODE>
__device__ __forceinline__ void attn_unit_p(const Args& a, LAS unsigned char* lds, int b, int h, int q0) {
    constexpr int ND = (MODE == 0) ? 6 : 4, NQK = 2 * ND;
    constexpr float THR = 8.f;
    unsigned char* ws = a.ws; asm volatile("" : "+s"(ws));
    typedef const GAS f16* gp;
    gp P = (gp)(ws + WS_P); gp QB = (gp)(ws + WS_QB); gp KV = (gp)(ws + WS_KV); GAS f16* MIX = (GAS f16*)(ws + WS_MIX);
    const GAS unsigned* MASK = (const GAS unsigned*)(ws + WS_MASK);
    const int tid = opaque_tid(), lane = tid & 63, r32 = lane & 31, hi = lane >> 5; const int w = __builtin_amdgcn_readfirstlane(tid >> 6);
    const size_t rowbase = (size_t)b * SEQ;
    const int qw = (MODE == 0) ? q0 + 32 * w : q0;
    const int NT = (MODE == 0) ? (q0 + 256) / 64 : (q0 + 32 + 63) / 64;
    const int NTw = (MODE == 0) ? (qw + 31) / 64 + 1 : NT;
    LAS float* wsf = (LAS float*)(lds + P_WSF) + w * 64;
    unsigned koff, roff, voff, moff;
    { const int ln = lane;
      if (MODE == 0) { koff = (unsigned)(ln * NKV + 8 * w) * 2u; roff = (unsigned)(ln * NPS + 8 * w) * 2u; voff = (unsigned)((16 * (w & 3) + (ln >> 2)) * NKV + (w >> 2) * 32 + (ln & 3) * 8) * 2u; moff = 0u; }
      else { koff = (unsigned)(ln * NPS + 8 * w) * 2u; roff = 0u; voff = (unsigned)((16 * (w & 3) + (ln >> 2)) * NPS + (w >> 2) * 32 + (ln & 3) * 8) * 2u; moff = (unsigned)((ln & 31) * 2 + (ln >> 5)) * 256u; } }
    auto dma = [&](int t) {
        LAS unsigned char* ks = lds + P_KOFF + (t % 3) * KSL; LAS unsigned char* vs = lds + P_VOFF + (t & 3) * VSL;
        const size_t trow = rowbase + (size_t)(64 * t);
        if (MODE == 0) {
            const GAS unsigned char* kb = (const GAS unsigned char*)(KV + trow * NKV + h * 64);
            const GAS unsigned char* rb = (const GAS unsigned char*)(P + trow * NPS + PC_KR);
            __builtin_amdgcn_global_load_lds((const GAS unsigned*)(kb + koff), (LAS unsigned*)(ks + w * 1024), 16, 0, 0);
            if (w < 4) __builtin_amdgcn_global_load_lds((const GAS unsigned*)(rb + roff), (LAS unsigned*)(ks + (8 + w) * 1024), 16, 0, 0);
            __builtin_amdgcn_global_load_lds((const GAS unsigned*)(kb + 1024 + voff), (LAS unsigned*)(vs + w * 1024), 16, 0, 0);
        } else {
            const GAS unsigned char* kb = (const GAS unsigned char*)(P + trow * NPS + PC_KA);
            const GAS unsigned char* vb = (const GAS unsigned char*)(P + trow * NPS + PC_VA);
            __builtin_amdgcn_global_load_lds((const GAS unsigned*)(kb + koff), (LAS unsigned*)(ks + w * 1024), 16, 0, 0);
            __builtin_amdgcn_global_load_lds((const GAS unsigned*)(vb + voff), (LAS unsigned*)(vs + w * 1024), 16, 0, 0);
            if (w == 0) { const GAS unsigned char* mb = (const GAS unsigned char*)(MASK + (rowbase + qw) * 128 + t);
                __builtin_amdgcn_global_load_lds((const GAS unsigned*)(mb + moff), (LAS unsigned*)(lds + P_MSK + (t & 3) * 256), 4, 0, 0); }
        }
    };
    h8 qr[ND];
    if (MODE == 0) {
        gp qp = QB + (rowbase + qw + r32) * NQB;
#pragma unroll
        for (int d0 = 0; d0 < 4; ++d0) qr[d0] = *(const GAS h8*)(qp + h * 64 + 16 * d0 + 8 * hi);
#pragma unroll
        for (int d0 = 4; d0 < ND; ++d0) qr[d0] = *(const GAS h8*)(qp + 512 + h * 32 + 16 * (d0 - 4) + 8 * hi);
    } else {
        gp qp = P + (rowbase + qw + r32) * NPS + PC_QA + w * 64;
#pragma unroll
        for (int d0 = 0; d0 < ND; ++d0) qr[d0] = *(const GAS h8*)(qp + 16 * d0 + 8 * hi);
    }
    asm volatile("" :: "v"(qr[0]), "v"(qr[ND - 1]));
    dma(0); if (NT > 1) dma(1);
    float mhat = 0.f, lsum = 0.f;
    f32x16 lacc = f32x16{};
    h8 ones8; { unsigned o1 = 0x3C003C00u; asm volatile("" : "+v"(o1)); const u32x4 ov = (u32x4){o1, o1, o1, o1}; ones8 = __builtin_bit_cast(h8, ov); }
    f32x16 o[2]; o[0] = f32x16{}; o[1] = f32x16{};
    f32x16 negm = f32x16{};
    const int kfo = hi * 1024 + r32 * 16;
    const int vfo = ((lane >> 4) & 1) * 32 + (lane & 3) * 8 + (4 * hi + ((lane & 15) >> 2)) * 64;
    bool resc = false;
    f32x16 pA0, pA1, pB0, pB1;
    h4 vlo[7], vhi[7]; u32x4 pw[4];
    unsigned mw = 0u;
#define AT_CMASK(C0, C1, t) do { if (MODE == 0 && 64 * (t) + 63 > qw) { const int qrow = qw + r32, kb = 64 * (t) + 4 * hi; \
        _Pragma("unroll") for (int r = 0; r < 16; ++r) { const int kv = kb + (r & 3) + 8 * (r >> 2); if (kv > qrow) C0[r] = -INFINITY; if (kv + 32 > qrow) C1[r] = -INFINITY; } } } while (0)
#define AT_DECIDE(C0, C1, FIRST) do { float rm = fmaxf(fmaxf(C0[0], C1[0]), fmaxf(C0[1], C1[1])); \
        _Pragma("unroll") for (int r = 2; r < 16; r += 2) rm = fmaxf(fmaxf(rm, C0[r]), fmaxf(C1[r], fmaxf(C0[r + 1], C1[r + 1]))); \
        rm = hmax2(rm); resc = false; \
        if ((FIRST) || __any(rm > THR)) { const float dl = (FIRST) ? rm : fmaxf(rm, 0.f), f = (FIRST) ? 1.f : __builtin_amdgcn_exp2f(-dl); \
            lsum *= f; mhat += dl; \
            _Pragma("unroll") for (int r = 0; r < 16; ++r) { C0[r] -= dl; C1[r] -= dl; negm[r] = -mhat; } \
            if (!(FIRST)) { if (hi == 0) wsf[r32] = f; resc = true; } } } while (0)
#define AT_RESC() do { if (resc) { LDS_WAIT(); _Pragma("unroll") for (int r = 0; r < 16; ++r) { const float fr_ = wsf[crow(r, hi)]; o[0][r] *= fr_; o[1][r] *= fr_; if (MODE == 1) lacc[r] *= fr_; } LDS_WAIT(); } } while (0)
#define AT_EXP4(C, R0) do { _Pragma("unroll") for (int r_ = (R0); r_ < (R0) + 4; ++r_) C[r_] = __builtin_amdgcn_exp2f(C[r_]); } while (0)
#define AT_EXPM4(C, R0, SH) do { float c0_ = C[(R0)], c1_ = C[(R0) + 1], c2_ = C[(R0) + 2], c3_ = C[(R0) + 3]; \
        const unsigned m0_ = (unsigned)((int)(mw << (31 - ((SH) - (R0)))) >> 31), m1_ = (unsigned)((int)(mw << (31 - ((SH) - (R0) - 1))) >> 31), m2_ = (unsigned)((int)(mw << (31 - ((SH) - (R0) - 2))) >> 31), m3_ = (unsigned)((int)(mw << (31 - ((SH) - (R0) - 3))) >> 31); \
        asm volatile("v_exp_f32 %0, %0\n\tv_exp_f32 %1, %1\n\tv_exp_f32 %2, %2\n\tv_exp_f32 %3, %3\n\tv_and_b32 %0, %0, %4\n\tv_and_b32 %1, %1, %5\n\tv_and_b32 %2, %2, %6\n\tv_and_b32 %3, %3, %7" \
            : "+v"(c0_), "+v"(c1_), "+v"(c2_), "+v"(c3_) : "v"(m0_), "v"(m1_), "v"(m2_), "v"(m3_)); \
        C[(R0)] = c0_; C[(R0) + 1] = c1_; C[(R0) + 2] = c2_; C[(R0) + 3] = c3_; } while (0)
#define AT_EX(C, R0, SH) do { if (MODE == 1) AT_EXPM4(C, R0, SH); else AT_EXP4(C, R0); } while (0)
#define AT_MSK4(C, R0, SH) do { } while (0)
#define AT_PK(P, J) __builtin_bit_cast(unsigned, __builtin_amdgcn_cvt_pkrtz(P[J], P[(J) + 1]))
#define AT_VIDX(i) ((((i) & 1) * 4) + ((i) >> 1))
#define AT_VRD(i, vsb) do { vlo[(i) % 7] = vtr((vsb) + (AT_VIDX(i) >> 2) * 4096 + (AT_VIDX(i) & 3) * 1024); vhi[(i) % 7] = vtr((vsb) + (AT_VIDX(i) >> 2) * 4096 + (AT_VIDX(i) & 3) * 1024 + 512); } while (0)
#define AT_VFR(i) ((h8){vlo[(i) % 7][0], vlo[(i) % 7][1], vlo[(i) % 7][2], vlo[(i) % 7][3], vhi[(i) % 7][0], vhi[(i) % 7][1], vhi[(i) % 7][2], vhi[(i) % 7][3]})
#define AT_PAF(k) __builtin_bit_cast(h8, pw[k])
#define AT_FIN(P0, P1, i, vsb) do { \
        if ((i) < 4) { if (MODE == 0) sacc += (P0[4 * (i)] + P0[4 * (i) + 1]) + (P0[4 * (i) + 2] + P0[4 * (i) + 3]); pw[(i) >> 1][2 * ((i) & 1)] = AT_PK(P0, 4 * (i)); pw[(i) >> 1][2 * ((i) & 1) + 1] = AT_PK(P0, 4 * (i) + 2); asm volatile("" : "+v"(sacc)); asm volatile("" : "+v"(pw[(i) >> 1])); } \
        else { if (MODE == 0) sacc += (P1[4 * ((i) - 4)] + P1[4 * ((i) - 4) + 1]) + (P1[4 * ((i) - 4) + 2] + P1[4 * ((i) - 4) + 3]); pw[2 + (((i) - 4) >> 1)][2 * ((i) & 1)] = AT_PK(P1, 4 * ((i) - 4)); pw[2 + (((i) - 4) >> 1)][2 * ((i) & 1) + 1] = AT_PK(P1, 4 * ((i) - 4) + 2); asm volatile("" : "+v"(sacc)); asm volatile("" : "+v"(pw[2 + (((i) - 4) >> 1)])); } } while (0)
#define AT_KRD(j, ksb) (*(const LAS h8*)((ksb) + ((j) >> 1) * 2048 + ((j) & 1) * 512))
#define AT_QKSLOT(C0, C1, P0, P1, j, ksb, vsb, FIN) do { \
        if ((j) + 4 < NQK) kfr[((j) + 4) % 5] = AT_KRD((j) + 4, ksb); \
        AT_SB(); \
        if (((j) & 1) == 0) C0 = __builtin_amdgcn_mfma_f32_32x32x16_f16(kfr[(j) % 5], qr[(j) >> 1], ((j) < 2) ? negm : C0, 0, 0, 0); \
        else C1 = __builtin_amdgcn_mfma_f32_32x32x16_f16(kfr[(j) % 5], qr[(j) >> 1], ((j) < 2) ? negm : C1, 0, 0, 0); \
        AT_SB(); \
        if ((FIN) && (j) < 8) AT_FIN(P0, P1, ((j) & 7), vsb); \
        AT_SB(); } while (0)
#define AT_QK(C0, C1, P0, P1, ksb, vsb, FIN) do { h8 kfr[5]; kfr[0] = AT_KRD(0, ksb); kfr[1] = AT_KRD(1, ksb); kfr[2] = AT_KRD(2, ksb); kfr[3] = AT_KRD(3, ksb); AT_SB(); \
        AT_QKSLOT(C0, C1, P0, P1, 0, ksb, vsb, FIN); AT_QKSLOT(C0, C1, P0, P1, 1, ksb, vsb, FIN); AT_QKSLOT(C0, C1, P0, P1, 2, ksb, vsb, FIN); AT_QKSLOT(C0, C1, P0, P1, 3, ksb, vsb, FIN); \
        AT_QKSLOT(C0, C1, P0, P1, 4, ksb, vsb, FIN); AT_QKSLOT(C0, C1, P0, P1, 5, ksb, vsb, FIN); AT_QKSLOT(C0, C1, P0, P1, 6, ksb, vsb, FIN); AT_QKSLOT(C0, C1, P0, P1, 7, ksb, vsb, FIN); \
        if (NQK > 8) { AT_QKSLOT(C0, C1, P0, P1, 8, ksb, vsb, FIN); AT_QKSLOT(C0, C1, P0, P1, 9, ksb, vsb, FIN); AT_QKSLOT(C0, C1, P0, P1, 10, ksb, vsb, FIN); AT_QKSLOT(C0, C1, P0, P1, 11, ksb, vsb, FIN); } } while (0)
#define AT_PVSLOT(C0, C1, i, DOEXP, vsb) do { o[(i) & 1] = __builtin_amdgcn_mfma_f32_32x32x16_f16(AT_PAF((i) >> 1), AT_VFR(i), o[(i) & 1], 0, 0, 0); \
        if (MODE == 1 && ((i) & 1) == 0) lacc = __builtin_amdgcn_mfma_f32_32x32x16_f16(AT_PAF((i) >> 1), ones8, lacc, 0, 0, 0); AT_SB(); \
        if ((i) + 6 < 8) AT_VRD(((i) + 6) & 7, vsb); \
        if (DOEXP) { if ((i) < 4) { AT_EX(C0, 4 * (i), 15); asm volatile("" : "+v"(C0)); } else { AT_EX(C1, 4 * ((i) - 4), 31); asm volatile("" : "+v"(C1)); } } \
        AT_SB(); } while (0)
#define AT_PV(C0, C1, DOEXP, vsb) do { AT_VRD(0, vsb); AT_VRD(1, vsb); AT_VRD(2, vsb); AT_VRD(3, vsb); AT_VRD(4, vsb); AT_VRD(5, vsb); AT_SB(); AT_PVSLOT(C0, C1, 0, DOEXP, vsb); AT_PVSLOT(C0, C1, 1, DOEXP, vsb); AT_PVSLOT(C0, C1, 2, DOEXP, vsb); AT_PVSLOT(C0, C1, 3, DOEXP, vsb); \
        AT_PVSLOT(C0, C1, 4, DOEXP, vsb); AT_PVSLOT(C0, C1, 5, DOEXP, vsb); AT_PVSLOT(C0, C1, 6, DOEXP, vsb); AT_PVSLOT(C0, C1, 7, DOEXP, vsb); } while (0)
#define AT_STEP(C0, C1, P0, P1, t) do { \
        const LAS unsigned char* ksb_ = lds + P_KOFF + ((t) % 3) * KSL + kfo; const LAS unsigned char* vsb_ = lds + P_VOFF + (((t) - 1) & 3) * VSL + vfo; \
        if (MODE == 1) mw = *(const LAS unsigned*)(lds + P_MSK + ((t) & 3) * 256 + lane * 4); \
        float sacc = 0.f; \
        AT_QK(C0, C1, P0, P1, ksb_, vsb_, true); \
        lsum += sacc; \
        AT_CMASK(C0, C1, t); \
        AT_DECIDE(C0, C1, false); AT_SB(); \
        AT_PV(C0, C1, true, vsb_); \
        AT_RESC(); } while (0)
#define AT_DRAIN(P0, P1, t) do { const LAS unsigned char* vsb_ = lds + P_VOFF + (((t) - 1) & 3) * VSL + vfo; float sacc = 0.f; \
        AT_FIN(P0, P1, 0, vsb_); AT_FIN(P0, P1, 1, vsb_); AT_FIN(P0, P1, 2, vsb_); AT_FIN(P0, P1, 3, vsb_); AT_FIN(P0, P1, 4, vsb_); AT_FIN(P0, P1, 5, vsb_); AT_FIN(P0, P1, 6, vsb_); AT_FIN(P0, P1, 7, vsb_); \
        lsum += sacc; AT_SB(); AT_PV(P0, P1, false, vsb_); } while (0)

    const bool w3 = (MODE == 0) ? (w < 4) : (w == 0);
#define AT_WAITBAR(NEWER) do { if (NEWER) { if (w3) asm volatile("s_waitcnt vmcnt(3) lgkmcnt(0)\n\ts_barrier" ::: "memory"); else asm volatile("s_waitcnt vmcnt(2) lgkmcnt(0)\n\ts_barrier" ::: "memory"); } \
        else asm volatile("s_waitcnt vmcnt(0) lgkmcnt(0)\n\ts_barrier" ::: "memory"); } while (0)
    AT_WAITBAR(NT > 1);
    if (NT > 2) dma(2);
    {
        const LAS unsigned char* ksb_ = lds + P_KOFF + kfo; const LAS unsigned char* vsb_ = lds + P_VOFF + vfo;
        if (MODE == 1) mw = *(const LAS unsigned*)(lds + P_MSK + lane * 4);
        float sacc = 0.f;
        AT_QK(pA0, pA1, pA0, pA1, ksb_, vsb_, false);
        (void)sacc;
        AT_CMASK(pA0, pA1, 0);
        AT_DECIDE(pA0, pA1, true);
#pragma unroll
        for (int i = 0; i < 4; ++i) { AT_EX(pA0, 4 * i, 15); AT_EX(pA1, 4 * i, 31); }
    }
    AT_WAITBAR(NT > 2);
    int t = 1; bool lastB = false;
    for (; t + 1 < NTw; t += 2) {
        if (t + 2 < NT) dma(t + 2);
        AT_STEP(pB0, pB1, pA0, pA1, t);
        AT_WAITBAR(t + 2 < NT);
        if (t + 3 < NT) dma(t + 3);
        AT_STEP(pA0, pA1, pB0, pB1, t + 1);
        AT_WAITBAR(t + 3 < NT);
    }
    if (t < NTw) {
        if (t + 2 < NT) dma(t + 2);
        AT_STEP(pB0, pB1, pA0, pA1, t);
        AT_WAITBAR(t + 2 < NT);
        ++t; lastB = true;
    }
    if (lastB) { AT_DRAIN(pB0, pB1, t); } else { AT_DRAIN(pA0, pA1, t); }
    for (; t < NT; ++t) { if (t + 2 < NT) dma(t + 2); AT_WAITBAR(t + 2 < NT); }
    float rli[16];
    if (MODE == 0) {
        lsum = hsum2(lsum);
        if (hi == 0) wsf[32 + r32] = lsum;
        LDS_WAIT();
#pragma unroll
        for (int r = 0; r < 16; ++r) { const float lv = wsf[32 + crow(r, hi)]; rli[r] = lv > 0.f ? __builtin_amdgcn_rcpf(lv) : 0.f; }
    } else {
#pragma unroll
        for (int r = 0; r < 16; ++r) { const float lv = lacc[r]; rli[r] = lv > 0.f ? __builtin_amdgcn_rcpf(lv) : 0.f; }
    }
    LAS f16* stg = (LAS f16*)(lds + P_OST) + w * 2048;
#pragma unroll
    for (int r = 0; r < 16; ++r) { const int orow = crow(r, hi);
#pragma unroll
        for (int d0 = 0; d0 < 2; ++d0) stg[orow * 64 + d0 * 32 + r32] = (f16)(o[d0][r] * rli[r]); }
    LDS_WAIT();
    GAS f16* Ow = MIX + (rowbase + qw) * DM + ((MODE == 0) ? 512 + h * 64 : w * 64);
#pragma unroll
    for (int i = 0; i < 4; ++i) { const int row = i * 8 + (lane >> 3), ch = lane & 7; const u32x4 v = *(const LAS u32x4*)(stg + row * 64 + ch * 8); *(GAS u32x4*)(Ow + (size_t)row * DM + ch * 8) = v; }
    ATT_BAR();
}

#ifndef ATT_PIPE
#define ATT_PIPE 1
#endif
template <int MODE> __device__ __forceinline__ void attn_phase(const Args& a, Frame& F) {
    for (int k = F.vcu; k < 1024; k += F.G) {
        const int i = k >> 8, c = k & 255;
        if (MODE == 0) { const int bh = c >> 2, j = c & 3; const int qb = (i == 0) ? j : (i == 1) ? 7 - j : (i == 2) ? 8 + j : 15 - j;
            if (ATT_PIPE) attn_unit_p<0>(a, F.lds, bh >> 3, bh & 7, qb * 256); else attn_unit<0>(a, F.lds, bh >> 3, bh & 7, qb * 256); }
        else { const int b = c >> 5, j = c & 31; const int u = (i == 0) ? j : (i == 1) ? 63 - j : (i == 2) ? 64 + j : 127 - j;
            if (ATT_PIPE) attn_unit_p<1>(a, F.lds, b, 0, u * 32); else attn_unit<1>(a, F.lds, b, 0, u * 32); }
    }
}
}


namespace idx {
constexpr int QL_OFF = 0;
constexpr int HIST_OFF = 69632;
constexpr int SEL_OFF = HIST_OFF, CAND_OFF = HIST_OFF + 16384;
constexpr int NH_OFF = 102400;
constexpr int QP_OFF = 104448;
constexpr int WSC_OFF = 105472;
constexpr int NCAP = 512;
static_assert(WSC_OFF + 8 * 3072 <= RING_BYTES, "indexer LDS");
constexpr float IDX_SCALE = 0.03125f;
using att::crow;
#define IDX_BAR() asm volatile("s_waitcnt vmcnt(0) lgkmcnt(0)\n\ts_barrier" ::: "memory")
__device__ __forceinline__ unsigned ordu(float f) { const unsigned u = __builtin_bit_cast(unsigned, f); return (u & 0x80000000u) ? ~u : (u | 0x80000000u); }

#define IDX_CHAIN(X, KT) do { X = __builtin_amdgcn_mfma_f32_32x32x16_f16(kf[KT][0], qf[0], zero16, 0, 0, 0); X = __builtin_amdgcn_mfma_f32_32x32x16_f16(kf[KT][1], qf[1], X, 0, 0, 0); \
        X = __builtin_amdgcn_mfma_f32_32x32x16_f16(kf[KT][2], qf[2], X, 0, 0, 0); X = __builtin_amdgcn_mfma_f32_32x32x16_f16(kf[KT][3], qf[3], X, 0, 0, 0); } while (0)
#define IDX_FMA4(XV, KTV, W, R0) do { _Pragma("unroll") for (int r_ = (R0); r_ < (R0) + 4; ++r_) { float t_ = __builtin_fmaf(__builtin_fabsf(XV[r_]), W, acc[KTV][r_]); asm("" : "+v"(t_)); acc[KTV][r_] = t_; } } while (0)
#define IDX_SLOT(XD, KT, KS, XV, KTV, W, R0, EXTRA) do { XD = __builtin_amdgcn_mfma_f32_32x32x16_f16(kf[KT][KS], qf[KS], XD, 0, 0, 0); __builtin_amdgcn_sched_barrier(0); EXTRA; IDX_FMA4(XV, KTV, W, R0); __builtin_amdgcn_sched_barrier(0); } while (0)
typedef const GAS f16* gf16p;
__device__ __forceinline__ void load_kf(h8 (&kf)[4][4], gf16p Pk, int r32, int hi) {
#pragma unroll
    for (int kt = 0; kt < 4; ++kt)
#pragma unroll
        for (int ks = 0; ks < 4; ++ks) kf[kt][ks] = *(const GAS h8*)(Pk + (size_t)(32 * kt + r32) * NPS + 16 * ks + 8 * hi);
}
__device__ __forceinline__ void chunk_scores(const h8 (&kf)[4][4], const LAS unsigned char* QL, const LAS float* WH, int r32, int hi, f32x16 (&acc)[4]) {
    const LAS unsigned char* qb = QL + (hi * 32 + r32) * 16;
    const f32x16 zero16 = f32x16{};
    {
        h8 qf[4];
#pragma unroll
        for (int ks = 0; ks < 4; ++ks) qf[ks] = *(const LAS h8*)(qb + (16 * 8 + 2 * ks) * 512);
#pragma unroll
        for (int kt = 0; kt < 4; ++kt) IDX_CHAIN(acc[kt], kt);
    }
    f32x16 x0 = zero16, x1 = zero16, x2 = zero16, x3 = zero16; float wprev = 0.f;
    h8 qf[4];
#pragma unroll
    for (int ks = 0; ks < 4; ++ks) qf[ks] = *(const LAS h8*)(qb + (2 * ks) * 512);
    float wv = WH[r32];
#pragma unroll 1
    for (int h = 0; h < 16; ++h) {
        const LAS unsigned char* qn = qb + ((h + 1) * 8) * 512;
        float wnext;
        x0 = zero16; __builtin_amdgcn_sched_barrier(0);
        IDX_SLOT(x0, 0, 0, x2, 2, wprev, 8, (void)0);
        IDX_SLOT(x0, 0, 1, x2, 2, wprev, 12, (void)0);
        IDX_SLOT(x0, 0, 2, x3, 3, wprev, 0, (void)0);
        IDX_SLOT(x0, 0, 3, x3, 3, wprev, 4, x1 = zero16);
        IDX_SLOT(x1, 1, 0, x3, 3, wprev, 8, (void)0);
        IDX_SLOT(x1, 1, 1, x3, 3, wprev, 12, (void)0);
        IDX_SLOT(x1, 1, 2, x0, 0, wv, 0, (void)0);
        IDX_SLOT(x1, 1, 3, x0, 0, wv, 4, x2 = zero16);
        IDX_SLOT(x2, 2, 0, x0, 0, wv, 8, (void)0);
        IDX_SLOT(x2, 2, 1, x0, 0, wv, 12, (void)0);
        IDX_SLOT(x2, 2, 2, x1, 1, wv, 0, (void)0);
        IDX_SLOT(x2, 2, 3, x1, 1, wv, 4, x3 = zero16);
        IDX_SLOT(x3, 3, 0, x1, 1, wv, 8, qf[0] = *(const LAS h8*)(qn));
        IDX_SLOT(x3, 3, 1, x1, 1, wv, 12, qf[1] = *(const LAS h8*)(qn + 1024));
        IDX_SLOT(x3, 3, 2, x2, 2, wv, 0, qf[2] = *(const LAS h8*)(qn + 2048));
        IDX_SLOT(x3, 3, 3, x2, 2, wv, 4, qf[3] = *(const LAS h8*)(qn + 3072); wnext = WH[((h + 1) & 15) * 32 + r32]);
        wprev = wv; wv = wnext;
    }
    IDX_FMA4(x2, 2, wprev, 8); IDX_FMA4(x2, 2, wprev, 12); IDX_FMA4(x3, 3, wprev, 0); IDX_FMA4(x3, 3, wprev, 4); IDX_FMA4(x3, 3, wprev, 8); IDX_FMA4(x3, 3, wprev, 12);
}

__device__ __forceinline__ void idx_unit(const Args& a, LAS unsigned char* lds, int b, int u, int uslot) {
    unsigned char* ws = a.ws; asm volatile("" : "+s"(ws));
    gf16p P = (gf16p)(ws + WS_P); const GAS float* WI = (const GAS float*)(ws + WS_WI); GAS unsigned* MASK = (GAS unsigned*)(ws + WS_MASK);
    const int tid = opaque_tid(), lane = tid & 63, r32 = lane & 31, hi = lane >> 5; const int w = __builtin_amdgcn_readfirstlane(tid >> 6);
    const size_t rowbase = (size_t)b * SEQ; const int q0 = 32 * u, nch = (u >> 2) + 1; const bool selneeded = (u >= 8);
    LAS unsigned char* QL = lds + QL_OFF; LAS unsigned* HIST = (LAS unsigned*)(lds + HIST_OFF); LAS unsigned* SEL = (LAS unsigned*)(lds + SEL_OFF); LAS unsigned* CAND = (LAS unsigned*)(lds + CAND_OFF);
    LAS float* NH = (LAS float*)(lds + NH_OFF); LAS float* QP = (LAS float*)(lds + QP_OFF);
#pragma unroll
    for (int i = 0; i < 8; ++i) { const int p = w * 8 + i, hh = p >> 2, c = 2 * (p & 3) + (lane >> 5);
        __builtin_amdgcn_global_load_lds((const GAS unsigned*)(P + (rowbase + q0 + r32) * NPS + PC_QI + hh * 64 + c * 8), (LAS unsigned*)(QL + p * 1024), 16, 0, 0); }
#pragma unroll
    for (int i = 0; i < 4; ++i) *(LAS u32x4*)(lds + HIST_OFF + (i * 512 + tid) * 16) = (u32x4){0u, 0u, 0u, 0u};
    const int tq = tid & 31, th = tid >> 5;
    f32x4 wq[4];
#pragma unroll
    for (int j = 0; j < 4; ++j) wq[j] = *(const GAS f32x4*)(WI + (rowbase + q0 + tq) * 16 + 4 * j);
    IDX_BAR();
    { float s = 0.f;
#pragma unroll
        for (int c = 0; c < 8; ++c) { const h8 v = *(const LAS h8*)(QL + ((th * 8 + c) * 32 + tq) * 16);
#pragma unroll
            for (int j = 0; j < 8; ++j) { const float f = (float)v[j]; s += f * f; } }
        NH[th * 32 + tq] = __builtin_sqrtf(s); }
    IDX_BAR();
    if (tid < 32) { float s1 = 0.f, s2 = 0.f;
#pragma unroll
        for (int hh = 0; hh < 16; ++hh) { const float wv = wq[hh >> 2][hh & 3] * IDX_SCALE, n = NH[hh * 32 + tq]; s1 += wv * n; s2 += wv * wv * n * n; }
        const float mu = 0.3989423f * s1, sg = fmaxf(0.5838f * __builtin_sqrtf(s2), 1e-20f);
        const float invw = 25.6f / sg, lo = mu - 5.f * sg;
        QP[tq * 8 + 0] = invw; QP[tq * 8 + 1] = -lo * invw;
    }
    { const int c = th >> 1, hf = th & 1; float a0 = 0.f, a1 = 0.f, a2 = 0.f, a3 = 0.f;
#pragma unroll
        for (int hh = 0; hh < 16; ++hh) { const float wv = 0.5f * IDX_SCALE * wq[hh >> 2][hh & 3]; const h4 v = *(const LAS h4*)(QL + ((hh * 8 + c) * 32 + tq) * 16 + 8 * hf);
            a0 += wv * (float)v[0]; a1 += wv * (float)v[1]; a2 += wv * (float)v[2]; a3 += wv * (float)v[3]; }
        u32x2 o; o.x = pkh(a0, a1); o.y = pkh(a2, a3);
        *(LAS u32x2*)(QL + ((16 * 8 + c) * 32 + tq) * 16 + 8 * hf) = o; }
    IDX_BAR();
    { float wsel = wq[0][0];
#pragma unroll
        for (int hh = 1; hh < 16; ++hh) wsel = (th == hh) ? wq[hh >> 2][hh & 3] : wsel;
        NH[th * 32 + tq] = 0.5f * IDX_SCALE * wsel; }
    IDX_BAR();
    const LAS float* WH = NH;
    const float invw = QP[r32 * 8 + 0], yoff = QP[r32 * 8 + 1];
    unsigned cm16 = 0u;
#pragma unroll
    for (int r = 0; r < 16; ++r) cm16 |= (crow(r, hi) <= r32) ? (1u << (15 - r)) : 0u;
    const int du = u & 3;
    gf16p Pki = P + rowbase * NPS + PC_KI;
    GAS u32x4* binbuf = (GAS u32x4*)(ws + WS_MIX + (size_t)((gridDim.x % 8 == 0) ? (blockIdx.x % 8) * (gridDim.x / 8) + blockIdx.x / 8 : blockIdx.x) * 262144 + (size_t)(uslot & 1) * 131072);
    if (selneeded) {
        h8 kf[4][4];
        if (w < nch) load_kf(kf, Pki + (size_t)(128 * w) * NPS, r32, hi);
        const float a1 = invw * (1.f / 256.f), b1 = yoff * (1.f / 256.f);
        const unsigned hbase = (unsigned)(size_t)(lds + HIST_OFF) + 4u * (unsigned)r32 - 0x80000000u;
        for (int c = w; c < nch; c += 8) {
            f32x16 acc[4];
            chunk_scores(kf, QL, WH, r32, hi, acc);
            if (c + 8 < nch) load_kf(kf, Pki + (size_t)(128 * (c + 8)) * NPS, r32, hi);
            const bool last = (c == nch - 1);
#define IDX_BINZ(R) float y01_; asm("v_fma_f32 %0, %1, %2, %3 clamp" : "=v"(y01_) : "v"(acc[kt][R]), "v"(a1), "v"(b1)); \
                    const unsigned zi_ = __builtin_bit_cast(unsigned, __builtin_fmaf(y01_, 255.f, 8388608.f)); \
                    if (((R) & 3) == 0) pk[(R) >> 2] = zi_ & 255u; else pk[(R) >> 2] |= zi_ << (8 * ((R) & 3));
#pragma unroll
            for (int kt = 0; kt < 4; ++kt) {
                const int full = !last ? 1 : (kt < du ? 1 : 0);
                u32x4 pk;
                if (full) {
#pragma unroll
                    for (int r = 0; r < 16; ++r) { IDX_BINZ(r)
                        __hip_atomic_fetch_add((LAS unsigned*)(size_t)((zi_ << 7) + hbase), 1u, __ATOMIC_RELAXED, __HIP_MEMORY_SCOPE_WORKGROUP); }
                } else {
                    const unsigned fld = (kt == du) ? cm16 : 0u;
#pragma unroll
                    for (int r = 0; r < 16; ++r) { IDX_BINZ(r)
                        if ((fld >> (15 - r)) & 1u) __hip_atomic_fetch_add((LAS unsigned*)(size_t)((zi_ << 7) + hbase), 1u, __ATOMIC_RELAXED, __HIP_MEMORY_SCOPE_WORKGROUP); }
                }
                binbuf[(c * 64 + lane) * 4 + kt] = pk;
            }
        }
        IDX_BAR();
        { unsigned v[4][4], sm[4], I[4];
#pragma unroll
            for (int i = 0; i < 4; ++i) {
#pragma unroll
                for (int k = 0; k < 4; ++k) v[i][k] = HIST[(4 * lane + k) * 32 + 4 * w + i];
                sm[i] = v[i][0] + v[i][1] + v[i][2] + v[i][3]; I[i] = sm[i]; }
#pragma unroll
            for (int d = 1; d < 64; d <<= 1) {
#pragma unroll
                for (int i = 0; i < 4; ++i) { const unsigned t = __shfl_down(I[i], d); if (lane + d < 64) I[i] += t; } }
#pragma unroll
            for (int i = 0; i < 4; ++i) { const int q = 4 * w + i; const unsigned E = I[i] - sm[i];
                if (E < 256u && I[i] >= 256u) { unsigned cum = E; int bst = 4 * lane; unsigned nab = E; bool found = false;
#pragma unroll
                    for (int k = 3; k >= 0; --k) { if (!found && cum + v[i][k] >= 256u) { bst = 4 * lane + k; nab = cum; found = true; } cum += v[i][k]; }
                    QP[q * 8 + 2] = (float)bst; QP[q * 8 + 4] = (float)(256 - (int)nab); } }
        }
        IDX_BAR();
#pragma unroll
        for (int i = 0; i < 4; ++i) *(LAS u32x4*)(lds + HIST_OFF + (i * 512 + tid) * 16) = (u32x4){0u, 0u, 0u, 0u};
        IDX_BAR();
    }
    if (selneeded) {
        const int bst = (int)QP[r32 * 8 + 2];
        for (int c = w; c < nch; c += 8) {
            u32x4 pk[4];
#pragma unroll
            for (int kt = 0; kt < 4; ++kt) pk[kt] = binbuf[(c * 64 + lane) * 4 + kt];
            const bool last = (c == nch - 1);
#pragma unroll
            for (int jp = 0; jp < 2; ++jp) {
                unsigned selw = 0u, gew = 0u;
#pragma unroll
                for (int r = 0; r < 16; ++r) { const int bin = (int)((pk[2 * jp + 1][r >> 2] >> (8 * (r & 3))) & 255u);
                    selw = __builtin_amdgcn_alignbit(selw, (unsigned)(bst - bin), 31); gew = __builtin_amdgcn_alignbit(gew, (unsigned)(bst - 1 - bin), 31); }
#pragma unroll
                for (int r = 0; r < 16; ++r) { const int bin = (int)((pk[2 * jp][r >> 2] >> (8 * (r & 3))) & 255u);
                    selw = __builtin_amdgcn_alignbit(selw, (unsigned)(bst - bin), 31); gew = __builtin_amdgcn_alignbit(gew, (unsigned)(bst - 1 - bin), 31); }
                unsigned sel = selw, cand = gew & ~selw;
                if (last) { const int k0 = 2 * jp, k1 = 2 * jp + 1;
                    const unsigned f0 = k0 < du ? 0xFFFFu : (k0 == du ? cm16 : 0u), f1 = k1 < du ? 0xFFFFu : (k1 == du ? cm16 : 0u);
                    const unsigned cmw = f0 | (f1 << 16); sel &= cmw; cand &= cmw; }
                SEL[(r32 * 2 + hi) * 64 + 2 * c + jp] = sel; CAND[(r32 * 2 + hi) * 64 + 2 * c + jp] = cand;
            }
        }
    } else {
#pragma unroll
        for (int i = 0; i < 8; ++i) { const int widx = i * 512 + tid, q = widx >> 7, h2 = (widx >> 6) & 1, jj = widx & 63;
            unsigned cmq = 0u;
#pragma unroll
            for (int r = 0; r < 16; ++r) cmq |= (crow(r, h2) <= q) ? (1u << (15 - r)) : 0u;
            const int t0 = 2 * jj, t1 = 2 * jj + 1;
            const unsigned f0 = t0 < u ? 0xFFFFu : (t0 == u ? cmq : 0u), f1 = t1 < u ? 0xFFFFu : (t1 == u ? cmq : 0u);
            SEL[widx] = f0 | (f1 << 16); }
    }
    IDX_BAR();
    if (selneeded) {
        LAS u16* list = (LAS u16*)(lds + WSC_OFF + w * 3072); LAS float* scs = (LAS float*)(lds + WSC_OFF + w * 3072 + 1024);
        const int head = lane & 15, fq = lane >> 4;
        int need[4], n[4], off[4]; unsigned w0[4], w1[4];
#pragma unroll
        for (int i = 0; i < 4; ++i) { const int q = 4 * w + i; need[i] = (int)QP[q * 8 + 4]; w0[i] = CAND[(q * 2 + 0) * 64 + lane]; w1[i] = CAND[(q * 2 + 1) * 64 + lane];
            off[i] = __builtin_popcount(w0[i]) + __builtin_popcount(w1[i]); n[i] = off[i]; }
#pragma unroll
        for (int d = 1; d < 64; d <<= 1) {
#pragma unroll
            for (int i = 0; i < 4; ++i) { const int t = __shfl_up(n[i], d); if (lane >= d) n[i] += t; } }
#pragma unroll
        for (int i = 0; i < 4; ++i) { off[i] = n[i] - off[i]; n[i] = __builtin_amdgcn_readlane(n[i], 63); }
        const bool fast = (n[0] <= 64) && (n[1] <= 64) && (n[2] <= 64) && (n[3] <= 64);
        if (fast) {
#pragma unroll
            for (int i = 0; i < 4; ++i) { int pos = off[i];
                for (unsigned tmp = w0[i]; tmp; tmp &= tmp - 1) { const int be = __builtin_ctz(tmp); list[i * 64 + pos] = (u16)(64 * lane + 32 * (be >> 4) + crow(15 - (be & 15), 0)); ++pos; }
                for (unsigned tmp = w1[i]; tmp; tmp &= tmp - 1) { const int be = __builtin_ctz(tmp); list[i * 64 + pos] = (u16)(64 * lane + 32 * (be >> 4) + crow(15 - (be & 15), 1)); ++pos; } }
            LDS_WAIT(); asm volatile("" ::: "memory");
            float sc[4] = {0.f, 0.f, 0.f, 0.f}; int mykey[4];
#pragma unroll
            for (int i = 0; i < 4; ++i) { const int li = lane < n[i] ? lane : (n[i] > 0 ? n[i] - 1 : 0); mykey[i] = list[i * 64 + li]; }
#pragma unroll
            for (int p = 0; p < 2; ++p) {
                const int nm = n[2 * p] > n[2 * p + 1] ? n[2 * p] : n[2 * p + 1]; const int gmax = (nm + 15) >> 4;
                h8 aq[2][2]; f32x4 wv4[2]; h8 bk[2][4][2];
#pragma unroll
                for (int ii = 0; ii < 2; ++ii) { const int i = 2 * p + ii, q = 4 * w + i;
#pragma unroll
                    for (int ks = 0; ks < 2; ++ks) aq[ii][ks] = *(const LAS h8*)(QL + ((head * 8 + 4 * ks + fq) * 32 + q) * 16);
                    wv4[ii] = *(const GAS f32x4*)(WI + (rowbase + q0 + q) * 16 + 4 * fq); wv4[ii] = wv4[ii] * IDX_SCALE;
#pragma unroll
                    for (int g = 0; g < 4; ++g) if (g < gmax) { const int ci = 16 * g + head; const int li = ci < n[i] ? ci : (n[i] > 0 ? n[i] - 1 : 0); const int key = list[i * 64 + li];
                        gf16p kp = Pki + (size_t)key * NPS + 8 * fq; bk[ii][g][0] = *(const GAS h8*)kp; bk[ii][g][1] = *(const GAS h8*)(kp + 32); } }
#pragma unroll
                for (int ii = 0; ii < 2; ++ii) { const int i = 2 * p + ii;
#pragma unroll
                    for (int g = 0; g < 4; ++g) if (g < gmax) {
                        f32x4 x = __builtin_amdgcn_mfma_f32_16x16x32_f16(aq[ii][0], bk[ii][g][0], (f32x4){0.f, 0.f, 0.f, 0.f}, 0, 0, 0);
                        x = __builtin_amdgcn_mfma_f32_16x16x32_f16(aq[ii][1], bk[ii][g][1], x, 0, 0, 0);
                        float sv = wv4[ii].x * fmaxf(x.x, 0.f) + wv4[ii].y * fmaxf(x.y, 0.f) + wv4[ii].z * fmaxf(x.z, 0.f) + wv4[ii].w * fmaxf(x.w, 0.f);
                        sv += __shfl_xor(sv, 16); sv += __shfl_xor(sv, 32);
                        if (fq == g) sc[i] = sv; } }
            }
            int rank[4] = {0, 0, 0, 0};
            int nmax = n[0]; nmax = n[1] > nmax ? n[1] : nmax; nmax = n[2] > nmax ? n[2] : nmax; nmax = n[3] > nmax ? n[3] : nmax;
            for (int j = 0; j < nmax; ++j) {
#pragma unroll
                for (int i = 0; i < 4; ++i) { const float sj = __builtin_bit_cast(float, __builtin_amdgcn_readlane(__builtin_bit_cast(int, sc[i]), j));
                    rank[i] += (j < n[i] && (sj > sc[i] || (sj == sc[i] && j < lane))) ? 1 : 0; } }
#pragma unroll
            for (int i = 0; i < 4; ++i) if (lane < n[i] && rank[i] < need[i]) { const int q = 4 * w + i, key = mykey[i]; const int jj = key >> 6, tp = (key >> 5) & 1, i5 = key & 31, kh = (i5 >> 2) & 1, r = (i5 & 3) | ((i5 >> 3) << 2);
                __hip_atomic_fetch_or(SEL + (q * 2 + kh) * 64 + jj, 1u << (16 * tp + 15 - r), __ATOMIC_RELAXED, __HIP_MEMORY_SCOPE_WORKGROUP); }
        } else {
#pragma unroll 1
            for (int i = 0; i < 4; ++i) { const int q = 4 * w + i;
                const int needq = (int)QP[q * 8 + 4];
                const unsigned v0 = CAND[(q * 2 + 0) * 64 + lane], v1 = CAND[(q * 2 + 1) * 64 + lane];
                const int cnt = __builtin_popcount(v0) + __builtin_popcount(v1); int Pf = cnt;
#pragma unroll
                for (int d = 1; d < 64; d <<= 1) { const int t = __shfl_up(Pf, d); if (lane >= d) Pf += t; }
                int nq = __shfl(Pf, 63); int pos = Pf - cnt;
                for (unsigned tmp = v0; tmp; tmp &= tmp - 1) { const int be = __builtin_ctz(tmp); if (pos < NCAP) list[pos] = (u16)(64 * lane + 32 * (be >> 4) + crow(15 - (be & 15), 0)); ++pos; }
                for (unsigned tmp = v1; tmp; tmp &= tmp - 1) { const int be = __builtin_ctz(tmp); if (pos < NCAP) list[pos] = (u16)(64 * lane + 32 * (be >> 4) + crow(15 - (be & 15), 1)); ++pos; }
                nq = nq < NCAP ? nq : NCAP;
                LDS_WAIT(); asm volatile("" ::: "memory");
                if (nq > 0 && needq > 0) {
                    h8 aq[2];
#pragma unroll
                    for (int ks = 0; ks < 2; ++ks) aq[ks] = *(const LAS h8*)(QL + ((head * 8 + 4 * ks + fq) * 32 + q) * 16);
                    f32x4 wv4 = *(const GAS f32x4*)(WI + (rowbase + q0 + q) * 16 + 4 * fq); wv4 = wv4 * IDX_SCALE;
                    for (int g0 = 0; g0 < nq; g0 += 16) { const int ci = g0 + head; const int key = list[ci < nq ? ci : nq - 1];
                        gf16p kp = Pki + (size_t)key * NPS + 8 * fq;
                        const h8 bk0 = *(const GAS h8*)kp, bk1 = *(const GAS h8*)(kp + 32);
                        f32x4 x = __builtin_amdgcn_mfma_f32_16x16x32_f16(aq[0], bk0, (f32x4){0.f, 0.f, 0.f, 0.f}, 0, 0, 0);
                        x = __builtin_amdgcn_mfma_f32_16x16x32_f16(aq[1], bk1, x, 0, 0, 0);
                        float sv = wv4.x * fmaxf(x.x, 0.f) + wv4.y * fmaxf(x.y, 0.f) + wv4.z * fmaxf(x.z, 0.f) + wv4.w * fmaxf(x.w, 0.f);
                        sv += __shfl_xor(sv, 16); sv += __shfl_xor(sv, 32);
                        if (fq == 0 && ci < nq) scs[ci] = sv; }
                    LDS_WAIT(); asm volatile("" ::: "memory");
                    unsigned thr = 0u;
                    if (needq < nq) {
#pragma unroll 1
                        for (int bit = 31; bit >= 0; --bit) { const unsigned trial = thr | (1u << bit); int c2 = 0;
                            for (int i0 = 0; i0 < nq; i0 += 64) { const int ii = i0 + lane; const bool ok = ii < nq && ordu(scs[ii < nq ? ii : 0]) >= trial; c2 += __builtin_popcountll(__ballot(ok)); }
                            if (c2 >= needq) thr = trial; } }
                    for (int i0 = 0; i0 < nq; i0 += 64) { const int ii = i0 + lane;
                        if (ii < nq && ordu(scs[ii]) >= thr) { const int key = list[ii]; const int jj = key >> 6, tp = (key >> 5) & 1, i5 = key & 31, kh = (i5 >> 2) & 1, r = (i5 & 3) | ((i5 >> 3) << 2);
                            __hip_atomic_fetch_or(SEL + (q * 2 + kh) * 64 + jj, 1u << (16 * tp + 15 - r), __ATOMIC_RELAXED, __HIP_MEMORY_SCOPE_WORKGROUP); } }
                    LDS_WAIT(); asm volatile("" ::: "memory");
                }
            }
        }
    }
    IDX_BAR();
    { GAS u32x4* mo = (GAS u32x4*)(MASK + (rowbase + q0) * 128);
        mo[tid] = *(const LAS u32x4*)(lds + SEL_OFF + tid * 16); mo[512 + tid] = *(const LAS u32x4*)(lds + SEL_OFF + (512 + tid) * 16); }
    IDX_BAR();
}
__device__ __forceinline__ void idx_phase(const Args& a, Frame& F) {
    for (int k = F.vcu; k < 1024; k += F.G) { const int i = k >> 8, c = k & 255; const int b = c >> 5, j = c & 31;
        const int u = (i == 0) ? j : (i == 1) ? 63 - j : (i == 2) ? 64 + j : 127 - j;
        idx_unit(a, F.lds, b, u, i); }
}
}


namespace dbg {
__device__ __forceinline__ int sample_t(int i) { switch (i) { case 0: return 0; case 1: return 1; case 2: return 31; case 3: return 32; case 4: return 63; case 5: return 64; case 6: return 100; case 7: return 127; case 8: return 128; case 9: return 255; case 10: return 256; case 11: return 1000; case 12: return 2047; case 13: return 2048; case 14: return 3071; default: return 4095; } }
constexpr int CW_DBG = 16;
__device__ __forceinline__ void dbg_phase(const Args& a, Frame& F) {
    if (F.vcu >= 16) return;
    unsigned char* ws = a.ws; asm volatile("" : "+s"(ws));
    const f16* P = (const f16*)(ws + WS_P); const float* WI = (const float*)(ws + WS_WI); const unsigned* MASK = (const unsigned*)(ws + WS_MASK);
    unsigned* ctl = (unsigned*)(ws + WS_CTL);
    const int t = sample_t(F.vcu);
    const int b = F.vcu & 7; const size_t rowbase = (size_t)b * SEQ;
    LAS float* qf = (LAS float*)(F.lds);
    LAS float* sc = (LAS float*)(F.lds + 4096);
    LAS unsigned* red = (LAS unsigned*)(F.lds + 4096 + 16384);
    const int tid = F.tid;
    for (int i = tid; i < 1024; i += 512) qf[i] = (float)P[(rowbase + t) * NPS + PC_QI + i];
    if (tid < 2) red[tid] = 0u;
    __syncthreads();
    for (int j = tid; j <= t; j += 512) {
        const f16* kp = P + (rowbase + j) * NPS + PC_KI;
        float s = 0.f;
        for (int h = 0; h < 16; ++h) { float x = 0.f;
            for (int d = 0; d < 64; ++d) x += qf[h * 64 + d] * (float)kp[d];
            s += WI[(rowbase + t) * 16 + h] * fmaxf(x, 0.f); }
        sc[j] = s * 0.03125f;
    }
    __syncthreads();
    unsigned mism = 0u, nsel = 0u;
    for (int j = tid; j <= t; j += 512) {
        const float sj = sc[j]; int rank = 0;
        for (int i = 0; i <= t; ++i) { const float si = sc[i]; rank += (si > sj || (si == sj && i < j)) ? 1 : 0; }
        const bool exp_sel = (rank < 256);
        const int jj = j >> 6, tp = (j >> 5) & 1, i5 = j & 31, kh = (i5 >> 2) & 1, r = (i5 & 3) | ((i5 >> 3) << 2);
        const unsigned wv = MASK[((rowbase + t) * 2 + kh) * 64 + jj];
        const bool act = (wv >> (16 * tp + 15 - r)) & 1u;
        mism += (exp_sel != act) ? 1u : 0u; nsel += act ? 1u : 0u;
    }
    for (int j = t + 1 + tid; j < SEQ; j += 512) {
        const int jj = j >> 6, tp = (j >> 5) & 1, i5 = j & 31, kh = (i5 >> 2) & 1, r = (i5 & 3) | ((i5 >> 3) << 2);
        const unsigned wv = MASK[((rowbase + t) * 2 + kh) * 64 + jj];
        mism += ((wv >> (16 * tp + 15 - r)) & 1u) ? 1u : 0u;
    }
    atomicAdd((unsigned*)&red[0], mism); atomicAdd((unsigned*)&red[1], nsel);
    __syncthreads();
    if (tid == 0) { atomicAdd(ctl + CW_DBG, red[0]); const unsigned want = (t + 1 < 256) ? (unsigned)(t + 1) : 256u; if (red[1] != want) atomicAdd(ctl + CW_DBG + 1, 1u); }
    __syncthreads();
}

__device__ __forceinline__ void dbg2_phase(const Args& a, Frame& F) {
    if (F.vcu >= 16) return;
    unsigned char* ws = a.ws; asm volatile("" : "+s"(ws));
    const f16* P = (const f16*)(ws + WS_P); const unsigned* MASK = (const unsigned*)(ws + WS_MASK); const f16* MIX = (const f16*)(ws + WS_MIX);
    unsigned* ctl = (unsigned*)(ws + WS_CTL);
    const int t = sample_t(F.vcu);
    const int b = F.vcu & 7; const size_t rowbase = (size_t)b * SEQ;
    const int tid = F.tid, h = tid >> 6, d = tid & 63;
    LAS unsigned* red = (LAS unsigned*)(F.lds);
    if (tid < 2) red[tid] = 0u;
    __syncthreads();
    const f16* qp = P + (rowbase + t) * NPS + PC_QA + h * 64;
    float mx = -1e30f;
    for (int j = 0; j <= t; ++j) {
        const int jj = j >> 6, tp = (j >> 5) & 1, i5 = j & 31, kh = (i5 >> 2) & 1, r = (i5 & 3) | ((i5 >> 3) << 2);
        const unsigned wv = MASK[((rowbase + t) * 2 + kh) * 64 + jj];
        if (!((wv >> (16 * tp + 15 - r)) & 1u)) continue;
        const f16* kp = P + (rowbase + j) * NPS + PC_KA; float sdot = 0.f;
        for (int e = 0; e < 64; ++e) sdot += (float)qp[e] * (float)kp[e];
        mx = fmaxf(mx, sdot);
    }
    float l = 0.f, o = 0.f;
    for (int j = 0; j <= t; ++j) {
        const int jj = j >> 6, tp = (j >> 5) & 1, i5 = j & 31, kh = (i5 >> 2) & 1, r = (i5 & 3) | ((i5 >> 3) << 2);
        const unsigned wv = MASK[((rowbase + t) * 2 + kh) * 64 + jj];
        if (!((wv >> (16 * tp + 15 - r)) & 1u)) continue;
        const f16* kp = P + (rowbase + j) * NPS + PC_KA; float sdot = 0.f;
        for (int e = 0; e < 64; ++e) sdot += (float)qp[e] * (float)kp[e];
        const float p = __builtin_amdgcn_exp2f(sdot - mx);
        l += p; o += p * (float)P[(rowbase + j) * NPS + PC_VA + d];
    }
    o /= l;
    const float got = (float)MIX[(rowbase + t) * DM + h * 64 + d];
    if (F.vcu == 0 && tid == 0) { float m64 = -1e30f, s0v = 0.f; float qn = 0.f, kn = 0.f;
        for (int j = 0; j < 64; ++j) { const f16* kp = P + (rowbase + j) * NPS + PC_KA; float sd = 0.f; for (int e = 0; e < 64; ++e) sd += (float)qp[e] * (float)kp[e]; if (j == 0) s0v = sd; m64 = fmaxf(m64, sd); }
        for (int e = 0; e < 64; ++e) { qn += (float)qp[e] * (float)qp[e]; const float kv = (float)P[(rowbase + 0) * NPS + PC_KA + e]; kn += kv * kv; }
        ctl[20] = (unsigned)(m64 - s0v + 0.5f); ctl[21] = (unsigned)(__builtin_sqrtf(qn) * 4.f + 0.5f); ctl[22] = (unsigned)(__builtin_sqrtf(kn) * 4.f + 0.5f); }
    if (F.vcu == 0 && h == 3) { float ratio = got / o; if (!(ratio > 0.f && ratio < 6.f)) ratio = 6.f; atomicAdd(ctl + 28, (unsigned)(ratio * 10.f + 0.5f)); }
    LAS float* redf = (LAS float*)(F.lds + 64);
    if (tid < 2) redf[tid] = 0.f;
    __syncthreads();
    atomicAdd((float*)&redf[0], (got - o) * (got - o)); atomicAdd((float*)&redf[1], o * o);
    if (F.vcu == 0 && __builtin_fabsf(got - o) > 0.01f + 0.02f * __builtin_fabsf(o)) atomicAdd(ctl + 19, 1u);
    __syncthreads();
    if (tid == 0) { const float rr = __builtin_sqrtf(redf[0] / redf[1]); unsigned c = (unsigned)(rr * 100.f + 0.5f); if (!(rr < 10.f)) c = 1000; ctl[32 + F.vcu] = c; }
    __syncthreads();
}
}

enum { ST_GEMM = 0, ST_IDX = 1, ST_MLA = 2, ST_DSA = 3, ST_FINAL = 4, ST_ZMIX = 5, ST_DBG = 6, ST_DBG2 = 7, ST_NONE = 8 };

#ifndef DBG_WHICH
#define DBG_WHICH 3
#endif
__device__ __forceinline__ void final_phase(const Args& a, Frame& F) {
    const int gw = F.vcu * NWAVES + F.wave, NGW = F.G * NWAVES;
    const float* SS = (const float*)(a.ws + WS_SS16);
    f32x4 gv[4];
#pragma unroll
    for (int j = 0; j < 4; ++j) gv[j] = *((const f32x4*)a.g_final + F.lane + 64 * j);
    float dscale = 1.f;
    if (MK_TIMING) { const unsigned* ctl = (const unsigned*)(a.ws + WS_CTL); unsigned tk = 0; if (TSEL >= 100) { for (int i = 0; i < 12; ++i) tk += __hip_atomic_load(ctl + 48 + i, __ATOMIC_RELAXED, __HIP_MEMORY_SCOPE_AGENT); tk /= 5; } else if (TSEL == 67) tk = __hip_atomic_load(ctl + 48 + 6, __ATOMIC_RELAXED, __HIP_MEMORY_SCOPE_AGENT) + __hip_atomic_load(ctl + 48 + 7, __ATOMIC_RELAXED, __HIP_MEMORY_SCOPE_AGENT); else tk = __hip_atomic_load(ctl + 48 + TSEL, __ATOMIC_RELAXED, __HIP_MEMORY_SCOPE_AGENT); dscale = 1.f + (float)((tk + TOFF) / TUNIT); }
    if (MK_DEBUG) { const unsigned* ctl = (const unsigned*)(a.ws + WS_CTL); const unsigned mm = __hip_atomic_load(ctl + 16, __ATOMIC_RELAXED, __HIP_MEMORY_SCOPE_AGENT), bc = __hip_atomic_load(ctl + 17, __ATOMIC_RELAXED, __HIP_MEMORY_SCOPE_AGENT);
      const unsigned m2 = __hip_atomic_load(ctl + 18, __ATOMIC_RELAXED, __HIP_MEMORY_SCOPE_AGENT);
      unsigned code = 0; if (DBG_WHICH == 0) { if (mm) code = 1 + (31 - __builtin_clz(mm)); } else if (DBG_WHICH == 1) code = bc; else if (DBG_WHICH == 2) { if (m2) code = 1 + (31 - __builtin_clz(m2)); }
      else { unsigned nb = 0, first = 0, second = 0; for (int i = 0; i < 16; ++i) { const unsigned c = __hip_atomic_load(ctl + 32 + i, __ATOMIC_RELAXED, __HIP_MEMORY_SCOPE_AGENT); if (c > nb) nb = c; first += c; if (c > 3 && !second) second = i + 1; }
        code = (DBG_WHICH == 3) ? nb : (DBG_WHICH == 4) ? first / 16 : (DBG_WHICH == 14) ? (__hip_atomic_load(ctl + 28, __ATOMIC_RELAXED, __HIP_MEMORY_SCOPE_AGENT) / 64) : (DBG_WHICH >= 10) ? ({ const unsigned v_ = __hip_atomic_load(ctl + 14 + DBG_WHICH, __ATOMIC_RELAXED, __HIP_MEMORY_SCOPE_AGENT); v_ ? 1 + (31 - __builtin_clz(v_)) : 0u; }) : (DBG_WHICH == 5) ? second : (DBG_WHICH == 6) ? __hip_atomic_load(ctl + 19, __ATOMIC_RELAXED, __HIP_MEMORY_SCOPE_AGENT) / 8 : __hip_atomic_load(ctl + 13 + DBG_WHICH, __ATOMIC_RELAXED, __HIP_MEMORY_SCOPE_AGENT); if (code > 70) code = 70; } dscale = 1.f + (float)code; }
    for (int m = gw; m < M; m += NGW) {
        float s = (F.lane < 16) ? SS[(size_t)m * 16 + F.lane] : 0.f;
        s = wave_sum(s);
        const float rs = frsq(s * (1.f / DM) + EPS) * dscale;
        f32x4* xr = (f32x4*)(a.out + (size_t)m * DM) + F.lane; const h4* hr = (const h4*)((const f16*)(a.ws + WS_XH) + (size_t)m * DM) + F.lane;
#pragma unroll
        for (int j = 0; j < 4; ++j) { const h4 hv = hr[64 * j]; f32x4 v = (f32x4){(float)hv[0], (float)hv[1], (float)hv[2], (float)hv[3]}; v = v * rs * gv[j]; xr[64 * j] = v; }
    }
}
__device__ __forceinline__ void zmix_phase(const Args& a, Frame& F) {
    u32x4* p = (u32x4*)(a.ws + WS_MIX);
    const size_t n = (size_t)M * DM * 2 / 16;
    for (size_t i = (size_t)F.vcu * 512 + F.tid; i < n; i += (size_t)F.G * 512) p[i] = (u32x4){0u, 0u, 0u, 0u};
}

struct Stage { int type, gi, bar; };
__device__ __forceinline__ Stage get_stage(int s) {
#if MK_DEBUG
    switch (s) {
        case 0: return {ST_GEMM, G_FFN1A, 1};
        case 1: return {ST_GEMM, G_FFN1B, 1};
        case 2: return {ST_GEMM, G_WIN, 1};
        case 3: return {ST_GEMM, G_QUP, 0};
        case 4: return {ST_GEMM, G_KVUP, 0};
        case 5: return {ST_IDX, 0, 1};
        case 6: return {ST_DBG, 0, 1};
        case 7: return {ST_MLA, 0, 0};
        case 8: return {ST_DSA, 0, 1};
        case 9: return {ST_DBG2, 0, 1};
        case 10: return {ST_GEMM, G_WOUT, 1};
        case 11: return {ST_GEMM, G_FFN2A, 1};
        case 12: return {ST_GEMM, G_FFN2B, 1};
        default: return {ST_FINAL, 0, 0};
    }
#else
    switch (s) {
        case 0: return {ST_GEMM, G_FFN1A, 1};
        case 1: return {ST_GEMM, G_FFN1B, 1};
        case 2: return {ST_GEMM, G_WIN, 1};
        case 3: return {ST_GEMM, G_QUP, 0};
        case 4: return {ST_GEMM, G_KVUP, 0};
        case 5: return {ST_IDX, 0, 1};
        case 6: return {ST_MLA, 0, 0};
        case 7: return {ST_DSA, 0, 1};
#if DUP_STAGE == 6
        case 8: return {ST_MLA, 0, 1};
#elif DUP_STAGE == 7
        case 8: return {ST_DSA, 0, 1};
#elif DUP_STAGE == 5
        case 8: return {ST_IDX, 0, 1};
#endif
        case 8 + (DUP_STAGE ? 1 : 0): return {ST_GEMM, G_WOUT, 1};
        case 9 + (DUP_STAGE ? 1 : 0): return {ST_GEMM, G_FFN2A, 1};
        case 10 + (DUP_STAGE ? 1 : 0): return {ST_GEMM, G_FFN2B, (FUSE_FINAL && gridDim.x == 256) ? 0 : 1};
        default: return {(FUSE_FINAL && gridDim.x == 256) ? ST_NONE : ST_FINAL, 0, 0};
    }
#endif
}
#if MK_DEBUG
constexpr int NSTAGES = 14;
#else
constexpr int NSTAGES = 12 + (DUP_STAGE ? 1 : 0);
#endif

__global__ void __launch_bounds__(NWAVES * 64, 2) mega_fwd(Args args) {
    extern __shared__ __attribute__((aligned(16))) unsigned char lds_raw[];
    Frame F;
    F.lds = (LAS unsigned char*)lds_raw;
    volatile LAS unsigned* MISC = (volatile LAS unsigned*)(F.lds + MISC_OFF);
    F.tid = threadIdx.x; F.lane = F.tid & 63; F.wave = __builtin_amdgcn_readfirstlane(F.tid >> 6);
    F.G = gridDim.x; { const int bx = blockIdx.x; F.vcu = (F.G % 8 == 0) ? (bx % 8) * (F.G / 8) + bx / 8 : bx; }
    for (int u = F.tid; u < (LDS_BYTES - LDSCTL_OFF) / 4; u += NWAVES * 64) ((LAS unsigned*)(F.lds + LDSCTL_OFF))[u] = 0u;
    __syncthreads();
    unsigned* ctl = (unsigned*)(args.ws + WS_CTL);
    XcdBarrier bar = xcd_barrier_post(ctl + CW_BAR, MISC + 8);
    grp_barrier_post(bar);

    for (int rep = 0; rep < ((RSEL == 100) ? 2 : 1); ++rep) prep_phase(args, F);
    xcd_barrier(bar);

    for (int s = 0; s < NSTAGES; ++s) {
        const Stage st = get_stage(s);
        unsigned long long tq0 = 0; if (MK_TIMING && blockIdx.x == 0 && threadIdx.x == 0) tq0 = __builtin_amdgcn_s_memrealtime();
        F.tid = opaque_tid(); F.lane = F.tid & 63; F.wave = __builtin_amdgcn_readfirstlane(F.tid >> 6);
        for (int rep = 0; rep < ((s == RSEL) ? 2 : 1); ++rep) {
        if (st.type == ST_GEMM) {
            pg8::GemmDesc g; pg8::make_gemm(args, st.gi, g);
            pg8::StaticOrder S; S.init(g.M, g.N, F.G, (int)blockIdx.x);
            pg8::gemm_phase(F.lds, args, st.gi, g, S);
        } else if (st.type == ST_MLA) {
            if (F.wave >= 4) __builtin_amdgcn_s_setprio(1);
            att::attn_phase<0>(args, F);
            __builtin_amdgcn_s_setprio(0);
        } else if (st.type == ST_DSA) {
            if (F.wave >= 4) __builtin_amdgcn_s_setprio(1);
            att::attn_phase<1>(args, F);
            __builtin_amdgcn_s_setprio(0);
        } else if (st.type == ST_IDX) {
            idx::idx_phase(args, F);
#if MK_DEBUG
        } else if (st.type == ST_DBG) {
            dbg::dbg_phase(args, F);
        } else if (st.type == ST_DBG2) {
            dbg::dbg2_phase(args, F);
#endif
        } else if (st.type == ST_FINAL) {
            final_phase(args, F);
        }
        }
        if (st.bar) { if (GRPBAR && gridDim.x == 256) grp_barrier(bar); else xcd_barrier(bar); }
        if (MK_TIMING && blockIdx.x == 0 && threadIdx.x == 0) { const unsigned long long tq1 = __builtin_amdgcn_s_memrealtime(); __hip_atomic_store(ctl + 48 + s, (unsigned)(tq1 - tq0), __ATOMIC_RELAXED, __HIP_MEMORY_SCOPE_AGENT); }
    }
}

extern "C" void kernel_launch(void* const* d_in, const int* in_sizes, int n_in, void* d_out, int out_size, void* d_ws, size_t ws_size, hipStream_t stream) {
    static int grid = 0;
    if (grid == 0) {
        if (n_in != 17 || in_sizes[0] != M * DM || out_size != M * DM || ws_size < WS_END) {
            fprintf(stderr, "kernel_launch: unexpected shapes/workspace: n_in %d in0 %d out %d ws %zu (need %zu); nothing launched\n", n_in, n_in > 0 ? in_sizes[0] : -1, out_size, ws_size, (size_t)WS_END);
            grid = -1; return; }
        int dev = 0, cus = 0;
        if (hipGetDevice(&dev) != hipSuccess || hipDeviceGetAttribute(&cus, hipDeviceAttributeMultiprocessorCount, dev) != hipSuccess) { grid = -1; return; }
        if (hipFuncSetAttribute((const void*)mega_fwd, hipFuncAttributeMaxDynamicSharedMemorySize, LDS_BYTES) != hipSuccess) { fprintf(stderr, "kernel_launch: hipFuncSetAttribute failed\n"); grid = -1; return; }
        int per_cu = 0;
        if (hipOccupancyMaxActiveBlocksPerMultiprocessor(&per_cu, (const void*)mega_fwd, NWAVES * 64, LDS_BYTES) != hipSuccess || per_cu < 1)
            fprintf(stderr, "kernel_launch: note: occupancy query reports %d workgroups per CU\n", per_cu);
        (void)hipGetLastError();
        grid = cus < 256 ? cus : 256;
    }
    if (grid < 0) return;
    (void)hipMemsetAsync((char*)d_ws + WS_CTL, 0, CTL_ZERO_BYTES, stream);
    Args a{};
    a.x = (const float*)d_in[0]; a.g_ffn1 = (const float*)d_in[1]; a.w1_gate = (const float*)d_in[2]; a.w1_up = (const float*)d_in[3]; a.w1_down = (const float*)d_in[4];
    a.g_mix = (const float*)d_in[5]; a.w_in = (const float*)d_in[6]; a.g_q_lat = (const float*)d_in[7]; a.g_kv_lat = (const float*)d_in[8]; a.w_uq = (const float*)d_in[9]; a.w_ukv = (const float*)d_in[10];
    a.w_out = (const float*)d_in[11]; a.g_ffn2 = (const float*)d_in[12]; a.w2_gate = (const float*)d_in[13]; a.w2_up = (const float*)d_in[14]; a.w2_down = (const float*)d_in[15]; a.g_final = (const float*)d_in[16];
    a.out = (float*)d_out; a.ws = (unsigned char*)d_ws;
    hipLaunchKernelGGL(mega_fwd, dim3(grid), dim3(NWAVES * 64), LDS_BYTES, stream, a);
}
```
